# Optimizing an MI355X kernel written in HIP

```python
import math
import jax, jax.numpy as jnp
from jax import lax
import numpy as np


D_MODEL = 1024
BATCH = 8
SEQ = 2048
DEPTH = 1

DELTA_HEAD_DIM = 128
DELTA_WIDTH = D_MODEL // 2
N_DELTA_HEADS = DELTA_WIDTH // DELTA_HEAD_DIM
SHORT_CONV = 5
CHUNK = 64
POOL_WINDOWS = (2, 4, 8, 16)
N_POOL_GROUPS = len(POOL_WINDOWS)
POOL_WIDTH = D_MODEL - DELTA_WIDTH
POOL_GROUP_DIM = POOL_WIDTH // N_POOL_GROUPS
MIX_WIDTH = DELTA_WIDTH + POOL_WIDTH
IN_COLS = 4 * DELTA_WIDTH + 4 * N_DELTA_HEADS + POOL_WIDTH
N_EXPERTS = 16
EC_CAPACITY = 2
EXPERT_FF = 2 * D_MODEL
RMS_EPS = 1e-6

kernel_name = 'hybrid_deltanet_pool_ecmoe_encoder'


def _rmsnorm(x, w):
    xf = x.astype(jnp.float32)
    y = xf * lax.rsqrt(jnp.mean(xf * xf, axis=-1, keepdims=True) + RMS_EPS)
    return (y * w.astype(jnp.float32)).astype(x.dtype)


def _l2norm(x):
    xf = x.astype(jnp.float32)
    return xf * lax.rsqrt(jnp.sum(xf * xf, axis=-1, keepdims=True) + RMS_EPS)


def _centred_dwconv(x, w):
    K = w.shape[0]
    return lax.conv_general_dilated(
        x, w[:, None, :].astype(x.dtype), window_strides=(1,),
        padding=[(K // 2, K // 2)], dimension_numbers=('NWC', 'WIO', 'NWC'),
        feature_group_count=x.shape[-1])


def _chunk_gated_delta_rule(q, k, v, g, beta):
    out_dtype = v.dtype
    q, k, v, g, beta = (a.astype(jnp.float32) for a in (q, k, v, g, beta))
    B, H, T, Dk = q.shape
    Dv = v.shape[-1]
    N = T // CHUNK
    q = q.reshape(B, H, N, CHUNK, Dk)
    k = k.reshape(B, H, N, CHUNK, Dk)
    v = v.reshape(B, H, N, CHUNK, Dv)
    beta = beta.reshape(B, H, N, CHUNK)
    g = jnp.cumsum(g.reshape(B, H, N, CHUNK), axis=-1)
    incl = jnp.tril(jnp.ones((CHUNK, CHUNK), dtype=bool))
    strict = jnp.tril(jnp.ones((CHUNK, CHUNK), dtype=bool), -1)
    diff = g[..., :, None] - g[..., None, :]
    decay = jnp.where(incl, jnp.exp(jnp.where(incl, diff, 0.0)), 0.0)
    kk = jnp.einsum('bhncd,bhnsd->bhncs', k, k)
    a_mat = jnp.where(strict, beta[..., :, None] * kk * decay, 0.0) + jnp.eye(CHUNK, dtype=jnp.float32)
    rhs = jnp.concatenate([v * beta[..., None], k * (beta * jnp.exp(g))[..., None]], axis=-1)
    sol = lax.linalg.triangular_solve(a_mat, rhs, left_side=True, lower=True, unit_diagonal=True)
    u, w = sol[..., :Dv], sol[..., Dv:]
    qk = jnp.where(incl, jnp.einsum('bhncd,bhnsd->bhncs', q, k) * decay, 0.0)
    q_dec = q * jnp.exp(g)[..., None]
    g_last = g[..., -1]
    k_dec = k * jnp.exp(g_last[..., None] - g)[..., None]

    def step(S, xs):
        q_c, k_c, u_c, w_c, qk_c, gl_c = xs
        v_new = u_c - jnp.einsum('bhcd,bhde->bhce', w_c, S)
        o_c = jnp.einsum('bhcd,bhde->bhce', q_c, S) + jnp.einsum('bhcs,bhse->bhce', qk_c, v_new)
        S = S * jnp.exp(gl_c)[..., None, None] + jnp.einsum('bhcd,bhce->bhde', k_c, v_new)
        return S, o_c

    xs = tuple(jnp.moveaxis(a, 2, 0) for a in (q_dec, k_dec, u, w, qk, g_last))
    _, o = lax.scan(step, jnp.zeros((B, H, Dk, Dv), jnp.float32), xs)
    return jnp.moveaxis(o, 0, 2).reshape(B, H, T, Dv).astype(out_dtype)


def _log_decay(a, a_log, dt_bias):
    gl = -jnp.exp(a_log.astype(jnp.float32)) * jax.nn.softplus(a.astype(jnp.float32) + dt_bias.astype(jnp.float32))
    return jnp.swapaxes(gl, 1, 2)


def _centred_mean_pool(u, window):
    B, T, C = u.shape
    lo = window // 2
    hi = window - lo - 1
    csum = jnp.concatenate([jnp.zeros((B, 1, C), jnp.float32), jnp.cumsum(u.astype(jnp.float32), axis=1)], axis=1)
    t = jnp.arange(T)
    start = jnp.maximum(t - lo, 0)
    end = jnp.minimum(t + hi + 1, T)
    total = csum[:, end] - csum[:, start]
    count = (end - start).astype(jnp.float32)
    return (total / count[None, :, None]).astype(u.dtype)


def _hybrid_mixer(xn, w_in, conv_w, a_log_fwd, dt_bias_fwd, a_log_bwd, dt_bias_bwd,
                  head_norm_w, pool_w, pool_scale, w_out):
    B, T, _ = xn.shape
    H, Dh = N_DELTA_HEADS, DELTA_HEAD_DIM
    proj = jnp.einsum('btd,dc->btc', xn, w_in)
    qkv, z, ab, u = jnp.split(proj, [3 * DELTA_WIDTH, 4 * DELTA_WIDTH, 4 * DELTA_WIDTH + 4 * H], axis=-1)
    qkv = jax.nn.silu(_centred_dwconv(qkv, conv_w))
    q, k, v = jnp.split(qkv, 3, axis=-1)
    to_heads = lambda a: jnp.swapaxes(a.reshape(B, T, H, Dh), 1, 2)
    q = (_l2norm(to_heads(q)) * (Dh ** -0.5)).astype(xn.dtype)
    k = _l2norm(to_heads(k)).astype(xn.dtype)
    v = to_heads(v)
    a_f, b_f, a_b, b_b = jnp.split(ab, 4, axis=-1)
    g_f = _log_decay(a_f, a_log_fwd, dt_bias_fwd)
    g_b = _log_decay(a_b, a_log_bwd, dt_bias_bwd)
    beta_f = jnp.swapaxes(jax.nn.sigmoid(b_f.astype(jnp.float32)), 1, 2)
    beta_b = jnp.swapaxes(jax.nn.sigmoid(b_b.astype(jnp.float32)), 1, 2)
    o_fwd = _chunk_gated_delta_rule(q, k, v, g_f, beta_f)
    rev = lambda a: jnp.flip(a, axis=2)
    o_bwd = rev(_chunk_gated_delta_rule(rev(q), rev(k), rev(v), rev(g_b), rev(beta_b)))
    o = jnp.swapaxes(o_fwd + o_bwd, 1, 2)
    o = _rmsnorm(o, head_norm_w) * jax.nn.silu(z.reshape(B, T, H, Dh))
    o_delta = o.reshape(B, T, DELTA_WIDTH)
    ug = u.reshape(B, T, N_POOL_GROUPS, POOL_GROUP_DIM)
    pooled = jnp.stack([_centred_mean_pool(ug[:, :, i], w) for i, w in enumerate(POOL_WINDOWS)], axis=2)
    o_pool = jnp.einsum('btgc,gcd->btgd', pooled - ug, pool_w).reshape(B, T, POOL_WIDTH) * pool_scale
    return jnp.einsum('btc,cd->btd', jnp.concatenate([o_delta, o_pool], axis=-1), w_out)


def _expert_choice_ffn(xn, router_w, w_gate, w_up, w_down):
    B, T, D = xn.shape
    cap = EC_CAPACITY * T // N_EXPERTS
    probs = jax.nn.softmax(jnp.einsum('btd,de->bte', xn, router_w).astype(jnp.float32), axis=-1)
    gate, idx = lax.top_k(jnp.swapaxes(probs, 1, 2), cap)
    bidx = jnp.arange(B)[:, None, None]
    xg = xn[bidx, idx]
    h = jax.nn.silu(jnp.einsum('becd,edf->becf', xg, w_gate)) * jnp.einsum('becd,edf->becf', xg, w_up)
    y = jnp.einsum('becf,efd->becd', h, w_down) * gate[..., None].astype(xn.dtype)
    return jnp.zeros_like(xn).at[bidx, idx].add(y)


def setup_inputs(seed: int = 0) -> dict:
    key = jax.random.key(seed)
    ks = jax.random.split(key, 20)
    H = N_DELTA_HEADS
    nrm = lambda k, shape, fan_in: jax.random.normal(k, shape, jnp.float32) * (fan_in ** -0.5)
    gain = lambda k, shape: 1.0 + 0.02 * jax.random.normal(k, shape, jnp.float32)
    def dt_bias(k):
        dt = jnp.exp(jax.random.uniform(k, (DEPTH, H), jnp.float32, math.log(1e-3), math.log(1e-1)))
        return dt + jnp.log(-jnp.expm1(-dt))
    return {
        'x': jax.random.normal(ks[0], (BATCH, SEQ, D_MODEL), jnp.float32),
        'norm_mix_w': gain(ks[1], (DEPTH, D_MODEL)),
        'w_in': nrm(ks[2], (DEPTH, D_MODEL, IN_COLS), D_MODEL),
        'conv_w': nrm(ks[3], (DEPTH, SHORT_CONV, 3 * DELTA_WIDTH), SHORT_CONV),
        'a_log_fwd': jnp.log(jax.random.uniform(ks[4], (DEPTH, H), jnp.float32, 1.0, 16.0)),
        'dt_bias_fwd': dt_bias(ks[5]),
        'a_log_bwd': jnp.log(jax.random.uniform(ks[6], (DEPTH, H), jnp.float32, 1.0, 16.0)),
        'dt_bias_bwd': dt_bias(ks[7]),
        'head_norm_w': gain(ks[8], (DEPTH, DELTA_HEAD_DIM)),
        'pool_w': nrm(ks[9], (DEPTH, N_POOL_GROUPS, POOL_GROUP_DIM, POOL_GROUP_DIM), POOL_GROUP_DIM),
        'pool_scale': gain(ks[10], (DEPTH, POOL_WIDTH)),
        'w_out': nrm(ks[11], (DEPTH, MIX_WIDTH, D_MODEL), MIX_WIDTH),
        'norm_ffn_w': gain(ks[12], (DEPTH, D_MODEL)),
        'router_w': nrm(ks[13], (DEPTH, D_MODEL, N_EXPERTS), D_MODEL),
        'expert_w_gate': nrm(ks[14], (DEPTH, N_EXPERTS, D_MODEL, EXPERT_FF), D_MODEL),
        'expert_w_up': nrm(ks[15], (DEPTH, N_EXPERTS, D_MODEL, EXPERT_FF), D_MODEL),
        'expert_w_down': nrm(ks[16], (DEPTH, N_EXPERTS, EXPERT_FF, D_MODEL), EXPERT_FF),
        'norm_final_w': gain(ks[17], (D_MODEL,)),
    }


def reference(x, norm_mix_w, w_in, conv_w, a_log_fwd, dt_bias_fwd, a_log_bwd, dt_bias_bwd,
              head_norm_w, pool_w, pool_scale, w_out, norm_ffn_w, router_w,
              expert_w_gate, expert_w_up, expert_w_down, norm_final_w):
    h = x
    for i in range(DEPTH):
        h = h + _hybrid_mixer(_rmsnorm(h, norm_mix_w[i]), w_in[i], conv_w[i],
                              a_log_fwd[i], dt_bias_fwd[i], a_log_bwd[i], dt_bias_bwd[i],
                              head_norm_w[i], pool_w[i], pool_scale[i], w_out[i])
        h = h + _expert_choice_ffn(_rmsnorm(h, norm_ffn_w[i]), router_w[i],
                                   expert_w_gate[i], expert_w_up[i], expert_w_down[i])
    return _rmsnorm(h, norm_final_w)
```

```cpp
#include <hip/hip_runtime.h>
#include <cstdio>
#include <cstdint>

#define LAS __attribute__((address_space(3)))
typedef unsigned short bf16_t;
typedef short bf16x8 __attribute__((ext_vector_type(8)));
typedef float f32x4 __attribute__((ext_vector_type(4)));
typedef float f32x2 __attribute__((ext_vector_type(2)));
typedef unsigned u32x4 __attribute__((ext_vector_type(4)));
typedef unsigned u32x2 __attribute__((ext_vector_type(2)));

constexpr int NB = 8, T = 2048, D = 1024, MTOK = NB * T;
constexpr int INC = 2576, NPROJ = 2560;
constexpr int NH = 4, HD = 128, NCH = T / 64;
constexpr int NE = 16, CAP = 256, FF = 2048;
constexpr float EPS = 1e-6f;
constexpr int NBLK = 256, NTHR = 512, NWAVE = 8;
constexpr int LDS_BYTES = 155648;

constexpr size_t MiB = (size_t)1 << 20;
constexpr size_t WS_CTL = 0;
constexpr size_t WS_WIN = 1 * MiB;
constexpr size_t WS_WMIX = 6 * MiB;
constexpr size_t WS_PREP = 8 * MiB;
constexpr size_t WS_WGU = 8 * MiB;
constexpr size_t WS_WD = 136 * MiB;
constexpr size_t WS_XN = 200 * MiB;
constexpr size_t WS_AMIX = 232 * MiB;
constexpr size_t WS_Y = 200 * MiB;
constexpr size_t WS_GATES = 264 * MiB;
constexpr size_t WS_PROBS = 265 * MiB;
constexpr size_t WS_INV = 266 * MiB;
constexpr size_t WS_SELI = 267 * MiB;
constexpr size_t WS_SELG = 267 * MiB + 131072;
constexpr size_t WS_EGL = 267 * MiB + 262144;
constexpr size_t WS_PROJ = 268 * MiB;
constexpr size_t WS_XG = 268 * MiB;
constexpr size_t WS_S = 348 * MiB;
constexpr size_t WS_HMID = 332 * MiB;
constexpr size_t WS_END = 460 * MiB;
constexpr size_t PREP_STRIDE = 98304;

struct Args { const float* in[18]; float* out; unsigned char* ws; };

typedef __bf16 bf16v2_t __attribute__((ext_vector_type(2)));
__device__ __forceinline__ unsigned cvt_pk_bf16_asm(float lo, float hi) { unsigned r; asm volatile("v_cvt_pk_bf16_f32 %0, %1, %2" : "=v"(r) : "v"(lo), "v"(hi)); return r; }
__device__ __forceinline__ unsigned cvt_pk_bf16(float lo, float hi) { f32x2 f = {lo, hi}; return __builtin_bit_cast(unsigned, __builtin_convertvector(f, bf16v2_t)); }
__device__ __forceinline__ float bf2f(unsigned h) { return __uint_as_float(h << 16); }
__device__ __forceinline__ float bflo(unsigned w) { return __uint_as_float(w << 16); }
__device__ __forceinline__ float bfhi(unsigned w) { return __uint_as_float(w & 0xffff0000u); }
__device__ __forceinline__ float wave_sum(float v) {
#pragma unroll
    for (int o = 1; o < 64; o <<= 1) v += __shfl_xor(v, o);
    return v;
}
__device__ __forceinline__ float silu_f(float x) { return x / (1.f + __expf(-x)); }
__device__ __forceinline__ float sigmoid_f(float x) { return 1.f / (1.f + __expf(-x)); }
__device__ __forceinline__ float softplus_f(float x) { return fmaxf(x, 0.f) + log1pf(__expf(-fabsf(x))); }

namespace pg8 {
constexpr int BM = 256, BK = 64, HALF = 128, HTB = HALF * BK * 2, STAGE_BYTES = 8 * HTB, NXCD = 8, WGM = 8;
__host__ __device__ __forceinline__ int lds_byte(int r, int c) { const int st = (r >> 4) * 2 + (c >> 5), rr = r & 15, cc = c & 31, ob = rr * 64 + cc * 2; return st * 1024 + (ob ^ (((ob >> 9) & 1) << 5)); }
__host__ __device__ __forceinline__ void stage_rc(int b, int& R, int& C) { const int st = b / 1024, sb = b % 1024, swz = sb ^ (((sb >> 9) & 1) << 5); R = (st >> 1) * 16 + swz / 64; C = (st & 1) * 32 + (swz % 64) / 2; }
__host__ __device__ __forceinline__ int perm32(int rho) { const int n = rho >> 4, i = rho & 15; return 8 * (i >> 2) + 4 * n + (i & 3); }

struct Unit { int pm, pn; };
struct Gemm { const bf16_t* A; const bf16_t* Bt; int K; };

struct StaticOrder {
    int nM, nN, nwg, G, c;
    __device__ void init(int M, int N, int G_, int c_) { nM = M / BM; nN = N / BM; nwg = nM * nN; G = G_; c = c_; }
    __device__ bool next(int i, Unit& u) const {
        const long L = (long)i * G + c; if (L >= nwg) return false;
        int wgid = (int)L; { const int q = nwg / NXCD, r = nwg % NXCD, xcd = wgid % NXCD, off = wgid / NXCD; wgid = (xcd < r ? xcd * (q + 1) : r * (q + 1) + (xcd - r) * q) + off; }
        const int nig = WGM * nN, gid = wgid / nig, fm = gid * WGM, gsz = (nM - fm) < WGM ? (nM - fm) : WGM;
        u.pm = fm + ((wgid % nig) % gsz); u.pn = (wgid % nig) / gsz; return true;
    }
};
struct ExpertOrder {
    int e, b, pnh, ntile, rounds;
    __device__ void init(int c, int ntile_) { const int x = c & 7, j = c >> 3; e = 2 * x + (j >> 4); b = j & 7; pnh = (j >> 3) & 1; ntile = ntile_; rounds = ntile_ >> 1; }
    __device__ bool next(int i, Unit& u) const { if (i >= rounds) return false; u.pm = b * NE + e; u.pn = e * ntile + 2 * i + pnh; return true; }
};

template <class Epi, class Sched>
__device__ __forceinline__ void gemm_phase(LAS unsigned char* lds, const Gemm g, const Sched& S, const Epi& E) {
    const int tid = threadIdx.x, wid = __builtin_amdgcn_readfirstlane(tid >> 6), lane = tid & 63, wr = wid >> 2, wc = wid & 3, fr = lane & 15, fq = lane >> 4;
    const int K = g.K, nt = K / BK;
    unsigned voffA[2], voffB[2];
#pragma unroll
    for (int i = 0; i < 2; ++i) { int R, C; stage_rc(tid * 16 + i * 8192, R, C); const int Rb = Epi::PERM ? ((R & ~31) + perm32(R & 31)) : R;
        voffA[i] = (unsigned)(R * K + C) * 2u; voffB[i] = (unsigned)(Rb * K + C) * 2u; }
    const size_t kstep = (size_t)(BK * 2);
    const size_t hstep = (size_t)HALF * K * 2;
    const size_t tstep = 2 * hstep;
    const unsigned ldsw = (unsigned)wid * 1024u;
    const int aoff = lds_byte(wr * 64 + fr, fq * 8), boff = lds_byte(wc * 32 + fr, fq * 8);
#define PG8_SA(b, h) (((b) * 2 + (h)) * HTB)
#define PG8_SB(b, h) ((4 + (b) * 2 + (h)) * HTB)
#define PG8_STAGE(bufoff, gbase, voff) do { _Pragma("unroll") for (int _i = 0; _i < 2; ++_i) \
        __builtin_amdgcn_global_load_lds((const unsigned*)((const char*)(gbase) + (voff)[_i]), (LAS unsigned*)(lds + (bufoff) + ldsw + _i * 8192), 16, 0, 0); } while (0)
#define PG8_LDA(dst, b, h) do { _Pragma("unroll") for (int m = 0; m < 4; ++m) _Pragma("unroll") for (int k = 0; k < 2; ++k) dst[m][k] = *(const LAS bf16x8*)(lds + PG8_SA(b, h) + aoff + m * 2048 + k * 1024); } while (0)
#define PG8_LDB(dst, b, h) do { _Pragma("unroll") for (int n = 0; n < 2; ++n) _Pragma("unroll") for (int k = 0; k < 2; ++k) dst[n][k] = *(const LAS bf16x8*)(lds + PG8_SB(b, h) + boff + n * 2048 + k * 1024); } while (0)
#define PG8_MMA(ai, bj, At, Bt) do { __builtin_amdgcn_s_setprio(1); _Pragma("unroll") for (int m = 0; m < 4; ++m) _Pragma("unroll") for (int n = 0; n < 2; ++n) _Pragma("unroll") for (int k = 0; k < 2; ++k) \
        acc[ai][bj][m][n] = __builtin_amdgcn_mfma_f32_16x16x32_bf16(Bt[n][k], At[m][k], acc[ai][bj][m][n], 0, 0, 0); __builtin_amdgcn_s_setprio(0); } while (0)
#define PG8_WAIT_V(n) asm volatile("s_waitcnt vmcnt(" #n ")" ::: "memory")
#define PG8_WAIT_L(n) asm volatile("s_waitcnt lgkmcnt(" #n ")" ::: "memory")
#define PG8_BAR __builtin_amdgcn_s_barrier()
#define PG8_SCHED __builtin_amdgcn_sched_barrier(0)
    Unit cur, nxt; int ui = 0;
    if (!S.next(0, cur)) return;
    f32x4 acc[2][2][4][2];
#pragma unroll
    for (int a = 0; a < 2; ++a)
#pragma unroll
        for (int b = 0; b < 2; ++b)
#pragma unroll
            for (int m = 0; m < 4; ++m)
#pragma unroll
                for (int n = 0; n < 2; ++n) acc[a][b][m][n] = (f32x4){0.f, 0.f, 0.f, 0.f};
    bf16x8 At[4][2], B0[2][2], B1[2][2];
    const char* cA = (const char*)g.A + (size_t)cur.pm * tstep; const char* cB = (const char*)g.Bt + (size_t)cur.pn * tstep;
    PG8_STAGE(PG8_SB(0, 0), cB, voffB); PG8_STAGE(PG8_SB(0, 1), cB + hstep, voffB); PG8_STAGE(PG8_SA(0, 0), cA, voffA); PG8_STAGE(PG8_SA(0, 1), cA + hstep, voffA);
    if (wr == 1) PG8_BAR;
    PG8_WAIT_V(2); PG8_BAR;
    PG8_STAGE(PG8_SB(1, 0), cB + kstep, voffB); PG8_STAGE(PG8_SA(1, 0), cA + kstep, voffA); PG8_STAGE(PG8_SB(1, 1), cB + hstep + kstep, voffB);
    PG8_WAIT_V(6); PG8_BAR;
    for (;;) {
        const bool has_next = S.next(ui + 1, nxt);
        const char* nA = has_next ? (const char*)g.A + (size_t)nxt.pm * tstep : cA; const char* nB = has_next ? (const char*)g.Bt + (size_t)nxt.pn * tstep : cB;
        for (int t = 0; t < nt; t += 2) {
            const bool last = (t == nt - 2);
            const char* a1 = cA + (size_t)(t + 1) * kstep;
            const char* a2 = last ? nA : cA + (size_t)(t + 2) * kstep; const char* b2 = last ? nB : cB + (size_t)(t + 2) * kstep;
            const char* a3 = a2 + kstep; const char* b3 = b2 + kstep;
            PG8_LDB(B0, 0, 0); PG8_LDB(B1, 0, 1); PG8_SCHED; PG8_LDA(At, 0, 0); PG8_STAGE(PG8_SA(1, 1), a1 + hstep, voffA);
            PG8_WAIT_V(8); PG8_WAIT_L(0); PG8_BAR; PG8_MMA(0, 0, At, B0); PG8_MMA(0, 1, At, B1); PG8_BAR; PG8_SCHED;
            PG8_LDA(At, 0, 1); PG8_STAGE(PG8_SB(0, 0), b2, voffB); PG8_STAGE(PG8_SB(0, 1), b2 + hstep, voffB); PG8_STAGE(PG8_SA(0, 0), a2, voffA);
            PG8_WAIT_V(8); PG8_WAIT_L(0); PG8_BAR; PG8_MMA(1, 0, At, B0); PG8_MMA(1, 1, At, B1); PG8_BAR; PG8_SCHED;
            PG8_LDB(B0, 1, 0); PG8_LDB(B1, 1, 1); PG8_SCHED; PG8_LDA(At, 1, 0); PG8_STAGE(PG8_SA(0, 1), a2 + hstep, voffA);
            PG8_WAIT_V(8); PG8_WAIT_L(0); PG8_BAR; PG8_MMA(0, 0, At, B0); PG8_MMA(0, 1, At, B1); PG8_BAR; PG8_SCHED;
            PG8_LDA(At, 1, 1); PG8_STAGE(PG8_SB(1, 0), b3, voffB); PG8_STAGE(PG8_SB(1, 1), b3 + hstep, voffB); PG8_STAGE(PG8_SA(1, 0), a3, voffA);
            PG8_WAIT_V(8); PG8_WAIT_L(0); PG8_BAR; PG8_MMA(1, 0, At, B0); PG8_MMA(1, 1, At, B1); PG8_BAR; PG8_SCHED;
        }
        if (wr == 0) PG8_BAR;
        E(acc, cur, wr, wc, fr, fq);
        if (!has_next) break;
#pragma unroll
        for (int a = 0; a < 2; ++a)
#pragma unroll
            for (int b = 0; b < 2; ++b)
#pragma unroll
                for (int m = 0; m < 4; ++m)
#pragma unroll
                    for (int n = 0; n < 2; ++n) acc[a][b][m][n] = (f32x4){0.f, 0.f, 0.f, 0.f};
        cur = nxt; cA = nA; cB = nB; ++ui;
        if (wr == 1) PG8_BAR;
    }
    PG8_WAIT_V(0);
    PG8_BAR;
#undef PG8_SA
#undef PG8_SB
#undef PG8_STAGE
#undef PG8_LDA
#undef PG8_LDB
#undef PG8_MMA
#undef PG8_WAIT_V
#undef PG8_WAIT_L
#undef PG8_BAR
#undef PG8_SCHED
}
struct EpiProj {
    static constexpr bool PERM = true;
    bf16_t* O; int ldc;
    __device__ __forceinline__ void operator()(const f32x4 (&acc)[2][2][4][2], const Unit& u, int wr, int wc, int fr, int fq) const {
        const int row0 = u.pm * BM + wr * 64 + fr, col0 = u.pn * BM + wc * 32 + 8 * fq;
#pragma unroll
        for (int ai = 0; ai < 2; ++ai)
#pragma unroll
            for (int m = 0; m < 4; ++m) { bf16_t* rowp = O + (size_t)(row0 + ai * HALF + m * 16) * ldc + col0;
#pragma unroll
                for (int bj = 0; bj < 2; ++bj) { const f32x4 v0 = acc[ai][bj][m][0], v1 = acc[ai][bj][m][1];
                    u32x4 w; w.x = cvt_pk_bf16_asm(v0[0], v0[1]); w.y = cvt_pk_bf16_asm(v0[2], v0[3]); w.z = cvt_pk_bf16_asm(v1[0], v1[1]); w.w = cvt_pk_bf16_asm(v1[2], v1[3]);
                    *(u32x4*)(rowp + bj * HALF) = w; } }
    }
};
struct EpiResid {
    static constexpr bool PERM = false;
    const float* base; float* C; int ldc;
    __device__ __forceinline__ void operator()(const f32x4 (&acc)[2][2][4][2], const Unit& u, int wr, int wc, int fr, int fq) const {
        const int row0 = u.pm * BM + wr * 64 + fr, col0 = u.pn * BM + wc * 32 + 4 * fq;
#pragma unroll
        for (int ai = 0; ai < 2; ++ai)
#pragma unroll
            for (int m = 0; m < 4; ++m) { const size_t off = (size_t)(row0 + ai * HALF + m * 16) * ldc + col0;
#pragma unroll
                for (int bj = 0; bj < 2; ++bj)
#pragma unroll
                    for (int n = 0; n < 2; ++n) { const f32x4 bs = *(const f32x4*)(base + off + bj * HALF + n * 16); *(f32x4*)(C + off + bj * HALF + n * 16) = bs + acc[ai][bj][m][n]; } }
    }
};
struct EpiSwiglu {
    static constexpr bool PERM = true;
    bf16_t* O;
    __device__ __forceinline__ void operator()(const f32x4 (&acc)[2][2][4][2], const Unit& u, int wr, int wc, int fr, int fq) const {
        const int row0 = u.pm * BM + wr * 64 + fr, col0 = (u.pn & 15) * HALF + wc * 32 + 8 * fq;
#pragma unroll
        for (int ai = 0; ai < 2; ++ai)
#pragma unroll
            for (int m = 0; m < 4; ++m) { bf16_t* rowp = O + (size_t)(row0 + ai * HALF + m * 16) * FF + col0;
                float h[8];
#pragma unroll
                for (int n = 0; n < 2; ++n)
#pragma unroll
                    for (int j = 0; j < 4; ++j) { const float gt = acc[ai][0][m][n][j], up = acc[ai][1][m][n][j]; h[4 * n + j] = silu_f(gt) * up; }
                u32x4 w; w.x = cvt_pk_bf16_asm(h[0], h[1]); w.y = cvt_pk_bf16_asm(h[2], h[3]); w.z = cvt_pk_bf16_asm(h[4], h[5]); w.w = cvt_pk_bf16_asm(h[6], h[7]);
                *(u32x4*)rowp = w; }
    }
};
struct EpiDown {
    static constexpr bool PERM = true;
    bf16_t* O; const float* gate;
    __device__ __forceinline__ void operator()(const f32x4 (&acc)[2][2][4][2], const Unit& u, int wr, int wc, int fr, int fq) const {
        const int row0 = u.pm * BM + wr * 64 + fr, col0 = (u.pn & 3) * BM + wc * 32 + 8 * fq;
#pragma unroll
        for (int ai = 0; ai < 2; ++ai)
#pragma unroll
            for (int m = 0; m < 4; ++m) { const int row = row0 + ai * HALF + m * 16; const float gv = gate[row]; bf16_t* rowp = O + (size_t)row * D + col0;
#pragma unroll
                for (int bj = 0; bj < 2; ++bj) { const f32x4 v0 = acc[ai][bj][m][0] * gv, v1 = acc[ai][bj][m][1] * gv;
                    u32x4 w; w.x = cvt_pk_bf16_asm(v0[0], v0[1]); w.y = cvt_pk_bf16_asm(v0[2], v0[3]); w.z = cvt_pk_bf16_asm(v1[0], v1[1]); w.w = cvt_pk_bf16_asm(v1[2], v1[3]);
                    *(u32x4*)(rowp + bj * HALF) = w; } }
    }
};
}

__device__ __forceinline__ void transpose_item(const float* W, int ld, int k0, int n0, bf16_t* WT, size_t dst_row0, int ldt, LAS float* scr, int lane) {
#pragma unroll 8
    for (int i = 0; i < 32; ++i) { const int kk = 2 * i + (lane >> 5); scr[kk * 33 + (lane & 31)] = W[(size_t)(k0 + kk) * ld + n0 + (lane & 31)]; }
    asm volatile("s_waitcnt lgkmcnt(0)" ::: "memory");
    const int c = lane & 7;
#pragma unroll
    for (int j = 0; j < 4; ++j) { const int n = (lane >> 3) + 8 * j; const LAS float* s = scr + (8 * c) * 33 + n;
        u32x4 o; o.x = cvt_pk_bf16(s[0 * 33], s[1 * 33]); o.y = cvt_pk_bf16(s[2 * 33], s[3 * 33]); o.z = cvt_pk_bf16(s[4 * 33], s[5 * 33]); o.w = cvt_pk_bf16(s[6 * 33], s[7 * 33]);
        *(u32x4*)(WT + (dst_row0 + n) * (size_t)ldt + k0 + 8 * c) = o; }
    asm volatile("s_waitcnt lgkmcnt(0)" ::: "memory");
}

template <int MODE>
__device__ __forceinline__ void row_pass(const Args& a, LAS unsigned char* lds) {
    const int tid = threadIdx.x, lane = tid & 63, wave = tid >> 6;
    LAS float* wsT = (LAS float*)lds;
    const float* src = MODE == 0 ? a.in[0] : a.out;
    const float* nw = MODE == 0 ? a.in[1] : a.in[12];
    const float* wsm = MODE == 0 ? a.in[2] + 2048 : a.in[13];
    const int ld = MODE == 0 ? INC : NE;
    bf16_t* dst = (bf16_t*)(a.ws + WS_XN);
    float* aux = (float*)(a.ws + (MODE == 0 ? WS_GATES : WS_PROBS));
    for (int idx = tid; idx < 16 * 1024; idx += NTHR) { const int k = idx >> 4, c = idx & 15; wsT[c * 1024 + k] = wsm[(size_t)k * ld + c]; }
    __syncthreads();
    const f32x4* nw4 = (const f32x4*)nw + lane;
    f32x4 w4[4];
#pragma unroll
    for (int j = 0; j < 4; ++j) w4[j] = nw4[64 * j];
    const int c = lane >> 2;
    float alog = 0.f, dtb = 0.f;
    if (MODE == 0) { const int h = c & 3; if (c < 4) { alog = a.in[4][h]; dtb = a.in[5][h]; } else if (c >= 8 && c < 12) { alog = a.in[6][h]; dtb = a.in[7][h]; } }
    const int gw = blockIdx.x * NWAVE + wave, NGW = gridDim.x * NWAVE;
    for (int row = gw; row < MTOK; row += NGW) {
        const f32x4* xr = (const f32x4*)(src + (size_t)row * D) + lane;
        f32x4 v[4]; float ss = 0.f;
#pragma unroll
        for (int j = 0; j < 4; ++j) { v[j] = xr[64 * j]; ss += (v[j].x * v[j].x + v[j].y * v[j].y) + (v[j].z * v[j].z + v[j].w * v[j].w); }
        const float r = rsqrtf(wave_sum(ss) * (1.f / D) + EPS);
        u32x2* o8 = (u32x2*)(dst + (size_t)row * D) + lane;
#pragma unroll
        for (int j = 0; j < 4; ++j) { v[j] = v[j] * r * w4[j]; u32x2 w; w.x = cvt_pk_bf16(v[j].x, v[j].y); w.y = cvt_pk_bf16(v[j].z, v[j].w); o8[64 * j] = w; }
        float acc[16];
#pragma unroll
        for (int cc = 0; cc < 16; ++cc) { float s = 0.f;
#pragma unroll
            for (int j = 0; j < 4; ++j) { const f32x4 wv = *(const LAS f32x4*)(wsT + cc * 1024 + 4 * lane + 256 * j); s += (v[j].x * wv.x + v[j].y * wv.y) + (v[j].z * wv.z + v[j].w * wv.w); }
            acc[cc] = s; if ((cc & 3) == 3) asm volatile("" ::: "memory"); }
#pragma unroll
        for (int i = 0; i < 8; ++i) { const bool hi = lane & 32; const float send = hi ? acc[i] : acc[i + 8], keep = hi ? acc[i + 8] : acc[i]; acc[i] = keep + __shfl_xor(send, 32); }
#pragma unroll
        for (int i = 0; i < 4; ++i) { const bool hi = lane & 16; const float send = hi ? acc[i] : acc[i + 4], keep = hi ? acc[i + 4] : acc[i]; acc[i] = keep + __shfl_xor(send, 16); }
#pragma unroll
        for (int i = 0; i < 2; ++i) { const bool hi = lane & 8; const float send = hi ? acc[i] : acc[i + 2], keep = hi ? acc[i + 2] : acc[i]; acc[i] = keep + __shfl_xor(send, 8); }
        { const bool hi = lane & 4; const float send = hi ? acc[0] : acc[1], keep = hi ? acc[1] : acc[0]; acc[0] = keep + __shfl_xor(send, 4); }
        float s = acc[0]; s += __shfl_xor(s, 1); s += __shfl_xor(s, 2);
        float res;
        if (MODE == 0) {
            if (c < 4 || (c >= 8 && c < 12)) res = -__expf(alog) * softplus_f(s + dtb); else res = sigmoid_f(s);
        } else {
            float mx = s;
#pragma unroll
            for (int o = 4; o < 64; o <<= 1) mx = fmaxf(mx, __shfl_xor(mx, o));
            const float e = __expf(s - mx); float sm = e;
#pragma unroll
            for (int o = 4; o < 64; o <<= 1) sm += __shfl_xor(sm, o);
            res = e / sm;
        }
        if ((lane & 3) == 0) aux[(size_t)row * 16 + c] = res;
    }
}

__device__ __forceinline__ void ph_prologue(const Args& a, LAS unsigned char* lds) {
    const int tid = threadIdx.x, lane = tid & 63, wave = tid >> 6;
    LAS float* scr = (LAS float*)(lds + wave * 8704);
    const int gw = blockIdx.x * NWAVE + wave, NGW = gridDim.x * NWAVE;
    bf16_t* Win = (bf16_t*)(a.ws + WS_WIN); bf16_t* Wmix = (bf16_t*)(a.ws + WS_WMIX);
    constexpr int I_A = 16 * 64, I_B = 16 * 16, I_C = 8 * 32;
    for (int it = gw; it < I_A + I_B + I_C; it += NGW) {
        int r = it;
        if (r < I_A) { const int kb = r / 64, nb = r % 64; transpose_item(a.in[2], INC, 64 * kb, 32 * nb, Win, (size_t)32 * nb, D, scr, lane); continue; } r -= I_A;
        if (r < I_B) { const int kb = r / 16, nb = r % 16; transpose_item(a.in[2] + 2064, INC, 64 * kb, 32 * nb, Win, (size_t)2048 + 32 * nb, D, scr, lane); continue; } r -= I_B;
        { const int kb = r / 32, nb = r % 32; transpose_item(a.in[11], D, 64 * kb, 32 * nb, Wmix, (size_t)32 * nb, D, scr, lane); }
    }
    __syncthreads();
    for (int task = blockIdx.x; task < 64; task += gridDim.x) {
        const int g = task >> 4, n0 = (task & 15) * 64;
        LAS float* Wsc = (LAS float*)lds;
        LAS float* Pw = (LAS float*)(lds + 32768);
        for (int idx = tid; idx < 128 * 64; idx += NTHR) { const int d = idx >> 6, n = idx & 63; Wsc[idx] = a.in[11][(size_t)(512 + 128 * g + d) * D + n0 + n] * a.in[10][128 * g + d]; }
        for (int idx = tid; idx < 128 * 128; idx += NTHR) Pw[idx] = a.in[9][(size_t)g * 16384 + idx];
        __syncthreads();
        const int n = tid & 63, cg = tid >> 6;
        float accv[16];
#pragma unroll
        for (int j = 0; j < 16; ++j) accv[j] = 0.f;
        for (int d = 0; d < 128; ++d) { const float w = Wsc[d * 64 + n];
#pragma unroll
            for (int j = 0; j < 16; ++j) accv[j] += Pw[(cg * 16 + j) * 128 + d] * w; }
        bf16_t* dstp = Wmix + (size_t)(n0 + n) * D + 512 + 128 * g + cg * 16;
        u32x4 o0, o1;
        o0.x = cvt_pk_bf16(accv[0], accv[1]); o0.y = cvt_pk_bf16(accv[2], accv[3]); o0.z = cvt_pk_bf16(accv[4], accv[5]); o0.w = cvt_pk_bf16(accv[6], accv[7]);
        o1.x = cvt_pk_bf16(accv[8], accv[9]); o1.y = cvt_pk_bf16(accv[10], accv[11]); o1.z = cvt_pk_bf16(accv[12], accv[13]); o1.w = cvt_pk_bf16(accv[14], accv[15]);
        *(u32x4*)dstp = o0; *(u32x4*)(dstp + 8) = o1;
        __syncthreads();
    }
    __syncthreads();
    row_pass<0>(a, lds);
}

__device__ __forceinline__ void expert_weight_cvt(const Args& a, LAS unsigned char* lds) {
    const int tid = threadIdx.x, lane = tid & 63, wave = tid >> 6;
    LAS float* scr = (LAS float*)(lds + wave * 8704);
    const int gw = blockIdx.x * NWAVE + wave, NGW = gridDim.x * NWAVE;
    bf16_t* Wgu = (bf16_t*)(a.ws + WS_WGU); bf16_t* Wd = (bf16_t*)(a.ws + WS_WD);
    for (int it = gw; it < NE * 3072; it += NGW) {
        const int e = it / 3072, r = it % 3072, which = r >> 10, q = r & 1023;
        if (which < 2) { const int kb = q >> 6, nb = q & 63, f0 = 32 * nb;
            const float* W = (which == 0 ? a.in[14] : a.in[15]) + (size_t)e * D * FF;
            transpose_item(W, FF, 64 * kb, f0, Wgu, (size_t)e * 4096 + (f0 >> 7) * 256 + which * 128 + (f0 & 127), D, scr, lane);
        } else { const int kb = q >> 5, nb = q & 31;
            transpose_item(a.in[16] + (size_t)e * FF * D, D, 64 * kb, 32 * nb, Wd, (size_t)e * 1024 + 32 * nb, FF, scr, lane); }
    }
}

__device__ __forceinline__ int a128(int row, int col) { return row * 256 + ((((col >> 3) ^ (row & 15))) << 4) + ((col & 7) << 1); }
__device__ __forceinline__ int a64(int row, int col) { return row * 128 + ((((col >> 3) ^ ((row >> 1) & 7))) << 4) + ((col & 7) << 1); }
__device__ __forceinline__ bf16x8 frag128(LAS unsigned char* base, int row0, int k0, int lane) { return *(const LAS bf16x8*)(base + a128(row0 + (lane & 15), k0 + ((lane >> 4) << 3))); }
__device__ __forceinline__ bf16x8 frag64(LAS unsigned char* base, int row0, int k0, int lane) { return *(const LAS bf16x8*)(base + a64(row0 + (lane & 15), k0 + ((lane >> 4) << 3))); }
#define MFMA16(A, B, C) __builtin_amdgcn_mfma_f32_16x16x32_bf16(A, B, C, 0, 0, 0)
__device__ __forceinline__ u32x2 pack4(f32x4 v) { u32x2 w; w.x = cvt_pk_bf16(v[0], v[1]); w.y = cvt_pk_bf16(v[2], v[3]); return w; }

constexpr int L_QM = 0, L_KM = 16384, L_KT = 32768, L_VT = 49152, L_KET = 65536, L_P = 81920, L_PT = 90112, L_T = 98304, L_PQ = 106496, L_WT = 114688, L_UT = 131072, L_SM = 147456;
__device__ __forceinline__ void ph_chunk_prep(const Args& a, LAS unsigned char* lds) {
    const int tid = threadIdx.x, lane = tid & 63, wave = __builtin_amdgcn_readfirstlane(tid >> 6);
    const bf16_t* proj = (const bf16_t*)(a.ws + WS_PROJ);
    const float* gates = (const float*)(a.ws + WS_GATES);
    float* eglp = (float*)(a.ws + WS_EGL);
    LAS float* sm = (LAS float*)(lds + L_SM);
    const int l15 = lane & 15, l4 = lane >> 4;
    for (int task = blockIdx.x; task < NB * NH * NCH; task += gridDim.x) {
        const int n = task & 31, h = (task >> 5) & 3, b = task >> 7;
        const int tok0 = b * T + n * 64;
        if (wave == 0) {
            const float* gp = gates + (size_t)(tok0 + lane) * 16;
            const float gf = gp[h], bfv = gp[4 + h], gb = gp[8 + h], bbv = gp[12 + h];
            float pf = gf, pb = gb;
#pragma unroll
            for (int o = 1; o < 64; o <<= 1) { const float tf = __shfl_up(pf, o), tb = __shfl_up(pb, o); if (lane >= o) { pf += tf; pb += tb; } }
            const float totb = __shfl(pb, 63);
            sm[lane] = pf; sm[64 + lane] = totb - pb + gb; sm[128 + lane] = bfv; sm[192 + lane] = bbv;
        }
        {
            const int cch = tid & 15, rp = tid >> 4, i0 = 2 * rp;
#pragma unroll
            for (int mtx = 0; mtx < 3; ++mtx) {
                const int colb = mtx * 512 + h * HD + 8 * cch;
                float in[6][8];
#pragma unroll
                for (int jj = 0; jj < 6; ++jj) { const int tl = n * 64 + i0 - 2 + jj;
                    u32x4 w = (u32x4){0u, 0u, 0u, 0u};
                    if (tl >= 0 && tl < T) w = *(const u32x4*)(proj + (size_t)(b * T + tl) * NPROJ + colb);
                    in[jj][0] = bflo(w.x); in[jj][1] = bfhi(w.x); in[jj][2] = bflo(w.y); in[jj][3] = bfhi(w.y); in[jj][4] = bflo(w.z); in[jj][5] = bfhi(w.z); in[jj][6] = bflo(w.w); in[jj][7] = bfhi(w.w); }
                float val[2][8];
#pragma unroll
                for (int r = 0; r < 2; ++r)
#pragma unroll
                    for (int e = 0; e < 8; ++e) val[r][e] = 0.f;
#pragma unroll
                for (int j = 0; j < 5; ++j) { const f32x4 c0 = *(const f32x4*)(a.in[3] + (size_t)j * 1536 + colb), c1 = *(const f32x4*)(a.in[3] + (size_t)j * 1536 + colb + 4);
#pragma unroll
                    for (int r = 0; r < 2; ++r) {
#pragma unroll
                        for (int e = 0; e < 4; ++e) { val[r][e] += in[r + j][e] * c0[e]; val[r][4 + e] += in[r + j][4 + e] * c1[e]; } } }
#pragma unroll
                for (int r = 0; r < 2; ++r) { float ss = 0.f;
#pragma unroll
                    for (int e = 0; e < 8; ++e) { val[r][e] = silu_f(val[r][e]); ss += val[r][e] * val[r][e]; }
                    if (mtx < 2) { ss += __shfl_xor(ss, 1); ss += __shfl_xor(ss, 2); ss += __shfl_xor(ss, 4); ss += __shfl_xor(ss, 8);
                        const float sc = rsqrtf(ss + EPS) * (mtx == 0 ? 0.08838834764831845f : 1.f);
#pragma unroll
                        for (int e = 0; e < 8; ++e) val[r][e] *= sc; } }
                if (mtx < 2) {
#pragma unroll
                    for (int r = 0; r < 2; ++r) { u32x4 w; w.x = cvt_pk_bf16(val[r][0], val[r][1]); w.y = cvt_pk_bf16(val[r][2], val[r][3]); w.z = cvt_pk_bf16(val[r][4], val[r][5]); w.w = cvt_pk_bf16(val[r][6], val[r][7]);
                        *(LAS u32x4*)(lds + (mtx == 0 ? L_QM : L_KM) + a128(i0 + r, 8 * cch)) = w; } }
                if (mtx >= 1) {
#pragma unroll
                    for (int e = 0; e < 8; ++e) *(LAS unsigned*)(lds + (mtx == 1 ? L_KT : L_VT) + a64(8 * cch + e, i0)) = cvt_pk_bf16(val[0][e], val[1][e]); }
            }
        }
        __syncthreads();
        for (int dir = 0; dir < 2; ++dir) {
            LAS float* gc = sm + 64 * dir; LAS float* bet = sm + 128 + 64 * dir;
            const float gl = dir ? gc[0] : gc[63];
            { const int d = tid >> 2, ib = (tid & 3) * 16;
#pragma unroll
                for (int cpart = 0; cpart < 2; ++cpart) { const int i = ib + 8 * cpart; const u32x4 w = *(const LAS u32x4*)(lds + L_KT + a64(d, i));
                    float f[8] = {bflo(w.x), bfhi(w.x), bflo(w.y), bfhi(w.y), bflo(w.z), bfhi(w.z), bflo(w.w), bfhi(w.w)};
#pragma unroll
                    for (int e = 0; e < 8; ++e) f[e] *= __expf(gl - gc[i + e]);
                    u32x4 o; o.x = cvt_pk_bf16(f[0], f[1]); o.y = cvt_pk_bf16(f[2], f[3]); o.z = cvt_pk_bf16(f[4], f[5]); o.w = cvt_pk_bf16(f[6], f[7]);
                    *(LAS u32x4*)(lds + L_KET + a64(d, i)) = o; } }
            const int tn = wave & 3, tm0 = 2 * (wave >> 2);
            const int ra = 16 * tn + l15;
            f32x4 Tacc[2];
            {
                f32x4 kk[2] = {(f32x4){0, 0, 0, 0}, (f32x4){0, 0, 0, 0}}, qk[2] = {(f32x4){0, 0, 0, 0}, (f32x4){0, 0, 0, 0}};
#pragma unroll
                for (int ks = 0; ks < 4; ++ks) { const bf16x8 yk = frag128(lds + L_KM, 16 * tn, 32 * ks, lane), yq = frag128(lds + L_QM, 16 * tn, 32 * ks, lane);
#pragma unroll
                    for (int t2 = 0; t2 < 2; ++t2) { const bf16x8 xk = frag128(lds + L_KM, 16 * (tm0 + t2), 32 * ks, lane);
                        kk[t2] = MFMA16(xk, yk, kk[t2]); qk[t2] = MFMA16(xk, yq, qk[t2]); } }
                const float gca = gc[ra], ba = bet[ra];
#pragma unroll
                for (int t2 = 0; t2 < 2; ++t2) { const int rb0 = 16 * (tm0 + t2) + 4 * l4;
                    f32x4 pv, ptv, pqv;
#pragma unroll
                    for (int r = 0; r < 4; ++r) { const int rb = rb0 + r; const float gcb = gc[rb], bb = bet[rb];
                        const bool st_ab = dir ? (rb > ra) : (rb < ra), st_ba = dir ? (ra > rb) : (ra < rb), in_ab = st_ab || (rb == ra);
                        const float dab = __expf(fminf(gca - gcb, 0.f)), dba = __expf(fminf(gcb - gca, 0.f));
                        pv[r] = st_ab ? ba * kk[t2][r] * dab : 0.f;
                        ptv[r] = st_ba ? bb * kk[t2][r] * dba : 0.f;
                        pqv[r] = in_ab ? qk[t2][r] * dab : 0.f;
                        Tacc[t2][r] = (rb == ra ? 1.f : 0.f) - pv[r]; }
                    *(LAS u32x2*)(lds + L_P + a64(ra, rb0)) = pack4(pv);
                    *(LAS u32x2*)(lds + L_PT + a64(ra, rb0)) = pack4(ptv);
                    *(LAS u32x2*)(lds + L_PQ + a64(ra, rb0)) = pack4(pqv);
                    *(LAS u32x2*)(lds + L_T + a64(ra, rb0)) = pack4(Tacc[t2]); }
            }
            __syncthreads();
#pragma unroll 1
            for (int s = 0; s < 6; ++s) {
                bf16x8 xpt[2][2], xp[2][2], yp[2], ypt[2], yt[2];
#pragma unroll
                for (int ks = 0; ks < 2; ++ks) { yp[ks] = frag64(lds + L_P, 16 * tn, 32 * ks, lane); ypt[ks] = frag64(lds + L_PT, 16 * tn, 32 * ks, lane); yt[ks] = frag64(lds + L_T, 16 * tn, 32 * ks, lane);
#pragma unroll
                    for (int t2 = 0; t2 < 2; ++t2) { xpt[t2][ks] = frag64(lds + L_PT, 16 * (tm0 + t2), 32 * ks, lane); xp[t2][ks] = frag64(lds + L_P, 16 * (tm0 + t2), 32 * ks, lane); } }
                __syncthreads();
                f32x4 pn[2] = {(f32x4){0, 0, 0, 0}, (f32x4){0, 0, 0, 0}}, pnt[2] = {(f32x4){0, 0, 0, 0}, (f32x4){0, 0, 0, 0}};
#pragma unroll
                for (int t2 = 0; t2 < 2; ++t2)
#pragma unroll
                    for (int ks = 0; ks < 2; ++ks) {
                        if (s < 5) { pn[t2] = MFMA16(xpt[t2][ks], yp[ks], pn[t2]); pnt[t2] = MFMA16(xp[t2][ks], ypt[ks], pnt[t2]); }
                        if (s > 0) Tacc[t2] = MFMA16(xpt[t2][ks], yt[ks], Tacc[t2]); }
#pragma unroll
                for (int t2 = 0; t2 < 2; ++t2) { const int rb0 = 16 * (tm0 + t2) + 4 * l4;
                    if (s < 5) { *(LAS u32x2*)(lds + L_P + a64(ra, rb0)) = pack4(pn[t2]); *(LAS u32x2*)(lds + L_PT + a64(ra, rb0)) = pack4(pnt[t2]); }
                    if (s > 0 && s < 5) *(LAS u32x2*)(lds + L_T + a64(ra, rb0)) = pack4(Tacc[t2]); }
                __syncthreads();
            }
#pragma unroll
            for (int t2 = 0; t2 < 2; ++t2) { const int rb0 = 16 * (tm0 + t2) + 4 * l4; f32x4 tw, tu;
#pragma unroll
                for (int r = 0; r < 4; ++r) { const float bb = bet[rb0 + r]; tu[r] = Tacc[t2][r] * bb; tw[r] = tu[r] * __expf(gc[rb0 + r]); }
                *(LAS u32x2*)(lds + L_P + a64(ra, rb0)) = pack4(tw); *(LAS u32x2*)(lds + L_PT + a64(ra, rb0)) = pack4(tu); }
            __syncthreads();
            {
                f32x4 wa[4], ua[4];
#pragma unroll
                for (int t4 = 0; t4 < 4; ++t4) { wa[t4] = (f32x4){0, 0, 0, 0}; ua[t4] = (f32x4){0, 0, 0, 0}; }
#pragma unroll
                for (int ks = 0; ks < 2; ++ks) { const bf16x8 yk = frag64(lds + L_KT, 16 * wave, 32 * ks, lane), yv = frag64(lds + L_VT, 16 * wave, 32 * ks, lane);
#pragma unroll
                    for (int t4 = 0; t4 < 4; ++t4) { const bf16x8 xw = frag64(lds + L_P, 16 * t4, 32 * ks, lane), xu = frag64(lds + L_PT, 16 * t4, 32 * ks, lane);
                        wa[t4] = MFMA16(xw, yk, wa[t4]); ua[t4] = MFMA16(xu, yv, ua[t4]); } }
                const int rd = 16 * wave + l15;
#pragma unroll
                for (int t4 = 0; t4 < 4; ++t4) { *(LAS u32x2*)(lds + L_WT + a64(rd, 16 * t4 + 4 * l4)) = pack4(wa[t4]); *(LAS u32x2*)(lds + L_UT + a64(rd, 16 * t4 + 4 * l4)) = pack4(ua[t4]); }
            }
            __syncthreads();
            {
                const int cd = ((b * NH + h) * NCH + n) * 2 + dir;
                unsigned char* pb = a.ws + WS_PREP + (size_t)cd * PREP_STRIDE;
                if (tid == 0) eglp[cd] = __expf(gl);
                {
                    bf16x8 y[2]; y[0] = frag64(lds + L_KET, 16 * wave, 0, lane); y[1] = frag64(lds + L_KET, 16 * wave, 32, lane);
                    const int rd = 16 * wave + l15;
#pragma unroll
                    for (int t8 = 0; t8 < 8; ++t8) { f32x4 c = (f32x4){0, 0, 0, 0};
                        c = MFMA16(frag64(lds + L_WT, 16 * t8, 0, lane), y[0], c); c = MFMA16(frag64(lds + L_WT, 16 * t8, 32, lane), y[1], c);
                        *(u32x2*)(pb + (size_t)rd * 256 + (16 * t8 + 4 * l4) * 2) = pack4(-c); }
                }
                {
                    bf16x8 y[2]; y[0] = frag64(lds + L_UT, 16 * wave, 0, lane); y[1] = frag64(lds + L_UT, 16 * wave, 32, lane);
                    const int re = 16 * wave + l15;
#pragma unroll
                    for (int t8 = 0; t8 < 8; ++t8) { f32x4 c = (f32x4){0, 0, 0, 0};
                        c = MFMA16(frag64(lds + L_KET, 16 * t8, 0, lane), y[0], c); c = MFMA16(frag64(lds + L_KET, 16 * t8, 32, lane), y[1], c);
                        *(u32x2*)(pb + 32768 + (size_t)re * 256 + (16 * t8 + 4 * l4) * 2) = pack4(c); }
                }
                {
                    bf16x8 y[2]; y[0] = frag64(lds + L_PQ, 16 * tn, 0, lane); y[1] = frag64(lds + L_PQ, 16 * tn, 32, lane);
                    const float eg = __expf(gc[ra]);
#pragma unroll
                    for (int t4 = 0; t4 < 4; ++t4) { const int mt = 4 * (wave >> 2) + t4, c0 = 16 * mt + 4 * l4;
                        f32x4 cq = (f32x4){0, 0, 0, 0}, co = (f32x4){0, 0, 0, 0};
                        cq = MFMA16(frag64(lds + L_WT, 16 * mt, 0, lane), y[0], cq); cq = MFMA16(frag64(lds + L_WT, 16 * mt, 32, lane), y[1], cq);
                        co = MFMA16(frag64(lds + L_UT, 16 * mt, 0, lane), y[0], co); co = MFMA16(frag64(lds + L_UT, 16 * mt, 32, lane), y[1], co);
                        const u32x2 qw = *(const LAS u32x2*)(lds + L_QM + a128(ra, c0));
                        f32x4 qv; qv[0] = eg * bflo(qw.x) - cq[0]; qv[1] = eg * bfhi(qw.x) - cq[1]; qv[2] = eg * bflo(qw.y) - cq[2]; qv[3] = eg * bfhi(qw.y) - cq[3];
                        *(u32x2*)(pb + 65536 + (size_t)ra * 256 + c0 * 2) = pack4(qv);
                        *(u32x2*)(pb + 81920 + (size_t)ra * 256 + c0 * 2) = pack4(co); }
                }
            }
            __syncthreads();
        }
    }
}

__device__ __forceinline__ void ph_pool(const Args& a) {
    const bf16_t* proj = (const bf16_t*)(a.ws + WS_PROJ);
    bf16_t* amix = (bf16_t*)(a.ws + WS_AMIX);
    for (int it = blockIdx.x * NTHR + threadIdx.x; it < MTOK * 64; it += gridDim.x * NTHR) {
        const int tok = it >> 6, ch = it & 63, c0 = 8 * ch, g = c0 >> 7;
        const int w = 2 << g, lo = w >> 1, hi = w - lo - 1, tl = tok & (T - 1);
        const int s = max(tl - lo, 0), e = min(tl + hi + 1, T);
        float sum[8] = {0, 0, 0, 0, 0, 0, 0, 0};
        const bf16_t* base = proj + (size_t)(tok - tl) * NPROJ + 2048 + c0;
        for (int tt = s; tt < e; ++tt) { const u32x4 v = *(const u32x4*)(base + (size_t)tt * NPROJ);
            sum[0] += bflo(v.x); sum[1] += bfhi(v.x); sum[2] += bflo(v.y); sum[3] += bfhi(v.y); sum[4] += bflo(v.z); sum[5] += bfhi(v.z); sum[6] += bflo(v.w); sum[7] += bfhi(v.w); }
        const u32x4 v = *(const u32x4*)(base + (size_t)tl * NPROJ);
        const float inv = 1.f / (float)(e - s);
        u32x4 o; o.x = cvt_pk_bf16(sum[0] * inv - bflo(v.x), sum[1] * inv - bfhi(v.x)); o.y = cvt_pk_bf16(sum[2] * inv - bflo(v.y), sum[3] * inv - bfhi(v.y));
        o.z = cvt_pk_bf16(sum[4] * inv - bflo(v.z), sum[5] * inv - bfhi(v.z)); o.w = cvt_pk_bf16(sum[6] * inv - bflo(v.w), sum[7] * inv - bfhi(v.w));
        *(u32x4*)(amix + (size_t)tok * D + 512 + c0) = o;
    }
}

__device__ __forceinline__ void ph_scan(const Args& a, LAS unsigned char* lds) {
    const int tid = threadIdx.x, lane = tid & 63, wave = __builtin_amdgcn_readfirstlane(tid >> 6), l15 = lane & 15, l4 = lane >> 4;
    const float* eglp = (const float*)(a.ws + WS_EGL);
    for (int job = blockIdx.x; job < 256; job += gridDim.x) {
        const int x = job & 7, j = job >> 3, chain = x * 8 + (j >> 2), sl = j & 3, dir = chain & 1, bh = chain >> 1;
        f32x4 acc[2] = {(f32x4){0, 0, 0, 0}, (f32x4){0, 0, 0, 0}};
        __syncthreads();
        for (int step = 0; step < NCH; ++step) {
            const int n = dir ? NCH - 1 - step : step, cd = (bh * NCH + n) * 2 + dir, cur = step & 1;
            const unsigned char* pb = a.ws + WS_PREP + (size_t)cd * PREP_STRIDE;
            unsigned char* sg = a.ws + WS_S + (size_t)cd * 32768;
#pragma unroll
            for (int et = 0; et < 2; ++et) { const u32x2 w = pack4(acc[et]); const int el = 16 * et + l15, d0 = 16 * wave + 4 * l4;
                *(LAS u32x2*)(lds + cur * 8192 + a128(el, d0)) = w; *(u32x2*)(sg + (size_t)(32 * sl + el) * 256 + d0 * 2) = w; }
            bf16x8 xm[4];
#pragma unroll
            for (int ks = 0; ks < 4; ++ks) xm[ks] = *(const bf16x8*)(pb + (size_t)(16 * wave + l15) * 256 + (32 * ks + 8 * l4) * 2);
            u32x2 cw[2];
#pragma unroll
            for (int et = 0; et < 2; ++et) cw[et] = *(const u32x2*)(pb + 32768 + (size_t)(32 * sl + 16 * et + l15) * 256 + (16 * wave + 4 * l4) * 2);
            const float egl = eglp[cd];
            __syncthreads();
#pragma unroll
            for (int et = 0; et < 2; ++et) {
                acc[et][0] = egl * acc[et][0] + bflo(cw[et].x); acc[et][1] = egl * acc[et][1] + bfhi(cw[et].x); acc[et][2] = egl * acc[et][2] + bflo(cw[et].y); acc[et][3] = egl * acc[et][3] + bfhi(cw[et].y);
#pragma unroll
                for (int ks = 0; ks < 4; ++ks) acc[et] = MFMA16(xm[ks], frag128(lds + cur * 8192, 16 * et, 32 * ks, lane), acc[et]); }
        }
    }
}

__device__ __forceinline__ void ph_delta_out(const Args& a, LAS unsigned char* lds) {
    const int tid = threadIdx.x, lane = tid & 63, wave = __builtin_amdgcn_readfirstlane(tid >> 6), l15 = lane & 15, l4 = lane >> 4;
    const bf16_t* proj = (const bf16_t*)(a.ws + WS_PROJ);
    bf16_t* amix = (bf16_t*)(a.ws + WS_AMIX);
    LAS float* red = (LAS float*)lds;
    const int tn = wave & 3, mh = wave >> 2, ri = 16 * tn + l15;
    for (int task = blockIdx.x; task < NB * NH * NCH; task += gridDim.x) {
        const int n = task & 31, h = (task >> 5) & 3, b = task >> 7;
        f32x4 acc[4];
#pragma unroll
        for (int t4 = 0; t4 < 4; ++t4) acc[t4] = (f32x4){0, 0, 0, 0};
#pragma unroll
        for (int dir = 0; dir < 2; ++dir) {
            const int cd = ((b * NH + h) * NCH + n) * 2 + dir;
            const unsigned char* pb = a.ws + WS_PREP + (size_t)cd * PREP_STRIDE;
            const unsigned char* sg = a.ws + WS_S + (size_t)cd * 32768;
#pragma unroll
            for (int ks = 0; ks < 4; ++ks) { const bf16x8 y = *(const bf16x8*)(pb + 65536 + (size_t)ri * 256 + (32 * ks + 8 * l4) * 2);
#pragma unroll
                for (int t4 = 0; t4 < 4; ++t4) { const bf16x8 xs = *(const bf16x8*)(sg + (size_t)(16 * (4 * mh + t4) + l15) * 256 + (32 * ks + 8 * l4) * 2);
                    acc[t4] = MFMA16(xs, y, acc[t4]); } }
#pragma unroll
            for (int t4 = 0; t4 < 4; ++t4) { const u32x2 ow = *(const u32x2*)(pb + 81920 + (size_t)ri * 256 + (16 * (4 * mh + t4) + 4 * l4) * 2);
                acc[t4][0] += bflo(ow.x); acc[t4][1] += bfhi(ow.x); acc[t4][2] += bflo(ow.y); acc[t4][3] += bfhi(ow.y); }
        }
        float ss = 0.f;
#pragma unroll
        for (int t4 = 0; t4 < 4; ++t4) ss += (acc[t4][0] * acc[t4][0] + acc[t4][1] * acc[t4][1]) + (acc[t4][2] * acc[t4][2] + acc[t4][3] * acc[t4][3]);
        ss += __shfl_xor(ss, 16); ss += __shfl_xor(ss, 32);
        __syncthreads();
        if (l4 == 0) red[mh * 64 + ri] = ss;
        __syncthreads();
        const float r = rsqrtf((red[ri] + red[64 + ri]) * (1.f / HD) + EPS);
        const int tok = b * T + n * 64 + ri;
#pragma unroll
        for (int t4 = 0; t4 < 4; ++t4) { const int e0 = 16 * (4 * mh + t4) + 4 * l4;
            const u32x2 zw = *(const u32x2*)(proj + (size_t)tok * NPROJ + 1536 + h * HD + e0);
            const f32x4 hw = *(const f32x4*)(a.in[8] + e0);
            f32x4 o; o[0] = acc[t4][0] * r * hw[0] * silu_f(bflo(zw.x)); o[1] = acc[t4][1] * r * hw[1] * silu_f(bfhi(zw.x)); o[2] = acc[t4][2] * r * hw[2] * silu_f(bflo(zw.y)); o[3] = acc[t4][3] * r * hw[3] * silu_f(bfhi(zw.y));
            *(u32x2*)(amix + (size_t)tok * D + h * HD + e0) = pack4(o); }
    }
}

__device__ __forceinline__ int block_sum(int v, LAS int* slot8, int wave, int lane) {
#pragma unroll
    for (int o = 1; o < 64; o <<= 1) v += __shfl_xor(v, o);
    if (lane == 0) slot8[wave] = v;
    __syncthreads();
    int s = 0;
#pragma unroll
    for (int w = 0; w < 8; ++w) s += slot8[w];
    return s;
}
__device__ __forceinline__ int block_excl_scan(int v, LAS int* slot8, int wave, int lane) {
    int inc = v;
#pragma unroll
    for (int o = 1; o < 64; o <<= 1) { const int t = __shfl_up(inc, o); if (lane >= o) inc += t; }
    if (lane == 63) slot8[wave] = inc;
    __syncthreads();
    int off = 0;
#pragma unroll
    for (int w = 0; w < 8; ++w) off += (w < wave) ? slot8[w] : 0;
    return off + inc - v;
}
__device__ __forceinline__ void ph_topk_gather(const Args& a, LAS unsigned char* lds) {
    const int tid = threadIdx.x, lane = tid & 63, wave = tid >> 6;
    const float* probs = (const float*)(a.ws + WS_PROBS);
    int* inv = (int*)(a.ws + WS_INV); int* seli = (int*)(a.ws + WS_SELI); float* selg = (float*)(a.ws + WS_SELG);
    const bf16_t* xn = (const bf16_t*)(a.ws + WS_XN); bf16_t* xg = (bf16_t*)(a.ws + WS_XG);
    LAS int* red = (LAS int*)lds;
    LAS int* lidx = (LAS int*)(lds + 4096);
    for (int job = blockIdx.x; job < 2 * NB * NE; job += gridDim.x) {
        const int be = job & 127, half = job >> 7, b = be >> 4, e = be & 15;
        unsigned v[4];
#pragma unroll
        for (int j = 0; j < 4; ++j) v[j] = __float_as_uint(probs[(size_t)(b * T + 4 * tid + j) * 16 + e]);
        __syncthreads();
        unsigned thr = 0u; int it = 0;
        for (int bit = 30; bit >= 0; --bit, ++it) { const unsigned cand = thr | (1u << bit);
            int c = 0;
#pragma unroll
            for (int j = 0; j < 4; ++j) c += (v[j] >= cand) ? 1 : 0;
            if (block_sum(c, red + 8 * it, wave, lane) >= CAP) thr = cand; }
        int cgt = 0, ceq = 0;
#pragma unroll
        for (int j = 0; j < 4; ++j) { cgt += (v[j] > thr) ? 1 : 0; ceq += (v[j] == thr) ? 1 : 0; }
        const int tot_gt = block_sum(cgt, red + 8 * 32, wave, lane);
        const int need_eq = CAP - tot_gt;
        const int eq_before = block_excl_scan(ceq, red + 8 * 33, wave, lane);
        int sel[4], nsel = 0, eqc = eq_before;
#pragma unroll
        for (int j = 0; j < 4; ++j) { const bool iseq = (v[j] == thr); sel[j] = (v[j] > thr) || (iseq && eqc < need_eq); eqc += iseq ? 1 : 0; nsel += sel[j]; }
        int slot = block_excl_scan(nsel, red + 8 * 34, wave, lane);
#pragma unroll
        for (int j = 0; j < 4; ++j) { const int t = 4 * tid + j;
            if (sel[j]) { lidx[slot] = t; if (half == 0) { seli[be * CAP + slot] = t; selg[be * CAP + slot] = __uint_as_float(v[j]); } }
            if (half == 0) inv[(size_t)(b * T + t) * 16 + e] = sel[j] ? slot : -1;
            slot += sel[j]; }
        __syncthreads();
        for (int rr = wave; rr < 128; rr += NWAVE) { const int sl = half * 128 + rr, t = lidx[sl];
            const u32x4* srcp = (const u32x4*)(xn + (size_t)(b * T + t) * D) + lane; u32x4* dstp = (u32x4*)(xg + (size_t)(be * CAP + sl) * D) + lane;
            dstp[0] = srcp[0]; dstp[64] = srcp[64]; }
        __syncthreads();
    }
}

__device__ __forceinline__ void ph_final(const Args& a, bool with_ffn) {
    const int tid = threadIdx.x, lane = tid & 63, wave = tid >> 6;
    const int* inv = (const int*)(a.ws + WS_INV); const bf16_t* y = (const bf16_t*)(a.ws + WS_Y);
    const f32x4* nw4 = (const f32x4*)a.in[17] + lane;
    f32x4 w4[4];
#pragma unroll
    for (int j = 0; j < 4; ++j) w4[j] = nw4[64 * j];
    const int gw = blockIdx.x * NWAVE + wave, NGW = gridDim.x * NWAVE;
    for (int row = gw; row < MTOK; row += NGW) {
        f32x4* xr = (f32x4*)(a.out + (size_t)row * D) + lane;
        f32x4 v[4];
#pragma unroll
        for (int j = 0; j < 4; ++j) v[j] = xr[64 * j];
        if (with_ffn) {
            const int b = row >> 11;
            for (int e = 0; e < NE; ++e) { const int s = inv[(size_t)row * 16 + e];
                if (s >= 0) { const u32x2* yr = (const u32x2*)(y + (size_t)((b * NE + e) * CAP + s) * D) + lane;
#pragma unroll
                    for (int j = 0; j < 4; ++j) { const u32x2 w = yr[64 * j]; v[j].x += bflo(w.x); v[j].y += bfhi(w.x); v[j].z += bflo(w.y); v[j].w += bfhi(w.y); } } }
        }
        float ss = 0.f;
#pragma unroll
        for (int j = 0; j < 4; ++j) ss += (v[j].x * v[j].x + v[j].y * v[j].y) + (v[j].z * v[j].z + v[j].w * v[j].w);
        const float r = rsqrtf(wave_sum(ss) * (1.f / D) + EPS);
#pragma unroll
        for (int j = 0; j < 4; ++j) xr[64 * j] = v[j] * r * w4[j];
    }
}

#ifndef DBG_STAGE
#define DBG_STAGE 3
#endif
template <int LO, int HI>
__global__ void __launch_bounds__(NTHR, 2) fwd_kernel(Args a) {
    extern __shared__ __attribute__((aligned(16))) unsigned char lds_raw[];
    LAS unsigned char* lds = (LAS unsigned char*)lds_raw;
#define IN(k) (LO <= (k) && (k) < HI)
    if constexpr (IN(0)) ph_prologue(a, lds);
    if constexpr (IN(1)) { pg8::Gemm g{(const bf16_t*)(a.ws + WS_XN), (const bf16_t*)(a.ws + WS_WIN), D}; pg8::StaticOrder S; S.init(MTOK, NPROJ, gridDim.x, blockIdx.x);
        pg8::EpiProj E{(bf16_t*)(a.ws + WS_PROJ), NPROJ}; pg8::gemm_phase(lds, g, S, E); }
    if constexpr (IN(2)) { ph_pool(a); if (DBG_STAGE >= 2) ph_chunk_prep(a, lds); }
    if constexpr (IN(3)) { if (DBG_STAGE >= 2) ph_scan(a, lds); }
    if constexpr (IN(4)) { if (DBG_STAGE >= 2) ph_delta_out(a, lds); }
    if constexpr (IN(5)) { pg8::Gemm g{(const bf16_t*)(a.ws + WS_AMIX), (const bf16_t*)(a.ws + WS_WMIX), D}; pg8::StaticOrder S; S.init(MTOK, D, gridDim.x, blockIdx.x);
        pg8::EpiResid E{a.in[0], a.out, D}; pg8::gemm_phase(lds, g, S, E);
        if (DBG_STAGE >= 3) expert_weight_cvt(a, lds); }
    if constexpr (IN(6)) { if (DBG_STAGE >= 3) row_pass<1>(a, lds); }
    if constexpr (IN(7)) { if (DBG_STAGE >= 3) ph_topk_gather(a, lds); }
    if constexpr (IN(8)) { if (DBG_STAGE >= 3) { pg8::Gemm g{(const bf16_t*)(a.ws + WS_XG), (const bf16_t*)(a.ws + WS_WGU), D}; pg8::ExpertOrder S; S.init(blockIdx.x, 16);
        pg8::EpiSwiglu E{(bf16_t*)(a.ws + WS_HMID)}; pg8::gemm_phase(lds, g, S, E); } }
    if constexpr (IN(9)) { if (DBG_STAGE >= 3) { pg8::Gemm g{(const bf16_t*)(a.ws + WS_HMID), (const bf16_t*)(a.ws + WS_WD), FF}; pg8::ExpertOrder S; S.init(blockIdx.x, 4);
        pg8::EpiDown E{(bf16_t*)(a.ws + WS_Y), (const float*)(a.ws + WS_SELG)}; pg8::gemm_phase(lds, g, S, E); } }
    if constexpr (IN(10)) ph_final(a, DBG_STAGE >= 3);
#undef IN
}
template <int P> static void launch_phase(const Args& a, hipStream_t stream) {
    static bool attr = false;
    if (!attr) { (void)hipFuncSetAttribute((const void*)fwd_kernel<P, P + 1>, hipFuncAttributeMaxDynamicSharedMemorySize, LDS_BYTES); attr = true; }
    hipLaunchKernelGGL((fwd_kernel<P, P + 1>), dim3(NBLK), dim3(NTHR), LDS_BYTES, stream, a);
}

extern "C" void kernel_launch(void* const* d_in, const int* in_sizes, int n_in, void* d_out, int out_size, void* d_ws, size_t ws_size, hipStream_t stream) {
    if (n_in != 18 || out_size != MTOK * D || ws_size < WS_END) { fprintf(stderr, "kernel_launch: unexpected shapes (n_in %d out %d ws %zu)\n", n_in, out_size, ws_size); return; }
    Args a{};
    for (int i = 0; i < 18; ++i) a.in[i] = (const float*)d_in[i];
    a.out = (float*)d_out; a.ws = (unsigned char*)d_ws;
    if (DBG_STAGE < 2) (void)hipMemsetAsync((char*)d_ws + WS_AMIX, 0, 32 * MiB, stream);
    launch_phase<0>(a, stream); launch_phase<1>(a, stream); launch_phase<2>(a, stream); launch_phase<3>(a, stream); launch_phase<4>(a, stream); launch_phase<5>(a, stream);
    launch_phase<6>(a, stream); launch_phase<7>(a, stream); launch_phase<8>(a, stream); launch_phase<9>(a, stream); launch_phase<10>(a, stream);
}
```

```cpp
#include <hip/hip_runtime.h>
#include <hip/hip_cooperative_groups.h>
#include <cstdio>
#include <cstdint>

#define LAS __attribute__((address_space(3)))
#define GAS __attribute__((address_space(1)))
typedef unsigned short bf16_t;
typedef short bf16x8 __attribute__((ext_vector_type(8)));
typedef float f32x4 __attribute__((ext_vector_type(4)));
typedef float f32x2 __attribute__((ext_vector_type(2)));
typedef unsigned u32x4 __attribute__((ext_vector_type(4)));
typedef unsigned u32x2 __attribute__((ext_vector_type(2)));

constexpr int NB = 8, T = 2048, D = 1024, MTOK = NB * T;
constexpr int INC = 2576, NPROJ = 2560;
constexpr int NH = 4, HD = 128, NCH = T / 64;
constexpr int NE = 16, CAP = 256, FF = 2048;
constexpr float EPS = 1e-6f;
constexpr int NBLK = 256, NTHR = 512, NWAVE = 8;
constexpr int LDS_BYTES = 155648;

constexpr size_t MiB = (size_t)1 << 20;
constexpr size_t WS_CTL = 0;
constexpr size_t WS_WIN = 1 * MiB;
constexpr size_t WS_WMIX = 6 * MiB;
constexpr size_t WS_PREP = 8 * MiB;
constexpr size_t WS_WGU = 8 * MiB;
constexpr size_t WS_WD = 136 * MiB;
constexpr size_t WS_XN = 200 * MiB;
constexpr size_t WS_AMIX = 232 * MiB;
constexpr size_t WS_Y = 200 * MiB;
constexpr size_t WS_GATES = 264 * MiB;
constexpr size_t WS_PROBS = 265 * MiB;
constexpr size_t WS_INV = 266 * MiB;
constexpr size_t WS_SELI = 267 * MiB;
constexpr size_t WS_SELG = 267 * MiB + 131072;
constexpr size_t WS_EGL = 267 * MiB + 262144;
constexpr size_t WS_PROJ = 268 * MiB;
constexpr size_t WS_XG = 268 * MiB;
constexpr size_t WS_OD = 348 * MiB;
constexpr size_t WS_HMID = 332 * MiB;
constexpr size_t WS_WDA = 460 * MiB;
constexpr int NEARLY = 5;
constexpr size_t WS_END = 480 * MiB;
constexpr size_t PREP_STRIDE = 98304;

struct Args { const float* in[18]; float* out; unsigned char* ws; int ph_lo, ph_hi; };

typedef __bf16 bf16v2_t __attribute__((ext_vector_type(2)));
__device__ __forceinline__ unsigned cvt_pk_bf16_asm(float lo, float hi) { unsigned r; asm volatile("v_cvt_pk_bf16_f32 %0, %1, %2" : "=v"(r) : "v"(lo), "v"(hi)); return r; }
__device__ __forceinline__ unsigned cvt_pk_bf16(float lo, float hi) { f32x2 f = {lo, hi}; return __builtin_bit_cast(unsigned, __builtin_convertvector(f, bf16v2_t)); }
__device__ __forceinline__ float bf2f(unsigned h) { return __uint_as_float(h << 16); }
__device__ __forceinline__ float bflo(unsigned w) { return __uint_as_float(w << 16); }
__device__ __forceinline__ float bfhi(unsigned w) { return __uint_as_float(w & 0xffff0000u); }
__device__ __forceinline__ float wave_sum(float v) {
#pragma unroll
    for (int o = 1; o < 64; o <<= 1) v += __shfl_xor(v, o);
    return v;
}
__device__ __forceinline__ int tid_fresh() { int t = threadIdx.x; asm volatile("" : "+v"(t)); return t; }
__device__ __forceinline__ float silu_f(float x) { return x * __builtin_amdgcn_rcpf(1.f + __expf(-x)); }
__device__ __forceinline__ float sigmoid_f(float x) { return __builtin_amdgcn_rcpf(1.f + __expf(-x)); }
__device__ __forceinline__ float softplus_f(float x) { return fmaxf(x, 0.f) + log1pf(__expf(-fabsf(x))); }

namespace pg8 {
constexpr int BM = 256, BK = 64, HALF = 128, HTB = HALF * BK * 2, STAGE_BYTES = 8 * HTB, NXCD = 8, WGM = 8;
__host__ __device__ __forceinline__ int lds_byte(int r, int c) { const int st = (r >> 4) * 2 + (c >> 5), rr = r & 15, cc = c & 31, ob = rr * 64 + cc * 2; return st * 1024 + (ob ^ (((ob >> 9) & 1) << 5)); }
__host__ __device__ __forceinline__ void stage_rc(int b, int& R, int& C) { const int st = b / 1024, sb = b % 1024, swz = sb ^ (((sb >> 9) & 1) << 5); R = (st >> 1) * 16 + swz / 64; C = (st & 1) * 32 + (swz % 64) / 2; }
__host__ __device__ __forceinline__ int perm32(int rho) { const int n = rho >> 4, i = rho & 15; return 8 * (i >> 2) + 4 * n + (i & 3); }

struct Unit { int pm, pn; };
struct Gemm { const bf16_t* A; const bf16_t* Bt; int K; const int* gidx; };

struct StaticOrder {
    int nM, nN, nwg, G, c;
    __device__ void init(int M, int N, int G_, int c_) { nM = M / BM; nN = N / BM; nwg = nM * nN; G = G_; c = c_; }
    __device__ int pm_of(int) const { return 0; }
    __device__ bool next(int i, Unit& u) const {
        const long L = (long)i * G + c; if (L >= nwg) return false;
        int wgid = (int)L; { const int q = nwg / NXCD, r = nwg % NXCD, xcd = wgid % NXCD, off = wgid / NXCD; wgid = (xcd < r ? xcd * (q + 1) : r * (q + 1) + (xcd - r) * q) + off; }
        const int nig = WGM * nN, gid = wgid / nig, fm = gid * WGM, gsz = (nM - fm) < WGM ? (nM - fm) : WGM;
        u.pm = fm + ((wgid % nig) % gsz); u.pn = (wgid % nig) / gsz; return true;
    }
};
struct ExpertOrder {
    int x, b, pnq, ntile, rounds, rpe, early, eshift;
    __device__ void init(int c, int ntile_, int early_ = 0, int eshift_ = 0) { x = c & 7; const int j = c >> 3; b = j & 7; pnq = j >> 3; ntile = ntile_; rpe = ntile_ >> 2; rounds = 2 * rpe; early = early_; eshift = eshift_; }
    __device__ bool next(int i, Unit& u) const { if (i >= rounds) return false; const int e = 2 * x + (i / rpe); u.pm = b * NE + e; u.pn = e * ntile + 4 * (i % rpe) + pnq + (e < early ? eshift : 0); return true; }
    __device__ int pm_of(int k) const { return b * NE + 2 * x + k; }
};

template <class Epi, class Sched, bool GATHER = false>
__device__ __forceinline__ void gemm_phase(LAS unsigned char* lds, const Gemm g, const Sched& S, const Epi& E) {
    const int tid = tid_fresh(), wid = __builtin_amdgcn_readfirstlane(tid >> 6), lane = tid & 63, wr = wid >> 2, wc = wid & 3, fr = lane & 15, fq = lane >> 4;
    const int K = g.K, nt = K / BK;
    unsigned voffA[2], voffB[2];
#pragma unroll
    for (int i = 0; i < 2; ++i) { int R, C; stage_rc(tid * 16 + i * 8192, R, C); const int Rb = Epi::PERM ? ((R & ~31) + perm32(R & 31)) : R;
        voffA[i] = (unsigned)(R * K + C) * 2u; voffB[i] = (unsigned)(Rb * K + C) * 2u; }
    const size_t kstep = (size_t)(BK * 2);
    const size_t hstep = (size_t)HALF * K * 2;
    const size_t tstep = 2 * hstep;
    const size_t tstepA = GATHER ? 0 : tstep;
    unsigned tab[2][2][2];
    const int pmB = S.pm_of(1);
    if constexpr (GATHER) {
#pragma unroll
        for (int ei = 0; ei < 2; ++ei)
#pragma unroll
            for (int hf = 0; hf < 2; ++hf)
#pragma unroll
                for (int i = 0; i < 2; ++i) { int R, C; stage_rc(tid * 16 + i * 8192, R, C); tab[ei][hf][i] = (unsigned)(g.gidx[S.pm_of(ei) * BM + hf * HALF + R] * K + C) * 2u; }
    }
#define PG8_STAGE_A(bufoff, gbase, hf, ei) do { if constexpr (GATHER) { unsigned v_[2]; v_[0] = (ei) ? tab[1][hf][0] : tab[0][hf][0]; v_[1] = (ei) ? tab[1][hf][1] : tab[0][hf][1]; PG8_STAGE(bufoff, gbase, v_); } \
        else { PG8_STAGE(bufoff, (gbase) + (hf) * hstep, voffA); } } while (0)
    const unsigned ldsw = (unsigned)wid * 1024u;
    const int aoff = lds_byte(wr * 64 + fr, fq * 8), boff = lds_byte(wc * 32 + fr, fq * 8);
#define PG8_SA(b, h) (((b) * 2 + (h)) * HTB)
#define PG8_SB(b, h) ((4 + (b) * 2 + (h)) * HTB)
#define PG8_STAGE(bufoff, gbase, voff) do { _Pragma("unroll") for (int _i = 0; _i < 2; ++_i) \
        __builtin_amdgcn_global_load_lds((const unsigned*)((const char*)(gbase) + (voff)[_i]), (LAS unsigned*)(lds + (bufoff) + ldsw + _i * 8192), 16, 0, 0); } while (0)
#define PG8_LDA(dst, b, h) do { _Pragma("unroll") for (int m = 0; m < 4; ++m) _Pragma("unroll") for (int k = 0; k < 2; ++k) dst[m][k] = *(const LAS bf16x8*)(lds + PG8_SA(b, h) + aoff + m * 2048 + k * 1024); } while (0)
#define PG8_LDB(dst, b, h) do { _Pragma("unroll") for (int n = 0; n < 2; ++n) _Pragma("unroll") for (int k = 0; k < 2; ++k) dst[n][k] = *(const LAS bf16x8*)(lds + PG8_SB(b, h) + boff + n * 2048 + k * 1024); } while (0)
#define PG8_MMA(ai, bj, At, Bt) do { __builtin_amdgcn_s_setprio(1); _Pragma("unroll") for (int m = 0; m < 4; ++m) _Pragma("unroll") for (int n = 0; n < 2; ++n) _Pragma("unroll") for (int k = 0; k < 2; ++k) \
        acc[ai][bj][m][n] = __builtin_amdgcn_mfma_f32_16x16x32_bf16(Bt[n][k], At[m][k], acc[ai][bj][m][n], 0, 0, 0); __builtin_amdgcn_s_setprio(0); } while (0)
#define PG8_WAIT_V(n) asm volatile("s_waitcnt vmcnt(" #n ")" ::: "memory")
#define PG8_WAIT_L(n) asm volatile("s_waitcnt lgkmcnt(" #n ")" ::: "memory")
#define PG8_BAR __builtin_amdgcn_s_barrier()
#define PG8_SCHED __builtin_amdgcn_sched_barrier(0)
    Unit cur, nxt; int ui = 0;
    if (!S.next(0, cur)) return;
    f32x4 acc[2][2][4][2];
#pragma unroll
    for (int a = 0; a < 2; ++a)
#pragma unroll
        for (int b = 0; b < 2; ++b)
#pragma unroll
            for (int m = 0; m < 4; ++m)
#pragma unroll
                for (int n = 0; n < 2; ++n) acc[a][b][m][n] = (f32x4){0.f, 0.f, 0.f, 0.f};
    bf16x8 At[4][2], B0[2][2], B1[2][2];
    const char* cA = (const char*)g.A + (size_t)cur.pm * tstepA; const char* cB = (const char*)g.Bt + (size_t)cur.pn * tstep;
    bool cur_ei = GATHER && cur.pm == pmB, nxt_ei = cur_ei;
    PG8_STAGE(PG8_SB(0, 0), cB, voffB); PG8_STAGE(PG8_SB(0, 1), cB + hstep, voffB); PG8_STAGE_A(PG8_SA(0, 0), cA, 0, cur_ei); PG8_STAGE_A(PG8_SA(0, 1), cA, 1, cur_ei);
    if (wr == 1) PG8_BAR;
    PG8_WAIT_V(2); PG8_BAR;
    PG8_STAGE(PG8_SB(1, 0), cB + kstep, voffB); PG8_STAGE_A(PG8_SA(1, 0), cA + kstep, 0, cur_ei); PG8_STAGE(PG8_SB(1, 1), cB + hstep + kstep, voffB);
    PG8_WAIT_V(6); PG8_BAR;
    for (;;) {
        const bool has_next = S.next(ui + 1, nxt);
        const char* nA = has_next ? (const char*)g.A + (size_t)nxt.pm * tstepA : cA; const char* nB = has_next ? (const char*)g.Bt + (size_t)nxt.pn * tstep : cB;
        nxt_ei = has_next ? (GATHER && nxt.pm == pmB) : cur_ei;
        for (int t = 0; t < nt; t += 2) {
            const bool last = (t == nt - 2);
            const char* a1 = cA + (size_t)(t + 1) * kstep;
            const char* a2 = last ? nA : cA + (size_t)(t + 2) * kstep; const char* b2 = last ? nB : cB + (size_t)(t + 2) * kstep;
            const char* a3 = a2 + kstep; const char* b3 = b2 + kstep;
            const bool e2 = last ? nxt_ei : cur_ei;
            PG8_LDB(B0, 0, 0); PG8_LDB(B1, 0, 1); PG8_SCHED; PG8_LDA(At, 0, 0); PG8_STAGE_A(PG8_SA(1, 1), a1, 1, cur_ei);
            PG8_WAIT_V(8); PG8_WAIT_L(0); PG8_BAR; PG8_MMA(0, 0, At, B0); PG8_MMA(0, 1, At, B1); PG8_BAR; PG8_SCHED;
            PG8_LDA(At, 0, 1); PG8_STAGE(PG8_SB(0, 0), b2, voffB); PG8_STAGE(PG8_SB(0, 1), b2 + hstep, voffB); PG8_STAGE_A(PG8_SA(0, 0), a2, 0, e2);
            PG8_WAIT_V(8); PG8_WAIT_L(0); PG8_BAR; PG8_MMA(1, 0, At, B0); PG8_MMA(1, 1, At, B1); PG8_BAR; PG8_SCHED;
            PG8_LDB(B0, 1, 0); PG8_LDB(B1, 1, 1); PG8_SCHED; PG8_LDA(At, 1, 0); PG8_STAGE_A(PG8_SA(0, 1), a2, 1, e2);
            PG8_WAIT_V(8); PG8_WAIT_L(0); PG8_BAR; PG8_MMA(0, 0, At, B0); PG8_MMA(0, 1, At, B1); PG8_BAR; PG8_SCHED;
            PG8_LDA(At, 1, 1); PG8_STAGE(PG8_SB(1, 0), b3, voffB); PG8_STAGE(PG8_SB(1, 1), b3 + hstep, voffB); PG8_STAGE_A(PG8_SA(1, 0), a3, 0, e2);
            PG8_WAIT_V(8); PG8_WAIT_L(0); PG8_BAR; PG8_MMA(1, 0, At, B0); PG8_MMA(1, 1, At, B1); PG8_BAR; PG8_SCHED;
        }
        if (wr == 0) PG8_BAR;
        E(acc, cur, wr, wc, fr, fq);
        if (!has_next) break;
#pragma unroll
        for (int a = 0; a < 2; ++a)
#pragma unroll
            for (int b = 0; b < 2; ++b)
#pragma unroll
                for (int m = 0; m < 4; ++m)
#pragma unroll
                    for (int n = 0; n < 2; ++n) acc[a][b][m][n] = (f32x4){0.f, 0.f, 0.f, 0.f};
        cur = nxt; cA = nA; cB = nB; cur_ei = nxt_ei; ++ui;
        if (wr == 1) PG8_BAR;
    }
    PG8_WAIT_V(0);
    PG8_BAR;
#undef PG8_SA
#undef PG8_SB
#undef PG8_STAGE
#undef PG8_STAGE_A
#undef PG8_LDA
#undef PG8_LDB
#undef PG8_MMA
#undef PG8_WAIT_V
#undef PG8_WAIT_L
#undef PG8_BAR
#undef PG8_SCHED
}
struct EpiProj {
    static constexpr bool PERM = true;
    bf16_t* O; int ldc;
    __device__ __forceinline__ void operator()(const f32x4 (&acc)[2][2][4][2], const Unit& u, int wr, int wc, int fr, int fq) const {
        const int row0 = u.pm * BM + wr * 64 + fr, col0 = u.pn * BM + wc * 32 + 8 * fq;
#pragma unroll
        for (int ai = 0; ai < 2; ++ai)
#pragma unroll
            for (int m = 0; m < 4; ++m) { bf16_t* rowp = O + (size_t)(row0 + ai * HALF + m * 16) * ldc + col0;
#pragma unroll
                for (int bj = 0; bj < 2; ++bj) { const f32x4 v0 = acc[ai][bj][m][0], v1 = acc[ai][bj][m][1];
                    u32x4 w; w.x = cvt_pk_bf16_asm(v0[0], v0[1]); w.y = cvt_pk_bf16_asm(v0[2], v0[3]); w.z = cvt_pk_bf16_asm(v1[0], v1[1]); w.w = cvt_pk_bf16_asm(v1[2], v1[3]);
                    *(u32x4*)(rowp + bj * HALF) = w; } }
    }
};
struct EpiResid {
    static constexpr bool PERM = false;
    const float* base; float* C; int ldc;
    __device__ __forceinline__ void operator()(const f32x4 (&acc)[2][2][4][2], const Unit& u, int wr, int wc, int fr, int fq) const {
        const int row0 = u.pm * BM + wr * 64 + fr, col0 = u.pn * BM + wc * 32 + 4 * fq;
#pragma unroll
        for (int ai = 0; ai < 2; ++ai)
#pragma unroll
            for (int m = 0; m < 4; ++m) { const size_t off = (size_t)(row0 + ai * HALF + m * 16) * ldc + col0;
#pragma unroll
                for (int bj = 0; bj < 2; ++bj)
#pragma unroll
                    for (int n = 0; n < 2; ++n) { const f32x4 bs = *(const f32x4*)(base + off + bj * HALF + n * 16); *(f32x4*)(C + off + bj * HALF + n * 16) = bs + acc[ai][bj][m][n]; }
                asm volatile("" ::: "memory"); }
    }
};
struct EpiSwiglu {
    static constexpr bool PERM = true;
    bf16_t* O;
    __device__ __forceinline__ void operator()(const f32x4 (&acc)[2][2][4][2], const Unit& u, int wr, int wc, int fr, int fq) const {
        const int row0 = u.pm * BM + wr * 64 + fr, col0 = (u.pn & 15) * HALF + wc * 32 + 8 * fq;
#pragma unroll
        for (int ai = 0; ai < 2; ++ai)
#pragma unroll
            for (int m = 0; m < 4; ++m) { bf16_t* rowp = O + (size_t)(row0 + ai * HALF + m * 16) * FF + col0;
                float h[8];
#pragma unroll
                for (int n = 0; n < 2; ++n)
#pragma unroll
                    for (int j = 0; j < 4; ++j) { const float gt = acc[ai][0][m][n][j], up = acc[ai][1][m][n][j]; h[4 * n + j] = silu_f(gt) * up; }
                u32x4 w; w.x = cvt_pk_bf16_asm(h[0], h[1]); w.y = cvt_pk_bf16_asm(h[2], h[3]); w.z = cvt_pk_bf16_asm(h[4], h[5]); w.w = cvt_pk_bf16_asm(h[6], h[7]);
                *(u32x4*)rowp = w; }
    }
};
struct EpiDown {
    static constexpr bool PERM = true;
    bf16_t* O;
    __device__ __forceinline__ void operator()(const f32x4 (&acc)[2][2][4][2], const Unit& u, int wr, int wc, int fr, int fq) const {
        const int row0 = u.pm * BM + wr * 64 + fr, col0 = (u.pn & 3) * BM + wc * 32 + 8 * fq;
#pragma unroll
        for (int ai = 0; ai < 2; ++ai)
#pragma unroll
            for (int m = 0; m < 4; ++m) { bf16_t* rowp = O + (size_t)(row0 + ai * HALF + m * 16) * D + col0;
#pragma unroll
                for (int bj = 0; bj < 2; ++bj) { const f32x4 v0 = acc[ai][bj][m][0], v1 = acc[ai][bj][m][1];
                    u32x4 w; w.x = cvt_pk_bf16_asm(v0[0], v0[1]); w.y = cvt_pk_bf16_asm(v0[2], v0[3]); w.z = cvt_pk_bf16_asm(v1[0], v1[1]); w.w = cvt_pk_bf16_asm(v1[2], v1[3]);
                    *(u32x4*)(rowp + bj * HALF) = w; } }
    }
};
}

__device__ __forceinline__ void transpose_item(const float* W, int ld, int k0, int n0, bf16_t* WT, size_t dst_row0, int ldt, LAS float* scr, int lane) {
#pragma unroll 8
    for (int i = 0; i < 32; ++i) { const int kk = 2 * i + (lane >> 5); scr[kk * 33 + (lane & 31)] = W[(size_t)(k0 + kk) * ld + n0 + (lane & 31)]; }
    asm volatile("s_waitcnt lgkmcnt(0)" ::: "memory");
    const int c = lane & 7;
#pragma unroll
    for (int j = 0; j < 4; ++j) { const int n = (lane >> 3) + 8 * j; const LAS float* s = scr + (8 * c) * 33 + n;
        u32x4 o; o.x = cvt_pk_bf16(s[0 * 33], s[1 * 33]); o.y = cvt_pk_bf16(s[2 * 33], s[3 * 33]); o.z = cvt_pk_bf16(s[4 * 33], s[5 * 33]); o.w = cvt_pk_bf16(s[6 * 33], s[7 * 33]);
        *(u32x4*)(WT + (dst_row0 + n) * (size_t)ldt + k0 + 8 * c) = o; }
    asm volatile("s_waitcnt lgkmcnt(0)" ::: "memory");
}

#define XB_TMO      128
#define XB_XCNT(j)  (256  + 64 * (j))
#define XB_XSUB(j)  (1280 + 64 * (j))
#define XB_XGEN(j)  (2304 + 64 * (j))
#define XB_TOP      3328
#define XB_TOPGEN   3392
#define XCD_BAR_WORDS 3456
#define XB_PRB(b)   (3520 + 16 * (b))
#define XB_SPIN_CAP (1u << 20)
__device__ __forceinline__ unsigned xb_ld(unsigned* p)              { return __hip_atomic_load(p, __ATOMIC_RELAXED, __HIP_MEMORY_SCOPE_AGENT); }
__device__ __forceinline__ unsigned xb_add(unsigned* p, unsigned v) { return __hip_atomic_fetch_add(p, v, __ATOMIC_RELAXED, __HIP_MEMORY_SCOPE_AGENT); }
__device__ __forceinline__ unsigned xb_xcc_id() { return (unsigned)__builtin_amdgcn_s_getreg((3 << 11) | 20) & 0xFu; }
#define XB_SPIN(cond, bar) do { unsigned _sp = 0; while (cond) { __builtin_amdgcn_s_sleep(1); \
    if ((++_sp & 255u) == 0u) { if (xb_ld(&(bar)[XB_TMO])) break; if (_sp > XB_SPIN_CAP) { atomicAdd(&(bar)[XB_TMO], 1u); break; } } } } while (0)
struct XcdBarrier { unsigned* bar; unsigned x; volatile LAS unsigned* st; };
__device__ __forceinline__ XcdBarrier xcd_barrier_post(unsigned* bar, volatile LAS unsigned* st) {
    XcdBarrier b; b.bar = bar; b.x = xb_xcc_id(); b.st = st;
    if (threadIdx.x == 0) st[2] = xb_add(&bar[XB_XCNT(b.x)], 1u);
    return b;
}
__device__ __forceinline__ void xcd_barrier_complete(unsigned* bar, unsigned x, unsigned& nloc, unsigned& nx) {
    const unsigned G = gridDim.x * gridDim.y * gridDim.z;
    unsigned sum, cnt, mine, sp = 0u;
    for (;;) {
        sum = 0u; cnt = 0u; mine = 0u;
#pragma unroll
        for (unsigned j = 0; j < 16; ++j) { const unsigned c = xb_ld(&bar[XB_XCNT(j)]); sum += c; cnt += (c > 0u) ? 1u : 0u; mine = (j == x) ? c : mine; }
        if (sum == G) break;
        __builtin_amdgcn_s_sleep(1);
        if ((++sp & 255u) == 0u) { if (xb_ld(&bar[XB_TMO])) break; if (sp > XB_SPIN_CAP) { atomicAdd(&bar[XB_TMO], 1u); break; } }
    }
    nloc = mine > 0u ? mine : 1u; nx = cnt > 0u ? cnt : 1u;
}
__device__ __forceinline__ void xcd_barrier(const XcdBarrier& b) {
    asm volatile("s_waitcnt vmcnt(0)" ::: "memory");
    __syncthreads();
    if (threadIdx.x == 0) {
        unsigned* bar = b.bar;
        __builtin_amdgcn_s_waitcnt(0);
        unsigned nloc = b.st[0], nx = b.st[1];
        if (nloc == 0u) { xcd_barrier_complete(bar, b.x, nloc, nx); b.st[0] = nloc; b.st[1] = nx; }
        const unsigned old = xb_add(&bar[XB_XSUB(b.x)], 1u);
        const unsigned gen = old / nloc;
        if (old + 1u == (gen + 1u) * nloc) {
            __builtin_amdgcn_fence(__ATOMIC_RELEASE, "agent");
            asm volatile("s_waitcnt vmcnt(0)" ::: "memory");
            const unsigned og = xb_add(&bar[XB_TOP], 1u);
            const unsigned tg = og / nx;
            if (og + 1u == (tg + 1u) * nx) xb_add(&bar[XB_TOPGEN], 1u);
            else XB_SPIN(xb_ld(&bar[XB_TOPGEN]) == tg, bar);
            __builtin_amdgcn_fence(__ATOMIC_ACQUIRE, "agent");
            xb_add(&bar[XB_XGEN(b.x)], 1u);
            asm volatile("s_waitcnt vmcnt(0)" ::: "memory");
        } else {
            XB_SPIN(xb_ld(&bar[XB_XGEN(b.x)]) == gen, bar);
            __builtin_amdgcn_fence(__ATOMIC_ACQUIRE, "agent");
            asm volatile("s_waitcnt vmcnt(0)" ::: "memory");
        }
    }
    __syncthreads();
}

#define MFMA16(A, B, C) __builtin_amdgcn_mfma_f32_16x16x32_bf16(A, B, C, 0, 0, 0)
template <int MODE>
__device__ __forceinline__ void row_pass(const Args& a, LAS unsigned char* lds) {
    const int tid = tid_fresh(), lane = tid & 63, wave = __builtin_amdgcn_readfirstlane(tid >> 6), l15 = lane & 15, l4 = lane >> 4;
    const float* src = MODE == 0 ? a.in[0] : a.out;
    const float* nw = MODE == 0 ? a.in[1] : a.in[12];
    const float* wsm = MODE == 0 ? a.in[2] + 2048 : a.in[13];
    const int ld = MODE == 0 ? INC : NE;
    bf16_t* dst = (bf16_t*)(a.ws + WS_XN);
    float* aux = (float*)(a.ws + (MODE == 0 ? WS_GATES : WS_PROBS));
    LAS unsigned char* XH = lds; LAS unsigned char* XL = lds + 32768; LAS float* PART = (LAS float*)(lds + 65536);
    bf16x8 wh[4], wl[4];
#pragma unroll
    for (int ks = 0; ks < 4; ++ks) { float f[8];
#pragma unroll
        for (int j = 0; j < 8; ++j) f[j] = wsm[(size_t)(128 * wave + 32 * ks + 8 * l4 + j) * ld + l15];
        unsigned hw[4], lw[4];
#pragma unroll
        for (int j = 0; j < 4; ++j) { hw[j] = cvt_pk_bf16(f[2 * j], f[2 * j + 1]); lw[j] = cvt_pk_bf16(f[2 * j] - bflo(hw[j]), f[2 * j + 1] - bfhi(hw[j])); }
        u32x4 hv = (u32x4){hw[0], hw[1], hw[2], hw[3]}, lv = (u32x4){lw[0], lw[1], lw[2], lw[3]};
        wh[ks] = __builtin_bit_cast(bf16x8, hv); wl[ks] = __builtin_bit_cast(bf16x8, lv); }
    const f32x4* nw4 = (const f32x4*)nw + lane;
    f32x4 w4[4];
#pragma unroll
    for (int j = 0; j < 4; ++j) w4[j] = nw4[64 * j];
    const int ec = tid & 15;
    float alog = 0.f, dtb = 0.f;
    if (MODE == 0) { const int h = ec & 3; if (ec < 4) { alog = a.in[4][h]; dtb = a.in[5][h]; } else if (ec >= 8 && ec < 12) { alog = a.in[6][h]; dtb = a.in[7][h]; } }
    constexpr int NGRP = MTOK / 16;
    f32x4 vn[2][4];
    if ((int)blockIdx.x < NGRP) {
#pragma unroll
        for (int q = 0; q < 2; ++q) { const f32x4* xr = (const f32x4*)(src + (size_t)(16 * blockIdx.x + 2 * wave + q) * D) + lane;
#pragma unroll
            for (int j = 0; j < 4; ++j) vn[q][j] = xr[64 * j]; } }
    for (int grp = blockIdx.x; grp < NGRP; grp += gridDim.x) {
        f32x4 v[2][4];
#pragma unroll
        for (int q = 0; q < 2; ++q)
#pragma unroll
            for (int j = 0; j < 4; ++j) v[q][j] = vn[q][j];
        if (grp + (int)gridDim.x < NGRP) {
#pragma unroll
            for (int q = 0; q < 2; ++q) { const f32x4* xr = (const f32x4*)(src + (size_t)(16 * (grp + gridDim.x) + 2 * wave + q) * D) + lane;
#pragma unroll
                for (int j = 0; j < 4; ++j) vn[q][j] = xr[64 * j]; } }
#pragma unroll
        for (int q = 0; q < 2; ++q) { const int lr = 2 * wave + q, row = 16 * grp + lr; float ss = 0.f;
#pragma unroll
            for (int j = 0; j < 4; ++j) ss += (v[q][j].x * v[q][j].x + v[q][j].y * v[q][j].y) + (v[q][j].z * v[q][j].z + v[q][j].w * v[q][j].w);
            const float r = rsqrtf(wave_sum(ss) * (1.f / D) + EPS);
            u32x2* o8 = (u32x2*)(dst + (size_t)row * D) + lane;
#pragma unroll
            for (int j = 0; j < 4; ++j) { const f32x4 y = v[q][j] * r * w4[j]; u32x2 hw, lw; hw.x = cvt_pk_bf16(y.x, y.y); hw.y = cvt_pk_bf16(y.z, y.w);
                lw.x = cvt_pk_bf16(y.x - bflo(hw.x), y.y - bfhi(hw.x)); lw.y = cvt_pk_bf16(y.z - bflo(hw.y), y.w - bfhi(hw.y));
                o8[64 * j] = hw;
                const int off = lr * 2048 + ((((lane >> 1) + 32 * j) ^ lr) << 4) + 8 * (lane & 1);
                *(LAS u32x2*)(XH + off) = hw; *(LAS u32x2*)(XL + off) = lw; } }
        __syncthreads();
        f32x4 acc = (f32x4){0.f, 0.f, 0.f, 0.f};
#pragma unroll
        for (int ks = 0; ks < 4; ++ks) { const int off = l15 * 2048 + (((16 * wave + 4 * ks + l4) ^ l15) << 4);
            const bf16x8 xh = *(const LAS bf16x8*)(XH + off), xl = *(const LAS bf16x8*)(XL + off);
            acc = MFMA16(xh, wh[ks], acc); acc = MFMA16(xh, wl[ks], acc); acc = MFMA16(xl, wh[ks], acc); }
#pragma unroll
        for (int r4 = 0; r4 < 4; ++r4) PART[(wave * 16 + 4 * l4 + r4) * 16 + l15] = acc[r4];
        __syncthreads();
        if (tid < 256) { float s = 0.f;
#pragma unroll
            for (int w8 = 0; w8 < 8; ++w8) s += PART[w8 * 256 + tid];
            float res;
            if (MODE == 0) { if (ec < 4 || (ec >= 8 && ec < 12)) res = -__expf(alog) * softplus_f(s + dtb); else res = sigmoid_f(s); }
            else { float mx = s;
#pragma unroll
                for (int o = 1; o < 16; o <<= 1) mx = fmaxf(mx, __shfl_xor(mx, o));
                const float e = __expf(s - mx); float sm = e;
#pragma unroll
                for (int o = 1; o < 16; o <<= 1) sm += __shfl_xor(sm, o);
                res = e / sm; }
            if (MODE == 1) __hip_atomic_store((unsigned*)(aux + (size_t)(16 * grp) * 16 + tid), __float_as_uint(res), __ATOMIC_RELAXED, __HIP_MEMORY_SCOPE_AGENT);
            else aux[(size_t)(16 * grp) * 16 + tid] = res; }
        __syncthreads();
    }
    if (MODE == 1) {
        asm volatile("s_waitcnt vmcnt(0)" ::: "memory");
        __syncthreads();
        if (tid == 0) for (int grp = blockIdx.x; grp < NGRP; grp += gridDim.x) xb_add((unsigned*)(a.ws + WS_CTL) + XB_PRB(grp >> 7), 1u);
    }
}

__device__ __forceinline__ void ph_prologue(const Args& a, LAS unsigned char* lds) {
    const int tid = tid_fresh(), lane = tid & 63, wave = tid >> 6;
    LAS float* scr = (LAS float*)(lds + wave * 8704);
    const int gw = blockIdx.x * NWAVE + wave, NGW = gridDim.x * NWAVE;
    bf16_t* Win = (bf16_t*)(a.ws + WS_WIN); bf16_t* Wmix = (bf16_t*)(a.ws + WS_WMIX);
    constexpr int I_A = 16 * 64, I_B = 16 * 16, I_C = 8 * 32;
    for (int it = gw; it < I_A + I_B + I_C; it += NGW) {
        int r = it;
        if (r < I_A) { const int kb = r / 64, nb = r % 64; transpose_item(a.in[2], INC, 64 * kb, 32 * nb, Win, (size_t)32 * nb, D, scr, lane); continue; } r -= I_A;
        if (r < I_B) { const int kb = r / 16, nb = r % 16; transpose_item(a.in[2] + 2064, INC, 64 * kb, 32 * nb, Win, (size_t)2048 + 32 * nb, D, scr, lane); continue; } r -= I_B;
        { const int kb = r / 32, nb = r % 32; transpose_item(a.in[11], D, 64 * kb, 32 * nb, Wmix, (size_t)32 * nb, D, scr, lane); }
    }
    __syncthreads();
    for (int task = blockIdx.x; task < 256; task += gridDim.x) {
        const int g = task >> 6, n0 = (task & 63) * 16;
        LAS float* Wsc = (LAS float*)lds;
        LAS float* Pw = (LAS float*)(lds + 8192);
        for (int idx = tid; idx < 128 * 16; idx += NTHR) { const int d = idx >> 4, n = idx & 15; Wsc[idx] = a.in[11][(size_t)(512 + 128 * g + d) * D + n0 + n] * a.in[10][128 * g + d]; }
        for (int idx = tid; idx < 128 * 128; idx += NTHR) Pw[(idx >> 7) * 129 + (idx & 127)] = a.in[9][(size_t)g * 16384 + idx];
        __syncthreads();
        const int n = tid & 15, cq = tid >> 4;
        float accv[4] = {0.f, 0.f, 0.f, 0.f};
        for (int d = 0; d < 128; ++d) { const float w = Wsc[d * 16 + n];
#pragma unroll
            for (int j = 0; j < 4; ++j) accv[j] += Pw[(cq * 4 + j) * 129 + d] * w; }
        u32x2 o; o.x = cvt_pk_bf16(accv[0], accv[1]); o.y = cvt_pk_bf16(accv[2], accv[3]);
        *(u32x2*)(Wmix + (size_t)(n0 + n) * D + 512 + 128 * g + cq * 4) = o;
        __syncthreads();
    }
    __syncthreads();
    row_pass<0>(a, lds);
}

constexpr int CVT_ITEMS = NE * 3072, CVT_SPLIT = (CVT_ITEMS * 9 / 10) & ~2047;
template <bool EARLY>
__device__ __forceinline__ void expert_weight_cvt(const Args& a, LAS unsigned char* lds, int it_lo, int it_hi, int wg0, int nwg, int bid) {
    const int tid = tid_fresh(), lane = tid & 63, wave = tid >> 6;
    LAS float* scr = (LAS float*)(lds + wave * 8704);
    const int gw = (bid - wg0) * NWAVE + wave, NGW = nwg * NWAVE;
    bf16_t* Wgu = (bf16_t*)(a.ws + WS_WGU); bf16_t* Wd = (bf16_t*)(a.ws + WS_WD); bf16_t* WdA = (bf16_t*)(a.ws + WS_WDA);
    if (bid < wg0 || bid >= wg0 + nwg) return;
    for (int it = it_lo + gw; it < it_hi; it += NGW) {
        if (EARLY) { const int e = it >> 10, q = it & 1023, kb = q >> 5, nb = q & 31;
            transpose_item(a.in[16] + (size_t)e * FF * D, D, 64 * kb, 32 * nb, WdA, (size_t)e * 1024 + 32 * nb, FF, scr, lane); continue; }
        const int e = it / 3072, r = it % 3072, which = r >> 10, q = r & 1023;
        if (which < 2) { const int kb = q >> 6, nb = q & 63, f0 = 32 * nb;
            const float* W = (which == 0 ? a.in[14] : a.in[15]) + (size_t)e * D * FF;
            transpose_item(W, FF, 64 * kb, f0, Wgu, (size_t)e * 4096 + (f0 >> 7) * 256 + which * 128 + (f0 & 127), D, scr, lane);
        } else if (e >= NEARLY) { const int kb = q >> 5, nb = q & 31;
            transpose_item(a.in[16] + (size_t)e * FF * D, D, 64 * kb, 32 * nb, Wd, (size_t)e * 1024 + 32 * nb, FF, scr, lane); }
    }
}

__device__ __forceinline__ int a128(int row, int col) { return row * 256 + ((((col >> 3) ^ (row & 15))) << 4) + ((col & 7) << 1); }
__device__ __forceinline__ int a64(int row, int col) { return row * 128 + ((((col >> 3) ^ ((row >> 1) & 7))) << 4) + ((col & 7) << 1); }
__device__ __forceinline__ bf16x8 frag128(LAS unsigned char* base, int row0, int k0, int lane) { return *(const LAS bf16x8*)(base + a128(row0 + (lane & 15), k0 + ((lane >> 4) << 3))); }
__device__ __forceinline__ bf16x8 frag64(LAS unsigned char* base, int row0, int k0, int lane) { return *(const LAS bf16x8*)(base + a64(row0 + (lane & 15), k0 + ((lane >> 4) << 3))); }
__device__ __forceinline__ u32x2 pack4(f32x4 v) { u32x2 w; w.x = cvt_pk_bf16(v[0], v[1]); w.y = cvt_pk_bf16(v[2], v[3]); return w; }

template <bool FRAG>
__device__ __forceinline__ void staged_store_16x64(LAS unsigned char* stg, const f32x4 (&t)[4], unsigned char* gmat, int tile16, int half, int lane) {
    const int l15 = lane & 15, l4 = lane >> 4;
#pragma unroll
    for (int k = 0; k < 4; ++k) *(LAS u32x2*)(stg + l15 * 128 + (((2 * k + (l4 >> 1)) ^ (l15 & 7)) << 4) + 8 * (l4 & 1)) = pack4(t[k]);
#pragma unroll
    for (int q = 0; q < 2; ++q) { const int idx = lane + 64 * q, row = idx >> 3, c = idx & 7;
        const u32x4 v = *(const LAS u32x4*)(stg + row * 128 + ((c ^ (row & 7)) << 4));
        const size_t off = FRAG ? (size_t)(tile16 * 4 + 2 * half + (c >> 2)) * 1024 + row * 64 + (c & 3) * 16
                                : (size_t)(tile16 * 8 + 4 * half + (c >> 1)) * 512 + row * 32 + (c & 1) * 16;
        *(u32x4*)(gmat + off) = v; }
}
constexpr int L_QM = 0, L_KM = 16384, L_KT = 32768, L_VT = 49152, L_WT = 114688, L_UT = 131072, L_SM = 147456;
#define L_PD(d)  (65536 + (d) * 24576)
#define L_PTD(d) (65536 + (d) * 24576 + 8192)
#define L_PQD(d) (65536 + (d) * 24576 + 16384)
#define L_TD(d)  (114688 + (d) * 8192)
__device__ __forceinline__ void ph_chunk_prep(const Args& a, LAS unsigned char* lds) {
    const int tid0 = tid_fresh(), wave = __builtin_amdgcn_readfirstlane(tid0 >> 6);
    const bf16_t* proj = (const bf16_t*)(a.ws + WS_PROJ);
    const float* gates = (const float*)(a.ws + WS_GATES);
    float* eglp = (float*)(a.ws + WS_EGL);
    LAS float* sm = (LAS float*)(lds + L_SM);
    const int tn = wave & 3, tm0 = 2 * (wave >> 2);
#define SEG_LANE() int tid = tid0; asm volatile("" : "+v"(tid)); const int lane = tid & 63, l15 = lane & 15, l4 = lane >> 4, ra = 16 * tn + l15; (void)l4; (void)ra; (void)lane
    u32x4 raw[3][6]; float graw[4];
#define PREP_FETCH(task_) do { const int n_ = (task_) & 31, h_ = ((task_) >> 5) & 3, b_ = (task_) >> 7; int tidf = tid0; asm volatile("" : "+v"(tidf)); \
        const int cch_ = tidf & 15, i0_ = 2 * (tidf >> 4); \
        _Pragma("unroll") for (int mtx = 0; mtx < 3; ++mtx) _Pragma("unroll") for (int jj = 0; jj < 6; ++jj) { const int tl_ = n_ * 64 + i0_ - 2 + jj; \
            raw[mtx][jj] = (u32x4){0u, 0u, 0u, 0u}; \
            if (tl_ >= 0 && tl_ < T) raw[mtx][jj] = *(const u32x4*)(proj + (size_t)(b_ * T + tl_) * NPROJ + mtx * 512 + h_ * HD + 8 * cch_); } \
        if (wave == 0) { const float* gp_ = gates + (size_t)(b_ * T + n_ * 64 + (tidf & 63)) * 16; graw[0] = gp_[h_]; graw[1] = gp_[4 + h_]; graw[2] = gp_[8 + h_]; graw[3] = gp_[12 + h_]; } } while (0)
    if ((int)blockIdx.x < NB * NH * NCH) PREP_FETCH((int)blockIdx.x);
    for (int task = blockIdx.x; task < NB * NH * NCH; task += gridDim.x) {
        const int n = task & 31, h = (task >> 5) & 3, b = task >> 7;
        { SEG_LANE();
        if (wave == 0) {
            const float gf = graw[0], bfv = graw[1], gb = graw[2], bbv = graw[3];
            float pf = gf, pb = gb;
#pragma unroll
            for (int o = 1; o < 64; o <<= 1) { const float tf = __shfl_up(pf, o), tb = __shfl_up(pb, o); if (lane >= o) { pf += tf; pb += tb; } }
            const float totb = __shfl(pb, 63);
            sm[lane] = pf; sm[64 + lane] = totb - pb + gb; sm[128 + lane] = bfv; sm[192 + lane] = bbv;
        }
        {
            const int cch = tid & 15, rp = tid >> 4, i0 = 2 * rp;
#pragma unroll
            for (int mtx = 0; mtx < 3; ++mtx) {
                const int colb = mtx * 512 + h * HD + 8 * cch;
                float in[6][8];
#pragma unroll
                for (int jj = 0; jj < 6; ++jj) { const u32x4 w = raw[mtx][jj];
                    in[jj][0] = bflo(w.x); in[jj][1] = bfhi(w.x); in[jj][2] = bflo(w.y); in[jj][3] = bfhi(w.y); in[jj][4] = bflo(w.z); in[jj][5] = bfhi(w.z); in[jj][6] = bflo(w.w); in[jj][7] = bfhi(w.w); }
                float val[2][8];
#pragma unroll
                for (int r = 0; r < 2; ++r)
#pragma unroll
                    for (int e = 0; e < 8; ++e) val[r][e] = 0.f;
#pragma unroll
                for (int j = 0; j < 5; ++j) { const f32x4 c0 = *(const f32x4*)(a.in[3] + (size_t)j * 1536 + colb), c1 = *(const f32x4*)(a.in[3] + (size_t)j * 1536 + colb + 4);
#pragma unroll
                    for (int r = 0; r < 2; ++r) {
#pragma unroll
                        for (int e = 0; e < 4; ++e) { val[r][e] += in[r + j][e] * c0[e]; val[r][4 + e] += in[r + j][4 + e] * c1[e]; } } }
#pragma unroll
                for (int r = 0; r < 2; ++r) { float ss = 0.f;
#pragma unroll
                    for (int e = 0; e < 8; ++e) { val[r][e] = silu_f(val[r][e]); ss += val[r][e] * val[r][e]; }
                    if (mtx < 2) { ss += __shfl_xor(ss, 1); ss += __shfl_xor(ss, 2); ss += __shfl_xor(ss, 4); ss += __shfl_xor(ss, 8);
                        const float sc = rsqrtf(ss + EPS) * (mtx == 0 ? 0.08838834764831845f : 1.f);
#pragma unroll
                        for (int e = 0; e < 8; ++e) val[r][e] *= sc; } }
                if (mtx < 2) {
#pragma unroll
                    for (int r = 0; r < 2; ++r) { u32x4 w; w.x = cvt_pk_bf16(val[r][0], val[r][1]); w.y = cvt_pk_bf16(val[r][2], val[r][3]); w.z = cvt_pk_bf16(val[r][4], val[r][5]); w.w = cvt_pk_bf16(val[r][6], val[r][7]);
                        *(LAS u32x4*)(lds + (mtx == 0 ? L_QM : L_KM) + a128(i0 + r, 8 * cch)) = w; } }
                if (mtx >= 1) {
#pragma unroll
                    for (int e = 0; e < 8; ++e) *(LAS unsigned*)(lds + (mtx == 1 ? L_KT : L_VT) + a64(8 * cch + e, i0)) = cvt_pk_bf16(val[0][e], val[1][e]); }
            }
        }
        }
        if (task + (int)gridDim.x < NB * NH * NCH) PREP_FETCH(task + (int)gridDim.x);
        __syncthreads();
        { SEG_LANE();
            f32x4 kk[2] = {(f32x4){0, 0, 0, 0}, (f32x4){0, 0, 0, 0}}, qk[2] = {(f32x4){0, 0, 0, 0}, (f32x4){0, 0, 0, 0}};
#pragma unroll
            for (int ks = 0; ks < 4; ++ks) { const bf16x8 yk = frag128(lds + L_KM, 16 * tn, 32 * ks, lane), yq = frag128(lds + L_QM, 16 * tn, 32 * ks, lane);
#pragma unroll
                for (int t2 = 0; t2 < 2; ++t2) { const bf16x8 xk = frag128(lds + L_KM, 16 * (tm0 + t2), 32 * ks, lane);
                    kk[t2] = MFMA16(xk, yk, kk[t2]); qk[t2] = MFMA16(xk, yq, qk[t2]); } }
#pragma unroll
            for (int dir = 0; dir < 2; ++dir) {
                LAS float* gc = sm + 64 * dir; LAS float* bet = sm + 128 + 64 * dir;
                const float gca = gc[ra], ba = bet[ra];
#pragma unroll
                for (int t2 = 0; t2 < 2; ++t2) { const int rb0 = 16 * (tm0 + t2) + 4 * l4;
                    f32x4 pv, ptv, pqv, tv;
#pragma unroll
                    for (int r = 0; r < 4; ++r) { const int rb = rb0 + r; const float gcb = gc[rb], bb = bet[rb];
                        const bool st_ab = dir ? (rb > ra) : (rb < ra), st_ba = dir ? (ra > rb) : (ra < rb), in_ab = st_ab || (rb == ra);
                        const float dab = __expf(fminf(gca - gcb, 0.f)), dba = __expf(fminf(gcb - gca, 0.f));
                        pv[r] = st_ab ? ba * kk[t2][r] * dab : 0.f;
                        ptv[r] = st_ba ? bb * kk[t2][r] * dba : 0.f;
                        pqv[r] = in_ab ? qk[t2][r] * dab : 0.f;
                        tv[r] = (rb == ra ? 1.f : 0.f) - pv[r]; }
                    *(LAS u32x2*)(lds + L_PD(dir) + a64(ra, rb0)) = pack4(pv);
                    *(LAS u32x2*)(lds + L_PTD(dir) + a64(ra, rb0)) = pack4(ptv);
                    *(LAS u32x2*)(lds + L_PQD(dir) + a64(ra, rb0)) = pack4(pqv);
                    *(LAS u32x2*)(lds + L_TD(dir) + a64(ra, rb0)) = pack4(tv); }
            }
        }
        __syncthreads();
        if (wave < 4) { SEG_LANE();
            const int d = wave >> 1, R = 32 * (wave & 1);
            LAS unsigned char* Pi = lds + L_PD(d); LAS unsigned char* PTi = lds + L_PTD(d); LAS unsigned char* Ti = lds + L_TD(d); LAS unsigned char* TTi = lds + L_UT + wave * 4096;
            LAS float* gc = sm + 64 * d; LAS float* bet = sm + 128 + 64 * d;
            f32x4 Ta[2][2], TTa[2][2];
#pragma unroll
            for (int mi = 0; mi < 2; ++mi)
#pragma unroll
                for (int ni = 0; ni < 2; ++ni) { const int ar = R + 16 * ni + l15, b0 = R + 16 * mi + 4 * l4;
                    const u32x2 p = *(const LAS u32x2*)(Pi + a64(ar, b0)), pt = *(const LAS u32x2*)(PTi + a64(ar, b0));
                    Ta[mi][ni][0] = (ar == b0 ? 1.f : 0.f) - bflo(p.x); Ta[mi][ni][1] = (ar == b0 + 1 ? 1.f : 0.f) - bfhi(p.x); Ta[mi][ni][2] = (ar == b0 + 2 ? 1.f : 0.f) - bflo(p.y); Ta[mi][ni][3] = (ar == b0 + 3 ? 1.f : 0.f) - bfhi(p.y);
                    TTa[mi][ni][0] = (ar == b0 ? 1.f : 0.f) - bflo(pt.x); TTa[mi][ni][1] = (ar == b0 + 1 ? 1.f : 0.f) - bfhi(pt.x); TTa[mi][ni][2] = (ar == b0 + 2 ? 1.f : 0.f) - bflo(pt.y); TTa[mi][ni][3] = (ar == b0 + 3 ? 1.f : 0.f) - bfhi(pt.y);
                    *(LAS u32x2*)(TTi + a64(16 * ni + l15, b0)) = pack4(TTa[mi][ni]); }
#pragma unroll 1
            for (int s5 = 0; s5 < 5; ++s5) {
                bf16x8 fp[2], fpt[2], ft[2], ftt[2];
#pragma unroll
                for (int mi = 0; mi < 2; ++mi) { fp[mi] = frag64(Pi, R + 16 * mi, R, lane); fpt[mi] = frag64(PTi, R + 16 * mi, R, lane); ft[mi] = frag64(Ti, R + 16 * mi, R, lane);
                    ftt[mi] = *(const LAS bf16x8*)(TTi + a64(16 * mi + l15, R + 8 * l4)); }
                f32x4 pn[2][2], pnt[2][2];
#pragma unroll
                for (int mi = 0; mi < 2; ++mi)
#pragma unroll
                    for (int ni = 0; ni < 2; ++ni) { pn[mi][ni] = (f32x4){0, 0, 0, 0}; pnt[mi][ni] = (f32x4){0, 0, 0, 0};
                        if (s5 < 4) { pn[mi][ni] = MFMA16(fpt[mi], fp[ni], pn[mi][ni]); pnt[mi][ni] = MFMA16(fp[mi], fpt[ni], pnt[mi][ni]); }
                        if (s5 > 0) { Ta[mi][ni] = MFMA16(fpt[mi], ft[ni], Ta[mi][ni]); TTa[mi][ni] = MFMA16(ft[mi], fpt[ni], TTa[mi][ni]); } }
                (void)ftt;
#pragma unroll
                for (int mi = 0; mi < 2; ++mi)
#pragma unroll
                    for (int ni = 0; ni < 2; ++ni) { const int ar = R + 16 * ni + l15, b0 = R + 16 * mi + 4 * l4;
                        if (s5 < 4) { *(LAS u32x2*)(Pi + a64(ar, b0)) = pack4(pn[mi][ni]); *(LAS u32x2*)(PTi + a64(ar, b0)) = pack4(pnt[mi][ni]); }
                        if (s5 > 0 && s5 < 4) *(LAS u32x2*)(Ti + a64(ar, b0)) = pack4(Ta[mi][ni]); }
            }
#pragma unroll
            for (int mi = 0; mi < 2; ++mi)
#pragma unroll
                for (int ni = 0; ni < 2; ++ni) { const int ar = R + 16 * ni + l15, b0 = R + 16 * mi + 4 * l4; f32x4 tw, tu;
#pragma unroll
                    for (int r = 0; r < 4; ++r) { const float bb = bet[b0 + r]; tu[r] = Ta[mi][ni][r] * bb; tw[r] = tu[r] * __expf(gc[b0 + r]); }
                    *(LAS u32x2*)(Ti + a64(ar, b0)) = pack4(Ta[mi][ni]); *(LAS u32x2*)(TTi + a64(16 * ni + l15, b0)) = pack4(TTa[mi][ni]);
                    *(LAS u32x2*)(Pi + a64(ar, b0)) = pack4(tw); *(LAS u32x2*)(PTi + a64(ar, b0)) = pack4(tu); }
        }
        __syncthreads();
        if (wave == 4 || wave == 5) { SEG_LANE();
            const int d = wave - 4, ab = d ? 0 : 1, bb_ = 1 - ab, Ra = 32 * ab, Rb = 32 * bb_;
            LAS unsigned char* Pi = lds + L_PD(d); LAS unsigned char* PTi = lds + L_PTD(d); LAS unsigned char* Ti = lds + L_TD(d);
            LAS unsigned char* TTb = lds + L_UT + (2 * d + bb_) * 4096; LAS unsigned char* Zi = lds + L_KM + d * 4096;
            LAS float* gc = sm + 64 * d; LAS float* bet = sm + 128 + 64 * d;
            bf16x8 x1[2], y1[2];
#pragma unroll
            for (int t = 0; t < 2; ++t) { x1[t] = frag64(PTi, Rb + 16 * t, Ra, lane); y1[t] = frag64(Ti, Ra + 16 * t, Ra, lane); }
#pragma unroll
            for (int mi = 0; mi < 2; ++mi)
#pragma unroll
                for (int ni = 0; ni < 2; ++ni) { f32x4 z = (f32x4){0, 0, 0, 0}; z = MFMA16(x1[mi], y1[ni], z);
                    *(LAS u32x2*)(Zi + a64(16 * ni + l15, Rb + 16 * mi + 4 * l4)) = pack4(z);
                    *(LAS u32x2*)(PTi + a64(Rb + 16 * ni + l15, Ra + 16 * mi + 4 * l4)) = (u32x2){0u, 0u}; }
            bf16x8 x2[2], y2[2];
#pragma unroll
            for (int t = 0; t < 2; ++t) { x2[t] = *(const LAS bf16x8*)(TTb + a64(16 * t + l15, Rb + 8 * l4)); y2[t] = *(const LAS bf16x8*)(Zi + a64(16 * t + l15, Rb + 8 * l4)); }
#pragma unroll
            for (int mj = 0; mj < 2; ++mj)
#pragma unroll
                for (int ni = 0; ni < 2; ++ni) { f32x4 t = (f32x4){0, 0, 0, 0}; t = MFMA16(x2[mj], y2[ni], t);
                    const int ir = Ra + 16 * ni + l15, j0 = Rb + 16 * mj + 4 * l4; f32x4 tw, tu;
#pragma unroll
                    for (int r = 0; r < 4; ++r) { const float bb = bet[j0 + r]; tu[r] = -t[r] * bb; tw[r] = tu[r] * __expf(gc[j0 + r]); }
                    *(LAS u32x2*)(Pi + a64(ir, j0)) = pack4(tw); *(LAS u32x2*)(PTi + a64(ir, j0)) = pack4(tu); }
        }
        __syncthreads();
#pragma unroll 1
        for (int dir = 0; dir < 2; ++dir) {
            LAS float* gc = sm + 64 * dir;
            const float gl = dir ? gc[0] : gc[63];
            { SEG_LANE(); const int d = tid >> 2, ib = (tid & 3) * 16;
#pragma unroll
                for (int cpart = 0; cpart < 2; ++cpart) { const int i = ib + 8 * cpart; const u32x4 w = *(const LAS u32x4*)(lds + L_KT + a64(d, i));
                    float f[8] = {bflo(w.x), bfhi(w.x), bflo(w.y), bfhi(w.y), bflo(w.z), bfhi(w.z), bflo(w.w), bfhi(w.w)};
#pragma unroll
                    for (int e = 0; e < 8; ++e) f[e] *= __expf(gl - gc[i + e]);
                    u32x4 o; o.x = cvt_pk_bf16(f[0], f[1]); o.y = cvt_pk_bf16(f[2], f[3]); o.z = cvt_pk_bf16(f[4], f[5]); o.w = cvt_pk_bf16(f[6], f[7]);
                    *(LAS u32x4*)(lds + L_KM + a64(d, i)) = o; } }
            { SEG_LANE();
                f32x4 wa[4], ua[4];
#pragma unroll
                for (int t4 = 0; t4 < 4; ++t4) { wa[t4] = (f32x4){0, 0, 0, 0}; ua[t4] = (f32x4){0, 0, 0, 0}; }
#pragma unroll
                for (int ks = 0; ks < 2; ++ks) { const bf16x8 yk = frag64(lds + L_KT, 16 * wave, 32 * ks, lane), yv = frag64(lds + L_VT, 16 * wave, 32 * ks, lane);
#pragma unroll
                    for (int t4 = 0; t4 < 4; ++t4) { const bf16x8 xw = frag64(lds + L_PD(dir), 16 * t4, 32 * ks, lane), xu = frag64(lds + L_PTD(dir), 16 * t4, 32 * ks, lane);
                        wa[t4] = MFMA16(xw, yk, wa[t4]); ua[t4] = MFMA16(xu, yv, ua[t4]); } }
                const int rd = 16 * wave + l15;
#pragma unroll
                for (int t4 = 0; t4 < 4; ++t4) { *(LAS u32x2*)(lds + L_WT + a64(rd, 16 * t4 + 4 * l4)) = pack4(wa[t4]); *(LAS u32x2*)(lds + L_UT + a64(rd, 16 * t4 + 4 * l4)) = pack4(ua[t4]); }
            }
            __syncthreads();
            { SEG_LANE();
                const int cd = ((b * NH + h) * NCH + n) * 2 + dir;
                unsigned char* pb = a.ws + WS_PREP + (size_t)cd * PREP_STRIDE;
                if (tid == 0) eglp[cd] = __expf(gl);
                LAS unsigned char* stg = lds + L_PD(dir) + wave * 2048;
                {
                    bf16x8 y[2]; y[0] = frag64(lds + L_KM, 16 * wave, 0, lane); y[1] = frag64(lds + L_KM, 16 * wave, 32, lane);
#pragma unroll
                    for (int hf = 0; hf < 2; ++hf) { f32x4 c[4];
#pragma unroll
                        for (int t4 = 0; t4 < 4; ++t4) { const int t8 = 4 * hf + t4; c[t4] = (f32x4){0, 0, 0, 0};
                            c[t4] = MFMA16(frag64(lds + L_WT, 16 * t8, 0, lane), y[0], c[t4]); c[t4] = MFMA16(frag64(lds + L_WT, 16 * t8, 32, lane), y[1], c[t4]); c[t4] = -c[t4]; }
                        staged_store_16x64<true>(stg, c, pb, wave, hf, lane); }
                }
                {
                    bf16x8 y[2]; y[0] = frag64(lds + L_UT, 16 * wave, 0, lane); y[1] = frag64(lds + L_UT, 16 * wave, 32, lane);
#pragma unroll
                    for (int hf = 0; hf < 2; ++hf) { f32x4 c[4];
#pragma unroll
                        for (int t4 = 0; t4 < 4; ++t4) { const int t8 = 4 * hf + t4; c[t4] = (f32x4){0, 0, 0, 0};
                            c[t4] = MFMA16(frag64(lds + L_KM, 16 * t8, 0, lane), y[0], c[t4]); c[t4] = MFMA16(frag64(lds + L_KM, 16 * t8, 32, lane), y[1], c[t4]); }
                        staged_store_16x64<false>(stg, c, pb + 32768, wave, hf, lane); }
                }
                {
                    bf16x8 y[2]; y[0] = frag64(lds + L_PQD(dir), 16 * tn, 0, lane); y[1] = frag64(lds + L_PQD(dir), 16 * tn, 32, lane);
                    const float eg = __expf(gc[ra]);
                    f32x4 cq[4], co[4];
#pragma unroll
                    for (int t4 = 0; t4 < 4; ++t4) { const int mt = 4 * (wave >> 2) + t4, c0 = 16 * mt + 4 * l4;
                        cq[t4] = (f32x4){0, 0, 0, 0}; co[t4] = (f32x4){0, 0, 0, 0};
                        cq[t4] = MFMA16(frag64(lds + L_WT, 16 * mt, 0, lane), y[0], cq[t4]); cq[t4] = MFMA16(frag64(lds + L_WT, 16 * mt, 32, lane), y[1], cq[t4]);
                        co[t4] = MFMA16(frag64(lds + L_UT, 16 * mt, 0, lane), y[0], co[t4]); co[t4] = MFMA16(frag64(lds + L_UT, 16 * mt, 32, lane), y[1], co[t4]);
                        const u32x2 qw = *(const LAS u32x2*)(lds + L_QM + a128(ra, c0));
                        cq[t4][0] = eg * bflo(qw.x) - cq[t4][0]; cq[t4][1] = eg * bfhi(qw.x) - cq[t4][1]; cq[t4][2] = eg * bflo(qw.y) - cq[t4][2]; cq[t4][3] = eg * bfhi(qw.y) - cq[t4][3]; }
                    staged_store_16x64<true>(stg, cq, pb + 65536, tn, wave >> 2, lane);
                    staged_store_16x64<false>(stg, co, pb + 81920, tn, wave >> 2, lane);
                }
            }
            __syncthreads();
        }
    }
#undef SEG_LANE
#undef PREP_FETCH
}

__device__ __forceinline__ void ph_pool(const Args& a, LAS unsigned char* lds) {
    const int tid = tid_fresh(), lane = tid & 63, wave = __builtin_amdgcn_readfirstlane(tid >> 6), l15 = lane & 15, l4 = lane >> 4;
    const bf16_t* proj = (const bf16_t*)(a.ws + WS_PROJ);
    bf16_t* amix = (bf16_t*)(a.ws + WS_AMIX);
    for (int tile = blockIdx.x; tile < MTOK / 64; tile += gridDim.x) {
        const int tok0 = tile * 64, tl0 = tok0 & (T - 1);
        __syncthreads();
#pragma unroll
        for (int q = 0; q < 10; ++q) { const int idx = tid + NTHR * q, r = idx >> 6, ch = idx & 63, tl = tl0 - 8 + r;
            u32x4 v = (u32x4){0u, 0u, 0u, 0u};
            if (tl >= 0 && tl < T) v = *(const u32x4*)(proj + (size_t)(tok0 - 8 + r) * NPROJ + 2048 + 8 * ch);
            *(LAS u32x4*)(lds + r * 1024 + ch * 16) = v; }
        __syncthreads();
        const int g = wave & 3, w = 2 << g, lo = w >> 1, hi = w - lo - 1, ch = 16 * g + l15;
#pragma unroll 2
        for (int q = 0; q < 8; ++q) {
            const int tk = 8 * q + 4 * (wave >> 2) + l4, tl = tl0 + tk;
            float sum[8] = {0, 0, 0, 0, 0, 0, 0, 0};
            for (int j = -lo; j <= hi; ++j) { const u32x4 v = *(const LAS u32x4*)(lds + (tk + 8 + j) * 1024 + ch * 16);
                sum[0] += bflo(v.x); sum[1] += bfhi(v.x); sum[2] += bflo(v.y); sum[3] += bfhi(v.y); sum[4] += bflo(v.z); sum[5] += bfhi(v.z); sum[6] += bflo(v.w); sum[7] += bfhi(v.w); }
            const u32x4 v = *(const LAS u32x4*)(lds + (tk + 8) * 1024 + ch * 16);
            const int s0 = max(tl - lo, 0), e0 = min(tl + hi + 1, T);
            const float inv = 1.f / (float)(e0 - s0);
            u32x4 o; o.x = cvt_pk_bf16(sum[0] * inv - bflo(v.x), sum[1] * inv - bfhi(v.x)); o.y = cvt_pk_bf16(sum[2] * inv - bflo(v.y), sum[3] * inv - bfhi(v.y));
            o.z = cvt_pk_bf16(sum[4] * inv - bflo(v.z), sum[5] * inv - bfhi(v.z)); o.w = cvt_pk_bf16(sum[6] * inv - bflo(v.w), sum[7] * inv - bfhi(v.w));
            *(u32x4*)(amix + (size_t)(tok0 + tk) * D + 512 + 8 * ch) = o;
        }
    }
    __syncthreads();
}

struct ScanSet { bf16x8 xm[4]; bf16x8 yq[4]; u32x2 cw[2]; u32x2 ow; float egl; };
template <int VAR>
__device__ __forceinline__ void ph_scan(const Args& a, LAS unsigned char* lds, int vb) {
    const int tid = tid_fresh(), lane = tid & 63, wave = __builtin_amdgcn_readfirstlane(tid >> 6), l15 = lane & 15, l4 = lane >> 4;
    const float* eglp = (const float*)(a.ws + WS_EGL);
    bf16_t* od = (bf16_t*)(a.ws + (VAR == 0 ? WS_OD : (size_t)464 * MiB));
    const int tn = wave & 3, eo = wave >> 2;
    for (int job = vb; job < 256; job += gridDim.x) {
        const int x = job & 7, j = job >> 3, chain = x * 8 + (j >> 2), sl = j & 3, dir = chain & 1, bh = chain >> 1, b = bh >> 2, h = bh & 3;
        if (VAR == 1 && sl != 0) continue;
        f32x4 acc[2] = {(f32x4){0, 0, 0, 0}, (f32x4){0, 0, 0, 0}};
        const unsigned offx = (unsigned)(wave * 4) * 1024u + (unsigned)l15 * 64u + (unsigned)l4 * 16u;
        const unsigned offc = 32768u + (unsigned)((2 * sl) * 8 + wave) * 512u + (unsigned)l15 * 32u + (unsigned)l4 * 8u;
        const unsigned offq = 65536u + (unsigned)(tn * 4) * 1024u + (unsigned)l15 * 64u + (unsigned)l4 * 16u;
        const unsigned offo = 81920u + (unsigned)(tn * 8 + 2 * sl + eo) * 512u + (unsigned)l15 * 32u + (unsigned)l4 * 8u;
        const long dstep = dir ? -(long)(2 * PREP_STRIDE) : (long)(2 * PREP_STRIDE);
        const int cd0 = (bh * NCH + (dir ? NCH - 1 : 0)) * 2 + dir;
        const GAS unsigned char* pld = (const GAS unsigned char*)(a.ws + WS_PREP + (size_t)cd0 * PREP_STRIDE);
        const GAS float* pegl = (const GAS float*)(eglp + cd0);
        GAS bf16_t* pod = (GAS bf16_t*)od + ((size_t)dir * MTOK + (size_t)(b * T + (dir ? NCH - 1 : 0) * 64 + 16 * tn + l15)) * 512 + h * HD + 32 * sl + 16 * eo + 4 * l4;
        const long ostep = dir ? -(long)(64 * 512) : (long)(64 * 512);
        const long gstep = dir ? -2 : 2;
#define SCAN_LOAD(S) do { asm volatile("" : "+s"(pld), "+s"(pegl)); \
        _Pragma("unroll") for (int ks = 0; ks < 4; ++ks) { S.xm[ks] = *(const GAS bf16x8*)(pld + offx + 1024 * ks); S.yq[ks] = *(const GAS bf16x8*)(pld + offq + 1024 * ks); } \
        _Pragma("unroll") for (int et = 0; et < 2; ++et) S.cw[et] = *(const GAS u32x2*)(pld + offc + 4096 * et); \
        S.ow = *(const GAS u32x2*)(pld + offo); S.egl = *pegl; pld += dstep; pegl += gstep; } while (0)
#define SCAN_STEP(S, SN, step) do { const int cur_ = (step) & 1; \
        _Pragma("unroll") for (int et = 0; et < 2; ++et) *(LAS u32x2*)(lds + cur_ * 8192 + a128(16 * et + l15, 16 * wave + 4 * l4)) = pack4(acc[et]); \
        asm volatile("s_waitcnt lgkmcnt(0)" ::: "memory"); __builtin_amdgcn_s_barrier(); asm volatile("" ::: "memory"); \
        if ((step) + 3 < NCH) SCAN_LOAD(SN); \
        bf16x8 st_[2][4]; \
        _Pragma("unroll") for (int et = 0; et < 2; ++et) _Pragma("unroll") for (int ks = 0; ks < 4; ++ks) st_[et][ks] = frag128(lds + cur_ * 8192, 16 * et, 32 * ks, lane); \
        f32x4 o_; o_[0] = bflo(S.ow.x); o_[1] = bfhi(S.ow.x); o_[2] = bflo(S.ow.y); o_[3] = bfhi(S.ow.y); \
        _Pragma("unroll") for (int ks = 0; ks < 4; ++ks) o_ = MFMA16(eo ? st_[1][ks] : st_[0][ks], S.yq[ks], o_); \
        _Pragma("unroll") for (int et = 0; et < 2; ++et) { \
            acc[et][0] = S.egl * acc[et][0] + bflo(S.cw[et].x); acc[et][1] = S.egl * acc[et][1] + bfhi(S.cw[et].x); acc[et][2] = S.egl * acc[et][2] + bflo(S.cw[et].y); acc[et][3] = S.egl * acc[et][3] + bfhi(S.cw[et].y); \
            _Pragma("unroll") for (int ks = 0; ks < 4; ++ks) acc[et] = MFMA16(S.xm[ks], st_[et][ks], acc[et]); } \
        asm volatile("" : "+v"(pod)); *(GAS u32x2*)pod = pack4(o_); pod += ostep; } while (0)
        ScanSet s0, s1, s2, s3;
        SCAN_LOAD(s0); SCAN_LOAD(s1); SCAN_LOAD(s2);
        __syncthreads();
#pragma unroll
        for (int step = 0; step < NCH; step += 4) {
            SCAN_STEP(s0, s3, step); SCAN_STEP(s1, s0, step + 1); SCAN_STEP(s2, s1, step + 2); SCAN_STEP(s3, s2, step + 3);
        }
#undef SCAN_LOAD
#undef SCAN_STEP
    }
}

__device__ __forceinline__ void ph_delta_out(const Args& a, LAS unsigned char* lds) {
    const int tid = tid_fresh(), lane = tid & 63, wave = tid >> 6, l15 = lane & 15, l4 = lane >> 4;
    const bf16_t* proj = (const bf16_t*)(a.ws + WS_PROJ); const bf16_t* od = (const bf16_t*)(a.ws + WS_OD);
    bf16_t* amix = (bf16_t*)(a.ws + WS_AMIX);
    const f32x4 hw0 = *(const f32x4*)(a.in[8] + 8 * l15), hw1 = *(const f32x4*)(a.in[8] + 8 * l15 + 4);
    const int gw = blockIdx.x * NWAVE + wave, NGW = gridDim.x * NWAVE;
    u32x4 fn = (u32x4){0u, 0u, 0u, 0u}, gn = fn, zn = fn;
    if (gw < MTOK) { const size_t base = (size_t)gw * 512 + 128 * l4 + 8 * l15; fn = *(const u32x4*)(od + base); gn = *(const u32x4*)(od + (size_t)MTOK * 512 + base);
        zn = *(const u32x4*)(proj + (size_t)gw * NPROJ + 1536 + 128 * l4 + 8 * l15); }
    for (int it = gw; it < MTOK; it += NGW) {
        const u32x4 f = fn, g = gn, z = zn;
        if (it + NGW < MTOK) { const size_t base = (size_t)(it + NGW) * 512 + 128 * l4 + 8 * l15; fn = *(const u32x4*)(od + base); gn = *(const u32x4*)(od + (size_t)MTOK * 512 + base);
            zn = *(const u32x4*)(proj + (size_t)(it + NGW) * NPROJ + 1536 + 128 * l4 + 8 * l15); }
        float o[8] = {bflo(f.x) + bflo(g.x), bfhi(f.x) + bfhi(g.x), bflo(f.y) + bflo(g.y), bfhi(f.y) + bfhi(g.y), bflo(f.z) + bflo(g.z), bfhi(f.z) + bfhi(g.z), bflo(f.w) + bflo(g.w), bfhi(f.w) + bfhi(g.w)};
        float ss = 0.f;
#pragma unroll
        for (int e = 0; e < 8; ++e) ss += o[e] * o[e];
        ss += __shfl_xor(ss, 1); ss += __shfl_xor(ss, 2); ss += __shfl_xor(ss, 4); ss += __shfl_xor(ss, 8);
        const float r = rsqrtf(ss * (1.f / HD) + EPS);
        const float zf[8] = {bflo(z.x), bfhi(z.x), bflo(z.y), bfhi(z.y), bflo(z.z), bfhi(z.z), bflo(z.w), bfhi(z.w)};
        u32x4 w;
        w.x = cvt_pk_bf16(o[0] * r * hw0[0] * silu_f(zf[0]), o[1] * r * hw0[1] * silu_f(zf[1])); w.y = cvt_pk_bf16(o[2] * r * hw0[2] * silu_f(zf[2]), o[3] * r * hw0[3] * silu_f(zf[3]));
        w.z = cvt_pk_bf16(o[4] * r * hw1[0] * silu_f(zf[4]), o[5] * r * hw1[1] * silu_f(zf[5])); w.w = cvt_pk_bf16(o[6] * r * hw1[2] * silu_f(zf[6]), o[7] * r * hw1[3] * silu_f(zf[7]));
        *(u32x4*)(amix + (size_t)it * D + 128 * l4 + 8 * l15) = w;
    }
}

__device__ __forceinline__ int block_sum(int v, LAS int* slot8, int wave, int lane) {
#pragma unroll
    for (int o = 1; o < 64; o <<= 1) v += __shfl_xor(v, o);
    if (lane == 0) slot8[wave] = v;
    __syncthreads();
    int s = 0;
#pragma unroll
    for (int w = 0; w < 8; ++w) s += slot8[w];
    return s;
}
__device__ __forceinline__ int block_excl_scan(int v, LAS int* slot8, int wave, int lane) {
    int inc = v;
#pragma unroll
    for (int o = 1; o < 64; o <<= 1) { const int t = __shfl_up(inc, o); if (lane >= o) inc += t; }
    if (lane == 63) slot8[wave] = inc;
    __syncthreads();
    int off = 0;
#pragma unroll
    for (int w = 0; w < 8; ++w) off += (w < wave) ? slot8[w] : 0;
    return off + inc - v;
}
__device__ __forceinline__ void ph_topk_gather(const Args& a, LAS unsigned char* lds) {
    const int tid = tid_fresh(), lane = tid & 63, wave = tid >> 6;
    const float* probs = (const float*)(a.ws + WS_PROBS);
    int* inv = (int*)(a.ws + WS_INV); int* seli = (int*)(a.ws + WS_SELI); float* selg = (float*)(a.ws + WS_SELG);
    LAS int* red = (LAS int*)lds;
    for (int job = blockIdx.x; job < NB * NE; job += gridDim.x) {
        const int be = job, b = be >> 4, e = be & 15;
        if (tid == 0) { unsigned* ctl = (unsigned*)(a.ws + WS_CTL);
            XB_SPIN(xb_ld(&ctl[XB_PRB(b)]) < 128u, ctl);
            __builtin_amdgcn_fence(__ATOMIC_ACQUIRE, "agent");
            asm volatile("s_waitcnt vmcnt(0)" ::: "memory"); }
        __syncthreads();
        unsigned v[4];
#pragma unroll
        for (int j = 0; j < 4; ++j) v[j] = __float_as_uint(probs[(size_t)(b * T + 4 * tid + j) * 16 + e]);
        __syncthreads();
        unsigned thr = 0u;
#pragma unroll 1
        for (int rd = 0; rd < 8; ++rd) { const int sh = 28 - 4 * rd;
            LAS int* slot = red + 128 * (rd & 1);
#pragma unroll
            for (int i = 1; i < 16; ++i) { const unsigned cand = thr | ((unsigned)i << sh); int c = 0;
#pragma unroll
                for (int j = 0; j < 4; ++j) c += (int)__builtin_popcountll(__ballot(v[j] >= cand));
                if (lane == 0) slot[wave * 16 + i] = c; }
            __syncthreads();
            int best = 0;
#pragma unroll
            for (int i = 1; i < 16; ++i) { int c = 0;
#pragma unroll
                for (int w8 = 0; w8 < 8; ++w8) c += slot[w8 * 16 + i];
                best = (c >= CAP) ? i : best; }
            thr |= (unsigned)best << sh; }
        __syncthreads();
        int cgt = 0, ceq = 0;
#pragma unroll
        for (int j = 0; j < 4; ++j) { cgt += (v[j] > thr) ? 1 : 0; ceq += (v[j] == thr) ? 1 : 0; }
        const int tot_gt = block_sum(cgt, red + 8 * 32, wave, lane);
        const int need_eq = CAP - tot_gt;
        const int eq_before = block_excl_scan(ceq, red + 8 * 33, wave, lane);
        int sel[4], nsel = 0, eqc = eq_before;
#pragma unroll
        for (int j = 0; j < 4; ++j) { const bool iseq = (v[j] == thr); sel[j] = (v[j] > thr) || (iseq && eqc < need_eq); eqc += iseq ? 1 : 0; nsel += sel[j]; }
        int slot = block_excl_scan(nsel, red + 8 * 34, wave, lane);
#pragma unroll
        for (int j = 0; j < 4; ++j) { const int t = 4 * tid + j;
            if (sel[j]) { seli[be * CAP + slot] = b * T + t; selg[be * CAP + slot] = __uint_as_float(v[j]); }
            inv[(size_t)(b * T + t) * 16 + e] = sel[j] ? slot : -1;
            slot += sel[j]; }
        __syncthreads();
    }
}

__device__ __forceinline__ void ph_final(const Args& a, bool with_ffn) {
    const int tid = tid_fresh(), lane = tid & 63, wave = tid >> 6;
    const int* inv = (const int*)(a.ws + WS_INV); const bf16_t* y = (const bf16_t*)(a.ws + WS_Y); const float* selg = (const float*)(a.ws + WS_SELG);
    const f32x4* nw4 = (const f32x4*)a.in[17] + lane;
    f32x4 w4[4];
#pragma unroll
    for (int j = 0; j < 4; ++j) w4[j] = nw4[64 * j];
    const int gw = blockIdx.x * NWAVE + wave, NGW = gridDim.x * NWAVE;
    f32x4 vn[4]; int invn = -1;
    if (gw < MTOK) { const f32x4* xr0 = (const f32x4*)(a.out + (size_t)gw * D) + lane;
#pragma unroll
        for (int j = 0; j < 4; ++j) vn[j] = xr0[64 * j];
        if (with_ffn && lane < NE) invn = inv[(size_t)gw * 16 + lane]; }
    for (int row = gw; row < MTOK; row += NGW) {
        f32x4* xr = (f32x4*)(a.out + (size_t)row * D) + lane;
        f32x4 v[4];
#pragma unroll
        for (int j = 0; j < 4; ++j) v[j] = vn[j];
        const int myinv = invn;
        if (row + NGW < MTOK) { const f32x4* xr1 = (const f32x4*)(a.out + (size_t)(row + NGW) * D) + lane;
#pragma unroll
            for (int j = 0; j < 4; ++j) vn[j] = xr1[64 * j];
            invn = (with_ffn && lane < NE) ? inv[(size_t)(row + NGW) * 16 + lane] : -1; }
        if (with_ffn) {
            const int b = row >> 11;
            unsigned long long mask = __ballot(myinv >= 0);
            while (mask) {
                int yrow[4]; float gq[4];
#pragma unroll
                for (int q = 0; q < 4; ++q) { const bool ok = mask != 0ull; const int e = ok ? (int)__builtin_ctzll(mask) : 0; if (ok) mask &= mask - 1ull;
                    const int sl = __shfl(myinv, e); yrow[q] = (b * NE + e) * CAP + (ok ? sl : 0); gq[q] = ok ? selg[yrow[q]] : 0.f; }
                u32x2 wq[4][4];
#pragma unroll
                for (int q = 0; q < 4; ++q) { const u32x2* yr = (const u32x2*)(y + (size_t)yrow[q] * D) + lane;
#pragma unroll
                    for (int j = 0; j < 4; ++j) wq[q][j] = yr[64 * j]; }
#pragma unroll
                for (int q = 0; q < 4; ++q)
#pragma unroll
                    for (int j = 0; j < 4; ++j) { v[j].x += gq[q] * bflo(wq[q][j].x); v[j].y += gq[q] * bfhi(wq[q][j].x); v[j].z += gq[q] * bflo(wq[q][j].y); v[j].w += gq[q] * bfhi(wq[q][j].y); }
            }
        }
        float ss = 0.f;
#pragma unroll
        for (int j = 0; j < 4; ++j) ss += (v[j].x * v[j].x + v[j].y * v[j].y) + (v[j].z * v[j].z + v[j].w * v[j].w);
        const float r = rsqrtf(wave_sum(ss) * (1.f / D) + EPS);
#pragma unroll
        for (int j = 0; j < 4; ++j) xr[64 * j] = v[j] * r * w4[j];
    }
}

#ifndef EXP_VAR
#define EXP_VAR 0
#endif
#ifndef DBL_MASK
#define DBL_MASK 0
#endif
#ifndef PH_PER_LAUNCH
#define PH_PER_LAUNCH 1
#endif
#ifndef PLAIN_LAUNCH
#define PLAIN_LAUNCH 0
#endif
#ifndef USE_CG_SYNC
#define USE_CG_SYNC 0
#endif
#ifndef ONE_LAUNCH
#define ONE_LAUNCH 1
#endif
#ifndef DBG_STAGE
#define DBG_STAGE 3
#endif
typedef const __attribute__((address_space(4))) Args* CArgsP;
__device__ __forceinline__ Args fresh_args() {
    Args r{};
#if defined(__HIP_DEVICE_COMPILE__)
    const __attribute__((address_space(4))) unsigned long long* p = (const __attribute__((address_space(4))) unsigned long long*)__builtin_amdgcn_kernarg_segment_ptr();
    asm volatile("" : "+s"(p));
#pragma unroll
    for (int i = 0; i < 18; ++i) r.in[i] = (const float*)(const __attribute__((address_space(1))) float*)p[i];
    r.out = (float*)(__attribute__((address_space(1))) float*)p[18]; r.ws = (unsigned char*)(__attribute__((address_space(1))) unsigned char*)p[19]; r.ph_lo = (int)(unsigned)p[20]; r.ph_hi = (int)(p[20] >> 32);
#endif
    return r;
}
template <int LO, int HI>
__global__ void __launch_bounds__(NTHR, 2) fwd_kernel(Args a_unused) {
    extern __shared__ __attribute__((aligned(16))) unsigned char lds_raw[];
    LAS unsigned char* lds = (LAS unsigned char*)lds_raw;
    int rlo = LO, rhi = HI;
    if constexpr (HI - LO > 1) { const Args a = fresh_args(); rlo = a.ph_lo; rhi = a.ph_hi; }
#define IN(k) (LO <= (k) && (k) < HI)
#define RIN(k) (rlo <= (k) && (k) < rhi)
    XcdBarrier bar; bar.bar = nullptr; bar.x = 0; bar.st = nullptr;
    if constexpr (HI - LO > 1) {
        volatile LAS unsigned* st = (volatile LAS unsigned*)(lds + LDS_BYTES - 16);
        if (threadIdx.x == 0) { st[0] = 0u; st[1] = 0u; }
        __syncthreads();
        const Args a = fresh_args();
        bar = xcd_barrier_post((unsigned*)(a.ws + WS_CTL), st);
    }
#if USE_CG_SYNC
#define SEAM(k) do { if constexpr (IN(k) && IN((k) + 1)) { cooperative_groups::this_grid().sync(); } } while (0)
#else
#define SEAM(k) do { if constexpr (IN(k) && IN((k) + 1)) { if (RIN(k) && RIN((k) + 1)) xcd_barrier(bar); } } while (0)
#endif
    if constexpr (IN(0)) if (RIN(0)) { const Args a = fresh_args(); ph_prologue(a, lds); }
    SEAM(0);
    int vb = blockIdx.x;
    if constexpr (HI - LO > 1) {
        if (RIN(0) && RIN(1)) {
            volatile LAS unsigned* st = (volatile LAS unsigned*)(lds + LDS_BYTES - 16);
            if (threadIdx.x == 0) { bool ok = gridDim.x == 256;
                for (unsigned j = 0; j < 16; ++j) { const unsigned c = xb_ld(&bar.bar[XB_XCNT(j)]); ok = ok && (j < 8 ? c == 32u : c == 0u); }
                st[3] = ok ? (bar.x + 8u * st[2]) : blockIdx.x; }
            __syncthreads();
            vb = __builtin_amdgcn_readfirstlane((int)st[3]);
        }
    }
    if constexpr (IN(1)) if (RIN(1)) { const Args a = fresh_args(); pg8::Gemm g{(const bf16_t*)(a.ws + WS_XN), (const bf16_t*)(a.ws + WS_WIN), D, nullptr}; pg8::StaticOrder S; S.init(MTOK, NPROJ, gridDim.x, vb);
        pg8::EpiProj E{(bf16_t*)(a.ws + WS_PROJ), NPROJ}; pg8::gemm_phase(lds, g, S, E);
        if (DBG_STAGE >= 3) { if (gridDim.x == 256) expert_weight_cvt<true>(a, lds, 0, NEARLY * 1024, 128, 128, vb); else expert_weight_cvt<true>(a, lds, 0, NEARLY * 1024, 0, gridDim.x, blockIdx.x); } }
    SEAM(1);
    if constexpr (IN(2)) if (RIN(2)) { const Args a = fresh_args(); ph_pool(a, lds); if (DBG_STAGE >= 2) ph_chunk_prep(a, lds); }
    SEAM(2);
    if constexpr (IN(3)) if (RIN(3)) { const Args a = fresh_args(); if (DBG_STAGE >= 2) ph_scan<0>(a, lds, vb); }
    SEAM(3);
    if constexpr (IN(4)) if (RIN(4)) { const Args a = fresh_args(); if (DBG_STAGE >= 2) ph_delta_out(a, lds); }
    SEAM(4);
    if constexpr (IN(5)) if (RIN(5)) { { const Args a = fresh_args(); pg8::Gemm g{(const bf16_t*)(a.ws + WS_AMIX), (const bf16_t*)(a.ws + WS_WMIX), D, nullptr}; pg8::StaticOrder S; S.init(MTOK, D, gridDim.x, vb);
        pg8::EpiResid E{a.in[0], a.out, D}; pg8::gemm_phase(lds, g, S, E); }
        if (DBG_STAGE >= 3) { const Args a = fresh_args(); expert_weight_cvt<false>(a, lds, 0, CVT_SPLIT, 0, gridDim.x, blockIdx.x); } }
    SEAM(5);
    if constexpr (IN(6)) if (RIN(6)) { const Args a = fresh_args(); if (DBG_STAGE >= 3) row_pass<1>(a, lds); }
    if constexpr (IN(7)) if (RIN(7)) { const Args a = fresh_args(); if (DBG_STAGE >= 3) { ph_topk_gather(a, lds); if (gridDim.x > NB * NE) expert_weight_cvt<false>(a, lds, CVT_SPLIT, CVT_ITEMS, NB * NE, gridDim.x - NB * NE, blockIdx.x); else expert_weight_cvt<false>(a, lds, CVT_SPLIT, CVT_ITEMS, 0, gridDim.x, blockIdx.x); } }
    SEAM(7);
    if constexpr (IN(8)) if (RIN(8)) { if (DBG_STAGE >= 3) { const Args a = fresh_args(); pg8::Gemm g{(const bf16_t*)(a.ws + WS_XN), (const bf16_t*)(a.ws + WS_WGU), D, (const int*)(a.ws + WS_SELI)}; pg8::ExpertOrder S; S.init(vb, 16);
        pg8::EpiSwiglu E{(bf16_t*)(a.ws + WS_HMID)}; pg8::gemm_phase<pg8::EpiSwiglu, pg8::ExpertOrder, true>(lds, g, S, E); } }
    SEAM(8);
    if constexpr (IN(9)) if (RIN(9)) { if (DBG_STAGE >= 3) { const Args a = fresh_args(); pg8::Gemm g{(const bf16_t*)(a.ws + WS_HMID), (const bf16_t*)(a.ws + WS_WD), FF, nullptr}; pg8::ExpertOrder S; S.init(vb, 4, NEARLY, (int)((WS_WDA - WS_WD) / ((size_t)256 * FF * 2)));
        pg8::EpiDown E{(bf16_t*)(a.ws + WS_Y)}; pg8::gemm_phase(lds, g, S, E); } }
    SEAM(9);
    if constexpr (IN(10)) if (RIN(10)) { const Args a = fresh_args(); ph_final(a, DBG_STAGE >= 3); }
#undef IN
#undef SEAM
}
template <int VAR> __global__ void __launch_bounds__(NTHR, 2) exp_scan_kernel(Args a_unused) {
    extern __shared__ __attribute__((aligned(16))) unsigned char lds_raw[];
    const Args a = fresh_args(); ph_scan<VAR>(a, (LAS unsigned char*)lds_raw, blockIdx.x);
}
template <int P> static void launch_phase(const Args& a, hipStream_t stream) {
    static bool attr = false;
    if (!attr) { (void)hipFuncSetAttribute((const void*)fwd_kernel<P, P + 1>, hipFuncAttributeMaxDynamicSharedMemorySize, LDS_BYTES); attr = true; }
    hipLaunchKernelGGL((fwd_kernel<P, P + 1>), dim3(NBLK), dim3(NTHR), LDS_BYTES, stream, a);
}

extern "C" void kernel_launch(void* const* d_in, const int* in_sizes, int n_in, void* d_out, int out_size, void* d_ws, size_t ws_size, hipStream_t stream) {
    if (n_in != 18 || out_size != MTOK * D || ws_size < WS_END) { fprintf(stderr, "kernel_launch: unexpected shapes (n_in %d out %d ws %zu)\n", n_in, out_size, ws_size); return; }
    Args a{};
    for (int i = 0; i < 18; ++i) a.in[i] = (const float*)d_in[i];
    a.out = (float*)d_out; a.ws = (unsigned char*)d_ws;
    if (DBG_STAGE < 2) (void)hipMemsetAsync((char*)d_ws + WS_AMIX, 0, 32 * MiB, stream);
#if ONE_LAUNCH
    static int grid = 0;
    if (!grid) {
        int dev = 0, cus = 0, per_cu = 0;
        (void)hipGetDevice(&dev); (void)hipDeviceGetAttribute(&cus, hipDeviceAttributeMultiprocessorCount, dev);
        (void)hipFuncSetAttribute((const void*)fwd_kernel<0, 11>, hipFuncAttributeMaxDynamicSharedMemorySize, LDS_BYTES);
        (void)hipOccupancyMaxActiveBlocksPerMultiprocessor(&per_cu, (const void*)fwd_kernel<0, 11>, NTHR, LDS_BYTES);
        grid = (per_cu >= 1 && cus >= NBLK) ? NBLK : -1;
        if (grid < 0) fprintf(stderr, "kernel_launch: needs %d co-resident workgroups (cus %d, per_cu %d)\n", NBLK, cus, per_cu);
    }
    if (grid < 0) return;
    (void)hipMemsetAsync((char*)d_ws + WS_CTL, 0, 16384, stream);
    void* kargs[] = {(void*)&a};
#if PLAIN_LAUNCH
    (void)kargs;
    for (int p = 0; p < 11; p += PH_PER_LAUNCH) { a.ph_lo = p; a.ph_hi = (p + PH_PER_LAUNCH < 11) ? p + PH_PER_LAUNCH : 11;
        for (int rep = 0; rep < (((DBL_MASK >> p) & 1) ? 2 : 1); ++rep) hipLaunchKernelGGL((fwd_kernel<0, 11>), dim3(NBLK), dim3(NTHR), LDS_BYTES, stream, a);
#if EXP_VAR
        if (p == 3) { static bool at = false; if (!at) { (void)hipFuncSetAttribute((const void*)exp_scan_kernel<EXP_VAR>, hipFuncAttributeMaxDynamicSharedMemorySize, LDS_BYTES); at = true; }
            hipLaunchKernelGGL((exp_scan_kernel<EXP_VAR>), dim3(NBLK), dim3(NTHR), LDS_BYTES, stream, a); }
#endif
    }
#else
    a.ph_lo = 0; a.ph_hi = 11;
    hipError_t e = hipLaunchCooperativeKernel((const void*)fwd_kernel<0, 11>, dim3(NBLK), dim3(NTHR), kargs, LDS_BYTES, stream);
    if (e != hipSuccess) fprintf(stderr, "cooperative launch failed: %s\n", hipGetErrorString(e));
#endif
#else
    launch_phase<0>(a, stream); launch_phase<1>(a, stream); launch_phase<2>(a, stream); launch_phase<3>(a, stream); launch_phase<4>(a, stream); launch_phase<5>(a, stream);
    launch_phase<6>(a, stream); launch_phase<7>(a, stream); launch_phase<8>(a, stream); launch_phase<9>(a, stream); launch_phase<10>(a, stream);
#endif
}
#ifdef TEST_LO
template __global__ void fwd_kernel<TEST_LO, TEST_HI>(Args);
#endif
```

```cpp
#include <hip/hip_runtime.h>
#include <hip/hip_cooperative_groups.h>
#include <cstdio>
#include <cstdint>

#define LAS __attribute__((address_space(3)))
#define GAS __attribute__((address_space(1)))
typedef unsigned short bf16_t;
typedef short bf16x8 __attribute__((ext_vector_type(8)));
typedef float f32x4 __attribute__((ext_vector_type(4)));
typedef float f32x2 __attribute__((ext_vector_type(2)));
typedef unsigned u32x4 __attribute__((ext_vector_type(4)));
typedef unsigned u32x2 __attribute__((ext_vector_type(2)));

constexpr int NB = 8, T = 2048, D = 1024, MTOK = NB * T;
constexpr int INC = 2576, NPROJ = 2560;
constexpr int NH = 4, HD = 128, NCH = T / 64;
constexpr int NE = 16, CAP = 256, FF = 2048;
constexpr float EPS = 1e-6f;
constexpr int NBLK = 256, NTHR = 512, NWAVE = 8;
constexpr int LDS_BYTES = 155648;

constexpr size_t MiB = (size_t)1 << 20;
constexpr size_t WS_CTL = 0;
constexpr size_t WS_WIN = 1 * MiB;
constexpr size_t WS_WMIX = 6 * MiB;
constexpr size_t WS_PREP = 8 * MiB;
constexpr size_t WS_WGU = 8 * MiB;
constexpr size_t WS_WD = 136 * MiB;
constexpr size_t WS_XN = 200 * MiB;
constexpr size_t WS_AMIX = 232 * MiB;
constexpr size_t WS_Y = 200 * MiB;
constexpr size_t WS_GATES = 264 * MiB;
constexpr size_t WS_PROBS = 265 * MiB;
constexpr size_t WS_INV = 266 * MiB;
constexpr size_t WS_SELI = 267 * MiB;
constexpr size_t WS_SELG = 267 * MiB + 131072;
constexpr size_t WS_EGL = 267 * MiB + 262144;
constexpr size_t WS_PROJ = 268 * MiB;
constexpr size_t WS_XG = 268 * MiB;
constexpr size_t WS_OD = 348 * MiB;
constexpr size_t WS_HB = 268 * MiB;
constexpr size_t WS_HMID = 332 * MiB;
constexpr size_t WS_WDA = 460 * MiB;
constexpr int NEARLY = 5;
constexpr size_t WS_END = 480 * MiB;
constexpr size_t PREP_STRIDE = 98304;

struct Args { const float* in[18]; float* out; unsigned char* ws; int ph_lo, ph_hi; };

typedef __bf16 bf16v2_t __attribute__((ext_vector_type(2)));
__device__ __forceinline__ unsigned cvt_pk_bf16_asm(float lo, float hi) { unsigned r; asm volatile("v_cvt_pk_bf16_f32 %0, %1, %2" : "=v"(r) : "v"(lo), "v"(hi)); return r; }
__device__ __forceinline__ unsigned cvt_pk_bf16(float lo, float hi) { f32x2 f = {lo, hi}; return __builtin_bit_cast(unsigned, __builtin_convertvector(f, bf16v2_t)); }
__device__ __forceinline__ float bf2f(unsigned h) { return __uint_as_float(h << 16); }
__device__ __forceinline__ float bflo(unsigned w) { return __uint_as_float(w << 16); }
__device__ __forceinline__ float bfhi(unsigned w) { return __uint_as_float(w & 0xffff0000u); }
__device__ __forceinline__ float wave_sum(float v) {
#pragma unroll
    for (int o = 1; o < 64; o <<= 1) v += __shfl_xor(v, o);
    return v;
}
__device__ __forceinline__ int tid_fresh() { int t = threadIdx.x; asm volatile("" : "+v"(t)); return t; }
__device__ __forceinline__ float silu_f(float x) { return x * __builtin_amdgcn_rcpf(1.f + __expf(-x)); }
__device__ __forceinline__ float sigmoid_f(float x) { return __builtin_amdgcn_rcpf(1.f + __expf(-x)); }
__device__ __forceinline__ float softplus_f(float x) { return fmaxf(x, 0.f) + log1pf(__expf(-fabsf(x))); }

namespace pg8 {
constexpr int BM = 256, BK = 64, HALF = 128, HTB = HALF * BK * 2, STAGE_BYTES = 8 * HTB, NXCD = 8, WGM = 8;
__host__ __device__ __forceinline__ int lds_byte(int r, int c) { const int st = (r >> 4) * 2 + (c >> 5), rr = r & 15, cc = c & 31, ob = rr * 64 + cc * 2; return st * 1024 + (ob ^ (((ob >> 9) & 1) << 5)); }
__host__ __device__ __forceinline__ void stage_rc(int b, int& R, int& C) { const int st = b / 1024, sb = b % 1024, swz = sb ^ (((sb >> 9) & 1) << 5); R = (st >> 1) * 16 + swz / 64; C = (st & 1) * 32 + (swz % 64) / 2; }
__host__ __device__ __forceinline__ int perm32(int rho) { const int n = rho >> 4, i = rho & 15; return 8 * (i >> 2) + 4 * n + (i & 3); }

struct Unit { int pm, pn; };
struct Gemm { const bf16_t* A; const bf16_t* Bt; int K; const int* gidx; };

struct StaticOrder {
    int nM, nN, nwg, G, c;
    __device__ void init(int M, int N, int G_, int c_) { nM = M / BM; nN = N / BM; nwg = nM * nN; G = G_; c = c_; }
    __device__ int pm_of(int) const { return 0; }
    __device__ bool next(int i, Unit& u) const {
        const long L = (long)i * G + c; if (L >= nwg) return false;
        int wgid = (int)L; { const int q = nwg / NXCD, r = nwg % NXCD, xcd = wgid % NXCD, off = wgid / NXCD; wgid = (xcd < r ? xcd * (q + 1) : r * (q + 1) + (xcd - r) * q) + off; }
        const int nig = WGM * nN, gid = wgid / nig, fm = gid * WGM, gsz = (nM - fm) < WGM ? (nM - fm) : WGM;
        u.pm = fm + ((wgid % nig) % gsz); u.pn = (wgid % nig) / gsz; return true;
    }
};
struct ExpertOrder {
    int x, b, pnq, ntile, rounds, rpe, early, eshift;
    __device__ void init(int c, int ntile_, int early_ = 0, int eshift_ = 0) { x = c & 7; const int j = c >> 3; b = j & 7; pnq = j >> 3; ntile = ntile_; rpe = ntile_ >> 2; rounds = 2 * rpe; early = early_; eshift = eshift_; }
    __device__ bool next(int i, Unit& u) const { if (i >= rounds) return false; const int e = 2 * x + (i / rpe); u.pm = b * NE + e; u.pn = e * ntile + 4 * (i % rpe) + pnq + (e < early ? eshift : 0); return true; }
    __device__ int pm_of(int k) const { return b * NE + 2 * x + k; }
};

template <class Epi, class Sched, bool GATHER = false>
__device__ __forceinline__ void gemm_phase(LAS unsigned char* lds, const Gemm g, const Sched& S, const Epi& E) {
    const int tid = tid_fresh(), wid = __builtin_amdgcn_readfirstlane(tid >> 6), lane = tid & 63, wr = wid >> 2, wc = wid & 3, fr = lane & 15, fq = lane >> 4;
    const int K = g.K, nt = K / BK;
    unsigned voffA[2], voffB[2];
#pragma unroll
    for (int i = 0; i < 2; ++i) { int R, C; stage_rc(tid * 16 + i * 8192, R, C); const int Rb = Epi::PERM ? ((R & ~31) + perm32(R & 31)) : R;
        voffA[i] = (unsigned)(R * K + C) * 2u; voffB[i] = (unsigned)(Rb * K + C) * 2u; }
    const size_t kstep = (size_t)(BK * 2);
    const size_t hstep = (size_t)HALF * K * 2;
    const size_t tstep = 2 * hstep;
    const size_t tstepA = GATHER ? 0 : tstep;
    unsigned tab[2][2][2];
    const int pmB = S.pm_of(1);
    if constexpr (GATHER) {
#pragma unroll
        for (int ei = 0; ei < 2; ++ei)
#pragma unroll
            for (int hf = 0; hf < 2; ++hf)
#pragma unroll
                for (int i = 0; i < 2; ++i) { int R, C; stage_rc(tid * 16 + i * 8192, R, C); tab[ei][hf][i] = (unsigned)(g.gidx[S.pm_of(ei) * BM + hf * HALF + R] * K + C) * 2u; }
    }
#define PG8_STAGE_A(bufoff, gbase, hf, ei) do { if constexpr (GATHER) { unsigned v_[2]; v_[0] = (ei) ? tab[1][hf][0] : tab[0][hf][0]; v_[1] = (ei) ? tab[1][hf][1] : tab[0][hf][1]; PG8_STAGE(bufoff, gbase, v_); } \
        else { PG8_STAGE(bufoff, (gbase) + (hf) * hstep, voffA); } } while (0)
    const unsigned ldsw = (unsigned)wid * 1024u;
    const int aoff = lds_byte(wr * 64 + fr, fq * 8), boff = lds_byte(wc * 32 + fr, fq * 8);
#define PG8_SA(b, h) (((b) * 2 + (h)) * HTB)
#define PG8_SB(b, h) ((4 + (b) * 2 + (h)) * HTB)
#define PG8_STAGE(bufoff, gbase, voff) do { _Pragma("unroll") for (int _i = 0; _i < 2; ++_i) \
        __builtin_amdgcn_global_load_lds((const unsigned*)((const char*)(gbase) + (voff)[_i]), (LAS unsigned*)(lds + (bufoff) + ldsw + _i * 8192), 16, 0, 0); } while (0)
#define PG8_LDA(dst, b, h) do { _Pragma("unroll") for (int m = 0; m < 4; ++m) _Pragma("unroll") for (int k = 0; k < 2; ++k) dst[m][k] = *(const LAS bf16x8*)(lds + PG8_SA(b, h) + aoff + m * 2048 + k * 1024); } while (0)
#define PG8_LDB(dst, b, h) do { _Pragma("unroll") for (int n = 0; n < 2; ++n) _Pragma("unroll") for (int k = 0; k < 2; ++k) dst[n][k] = *(const LAS bf16x8*)(lds + PG8_SB(b, h) + boff + n * 2048 + k * 1024); } while (0)
#define PG8_MMA(ai, bj, At, Bt) do { __builtin_amdgcn_s_setprio(1); _Pragma("unroll") for (int m = 0; m < 4; ++m) _Pragma("unroll") for (int n = 0; n < 2; ++n) _Pragma("unroll") for (int k = 0; k < 2; ++k) \
        acc[ai][bj][m][n] = __builtin_amdgcn_mfma_f32_16x16x32_bf16(Bt[n][k], At[m][k], acc[ai][bj][m][n], 0, 0, 0); __builtin_amdgcn_s_setprio(0); } while (0)
#define PG8_WAIT_V(n) asm volatile("s_waitcnt vmcnt(" #n ")" ::: "memory")
#define PG8_WAIT_L(n) asm volatile("s_waitcnt lgkmcnt(" #n ")" ::: "memory")
#define PG8_BAR __builtin_amdgcn_s_barrier()
#define PG8_SCHED __builtin_amdgcn_sched_barrier(0)
    Unit cur, nxt; int ui = 0;
    if (!S.next(0, cur)) return;
    f32x4 acc[2][2][4][2];
#pragma unroll
    for (int a = 0; a < 2; ++a)
#pragma unroll
        for (int b = 0; b < 2; ++b)
#pragma unroll
            for (int m = 0; m < 4; ++m)
#pragma unroll
                for (int n = 0; n < 2; ++n) acc[a][b][m][n] = (f32x4){0.f, 0.f, 0.f, 0.f};
    bf16x8 At[4][2], B0[2][2], B1[2][2];
    const char* cA = (const char*)g.A + (size_t)cur.pm * tstepA; const char* cB = (const char*)g.Bt + (size_t)cur.pn * tstep;
    bool cur_ei = GATHER && cur.pm == pmB, nxt_ei = cur_ei;
    PG8_STAGE(PG8_SB(0, 0), cB, voffB); PG8_STAGE(PG8_SB(0, 1), cB + hstep, voffB); PG8_STAGE_A(PG8_SA(0, 0), cA, 0, cur_ei); PG8_STAGE_A(PG8_SA(0, 1), cA, 1, cur_ei);
    if (wr == 1) PG8_BAR;
    PG8_WAIT_V(2); PG8_BAR;
    PG8_STAGE(PG8_SB(1, 0), cB + kstep, voffB); PG8_STAGE_A(PG8_SA(1, 0), cA + kstep, 0, cur_ei); PG8_STAGE(PG8_SB(1, 1), cB + hstep + kstep, voffB);
    PG8_WAIT_V(6); PG8_BAR;
    for (;;) {
        const bool has_next = S.next(ui + 1, nxt);
        const char* nA = has_next ? (const char*)g.A + (size_t)nxt.pm * tstepA : cA; const char* nB = has_next ? (const char*)g.Bt + (size_t)nxt.pn * tstep : cB;
        nxt_ei = has_next ? (GATHER && nxt.pm == pmB) : cur_ei;
        for (int t = 0; t < nt; t += 2) {
            const bool last = (t == nt - 2);
            const char* a1 = cA + (size_t)(t + 1) * kstep;
            const char* a2 = last ? nA : cA + (size_t)(t + 2) * kstep; const char* b2 = last ? nB : cB + (size_t)(t + 2) * kstep;
            const char* a3 = a2 + kstep; const char* b3 = b2 + kstep;
            const bool e2 = last ? nxt_ei : cur_ei;
            PG8_LDB(B0, 0, 0); PG8_LDB(B1, 0, 1); PG8_SCHED; PG8_LDA(At, 0, 0); PG8_STAGE_A(PG8_SA(1, 1), a1, 1, cur_ei);
            PG8_WAIT_V(8); PG8_WAIT_L(0); PG8_BAR; PG8_MMA(0, 0, At, B0); PG8_MMA(0, 1, At, B1); PG8_BAR; PG8_SCHED;
            PG8_LDA(At, 0, 1); PG8_STAGE(PG8_SB(0, 0), b2, voffB); PG8_STAGE(PG8_SB(0, 1), b2 + hstep, voffB); PG8_STAGE_A(PG8_SA(0, 0), a2, 0, e2);
            PG8_WAIT_V(8); PG8_WAIT_L(0); PG8_BAR; PG8_MMA(1, 0, At, B0); PG8_MMA(1, 1, At, B1); PG8_BAR; PG8_SCHED;
            PG8_LDB(B0, 1, 0); PG8_LDB(B1, 1, 1); PG8_SCHED; PG8_LDA(At, 1, 0); PG8_STAGE_A(PG8_SA(0, 1), a2, 1, e2);
            PG8_WAIT_V(8); PG8_WAIT_L(0); PG8_BAR; PG8_MMA(0, 0, At, B0); PG8_MMA(0, 1, At, B1); PG8_BAR; PG8_SCHED;
            PG8_LDA(At, 1, 1); PG8_STAGE(PG8_SB(1, 0), b3, voffB); PG8_STAGE(PG8_SB(1, 1), b3 + hstep, voffB); PG8_STAGE_A(PG8_SA(1, 0), a3, 0, e2);
            PG8_WAIT_V(8); PG8_WAIT_L(0); PG8_BAR; PG8_MMA(1, 0, At, B0); PG8_MMA(1, 1, At, B1); PG8_BAR; PG8_SCHED;
        }
        if (wr == 0) PG8_BAR;
        E(acc, cur, wr, wc, fr, fq);
        if (!has_next) break;
#pragma unroll
        for (int a = 0; a < 2; ++a)
#pragma unroll
            for (int b = 0; b < 2; ++b)
#pragma unroll
                for (int m = 0; m < 4; ++m)
#pragma unroll
                    for (int n = 0; n < 2; ++n) acc[a][b][m][n] = (f32x4){0.f, 0.f, 0.f, 0.f};
        cur = nxt; cA = nA; cB = nB; cur_ei = nxt_ei; ++ui;
        if (wr == 1) PG8_BAR;
    }
    PG8_WAIT_V(0);
    PG8_BAR;
#undef PG8_SA
#undef PG8_SB
#undef PG8_STAGE
#undef PG8_STAGE_A
#undef PG8_LDA
#undef PG8_LDB
#undef PG8_MMA
#undef PG8_WAIT_V
#undef PG8_WAIT_L
#undef PG8_BAR
#undef PG8_SCHED
}
struct EpiProj {
    static constexpr bool PERM = true;
    bf16_t* O; int ldc;
    __device__ __forceinline__ void operator()(const f32x4 (&acc)[2][2][4][2], const Unit& u, int wr, int wc, int fr, int fq) const {
        const int row0 = u.pm * BM + wr * 64 + fr, col0 = u.pn * BM + wc * 32 + 8 * fq;
#pragma unroll
        for (int ai = 0; ai < 2; ++ai)
#pragma unroll
            for (int m = 0; m < 4; ++m) { bf16_t* rowp = O + (size_t)(row0 + ai * HALF + m * 16) * ldc + col0;
#pragma unroll
                for (int bj = 0; bj < 2; ++bj) { const f32x4 v0 = acc[ai][bj][m][0], v1 = acc[ai][bj][m][1];
                    u32x4 w; w.x = cvt_pk_bf16_asm(v0[0], v0[1]); w.y = cvt_pk_bf16_asm(v0[2], v0[3]); w.z = cvt_pk_bf16_asm(v1[0], v1[1]); w.w = cvt_pk_bf16_asm(v1[2], v1[3]);
                    *(u32x4*)(rowp + bj * HALF) = w; } }
    }
};
struct EpiResid {
    static constexpr bool PERM = true;
    const float* base; bf16_t* C; int ldc;
    __device__ __forceinline__ void operator()(const f32x4 (&acc)[2][2][4][2], const Unit& u, int wr, int wc, int fr, int fq) const {
        const int row0 = u.pm * BM + wr * 64 + fr, col0 = u.pn * BM + wc * 32 + 8 * fq;
#pragma unroll
        for (int ai = 0; ai < 2; ++ai)
#pragma unroll
            for (int m = 0; m < 4; ++m) { const size_t off = (size_t)(row0 + ai * HALF + m * 16) * ldc + col0;
#pragma unroll
                for (int bj = 0; bj < 2; ++bj) { const f32x4 b0 = *(const f32x4*)(base + off + bj * HALF), b1 = *(const f32x4*)(base + off + bj * HALF + 4);
                    const f32x4 v0 = b0 + acc[ai][bj][m][0], v1 = b1 + acc[ai][bj][m][1];
                    u32x4 w; w.x = cvt_pk_bf16_asm(v0[0], v0[1]); w.y = cvt_pk_bf16_asm(v0[2], v0[3]); w.z = cvt_pk_bf16_asm(v1[0], v1[1]); w.w = cvt_pk_bf16_asm(v1[2], v1[3]);
                    *(u32x4*)(C + off + bj * HALF) = w; }
                asm volatile("" ::: "memory"); }
    }
};
struct EpiSwiglu {
    static constexpr bool PERM = true;
    bf16_t* O;
    __device__ __forceinline__ void operator()(const f32x4 (&acc)[2][2][4][2], const Unit& u, int wr, int wc, int fr, int fq) const {
        const int row0 = u.pm * BM + wr * 64 + fr, col0 = (u.pn & 15) * HALF + wc * 32 + 8 * fq;
#pragma unroll
        for (int ai = 0; ai < 2; ++ai)
#pragma unroll
            for (int m = 0; m < 4; ++m) { bf16_t* rowp = O + (size_t)(row0 + ai * HALF + m * 16) * FF + col0;
                float h[8];
#pragma unroll
                for (int n = 0; n < 2; ++n)
#pragma unroll
                    for (int j = 0; j < 4; ++j) { const float gt = acc[ai][0][m][n][j], up = acc[ai][1][m][n][j]; h[4 * n + j] = silu_f(gt) * up; }
                u32x4 w; w.x = cvt_pk_bf16_asm(h[0], h[1]); w.y = cvt_pk_bf16_asm(h[2], h[3]); w.z = cvt_pk_bf16_asm(h[4], h[5]); w.w = cvt_pk_bf16_asm(h[6], h[7]);
                *(u32x4*)rowp = w; }
    }
};
struct EpiDown {
    static constexpr bool PERM = true;
    bf16_t* O;
    __device__ __forceinline__ void operator()(const f32x4 (&acc)[2][2][4][2], const Unit& u, int wr, int wc, int fr, int fq) const {
        const int row0 = u.pm * BM + wr * 64 + fr, col0 = (u.pn & 3) * BM + wc * 32 + 8 * fq;
#pragma unroll
        for (int ai = 0; ai < 2; ++ai)
#pragma unroll
            for (int m = 0; m < 4; ++m) { bf16_t* rowp = O + (size_t)(row0 + ai * HALF + m * 16) * D + col0;
#pragma unroll
                for (int bj = 0; bj < 2; ++bj) { const f32x4 v0 = acc[ai][bj][m][0], v1 = acc[ai][bj][m][1];
                    u32x4 w; w.x = cvt_pk_bf16_asm(v0[0], v0[1]); w.y = cvt_pk_bf16_asm(v0[2], v0[3]); w.z = cvt_pk_bf16_asm(v1[0], v1[1]); w.w = cvt_pk_bf16_asm(v1[2], v1[3]);
                    *(u32x4*)(rowp + bj * HALF) = w; } }
    }
};
}

__device__ __forceinline__ void transpose_item(const float* W, int ld, int k0, int n0, bf16_t* WT, size_t dst_row0, int ldt, LAS float* scr, int lane) {
#pragma unroll 8
    for (int i = 0; i < 32; ++i) { const int kk = 2 * i + (lane >> 5); scr[kk * 33 + (lane & 31)] = W[(size_t)(k0 + kk) * ld + n0 + (lane & 31)]; }
    asm volatile("s_waitcnt lgkmcnt(0)" ::: "memory");
    const int c = lane & 7;
#pragma unroll
    for (int j = 0; j < 4; ++j) { const int n = (lane >> 3) + 8 * j; const LAS float* s = scr + (8 * c) * 33 + n;
        u32x4 o; o.x = cvt_pk_bf16(s[0 * 33], s[1 * 33]); o.y = cvt_pk_bf16(s[2 * 33], s[3 * 33]); o.z = cvt_pk_bf16(s[4 * 33], s[5 * 33]); o.w = cvt_pk_bf16(s[6 * 33], s[7 * 33]);
        *(u32x4*)(WT + (dst_row0 + n) * (size_t)ldt + k0 + 8 * c) = o; }
    asm volatile("s_waitcnt lgkmcnt(0)" ::: "memory");
}

#define MFMA16(A, B, C) __builtin_amdgcn_mfma_f32_16x16x32_bf16(A, B, C, 0, 0, 0)
template <int MODE>
__device__ __forceinline__ void row_pass(const Args& a, LAS unsigned char* lds) {
    const int tid = tid_fresh(), lane = tid & 63, wave = __builtin_amdgcn_readfirstlane(tid >> 6), l15 = lane & 15, l4 = lane >> 4;
    const float* src = a.in[0]; const bf16_t* srcb = (const bf16_t*)(a.ws + WS_HB);
    const float* nw = MODE == 0 ? a.in[1] : a.in[12];
    const float* wsm = MODE == 0 ? a.in[2] + 2048 : a.in[13];
    const int ld = MODE == 0 ? INC : NE;
    bf16_t* dst = (bf16_t*)(a.ws + WS_XN);
    float* aux = (float*)(a.ws + (MODE == 0 ? WS_GATES : WS_PROBS));
    LAS unsigned char* XH = lds; LAS unsigned char* XL = lds + 32768; LAS float* PART = (LAS float*)(lds + 65536);
    bf16x8 wh[4], wl[4];
#pragma unroll
    for (int ks = 0; ks < 4; ++ks) { float f[8];
#pragma unroll
        for (int j = 0; j < 8; ++j) f[j] = wsm[(size_t)(128 * wave + 32 * ks + 8 * l4 + j) * ld + l15];
        unsigned hw[4], lw[4];
#pragma unroll
        for (int j = 0; j < 4; ++j) { hw[j] = cvt_pk_bf16(f[2 * j], f[2 * j + 1]); lw[j] = cvt_pk_bf16(f[2 * j] - bflo(hw[j]), f[2 * j + 1] - bfhi(hw[j])); }
        u32x4 hv = (u32x4){hw[0], hw[1], hw[2], hw[3]}, lv = (u32x4){lw[0], lw[1], lw[2], lw[3]};
        wh[ks] = __builtin_bit_cast(bf16x8, hv); wl[ks] = __builtin_bit_cast(bf16x8, lv); }
    const f32x4* nw4 = (const f32x4*)nw + lane;
    f32x4 w4[4];
#pragma unroll
    for (int j = 0; j < 4; ++j) w4[j] = nw4[64 * j];
    const int ec = tid & 15;
    float alog = 0.f, dtb = 0.f;
    if (MODE == 0) { const int h = ec & 3; if (ec < 4) { alog = a.in[4][h]; dtb = a.in[5][h]; } else if (ec >= 8 && ec < 12) { alog = a.in[6][h]; dtb = a.in[7][h]; } }
    constexpr int NGRP = MTOK / 16;
    f32x4 vn[2][4];
    if ((int)blockIdx.x < NGRP) {
#pragma unroll
        for (int q = 0; q < 2; ++q) { const size_t r_ = (size_t)(16 * blockIdx.x + 2 * wave + q);
#pragma unroll
            for (int j = 0; j < 4; ++j) { if (MODE == 0) vn[q][j] = ((const f32x4*)(src + r_ * D) + lane)[64 * j];
                else { const u32x2 w_ = ((const u32x2*)(srcb + r_ * D) + lane)[64 * j]; vn[q][j] = (f32x4){bflo(w_.x), bfhi(w_.x), bflo(w_.y), bfhi(w_.y)}; } } } }
    for (int grp = blockIdx.x; grp < NGRP; grp += gridDim.x) {
        f32x4 v[2][4];
#pragma unroll
        for (int q = 0; q < 2; ++q)
#pragma unroll
            for (int j = 0; j < 4; ++j) v[q][j] = vn[q][j];
        if (grp + (int)gridDim.x < NGRP) {
#pragma unroll
            for (int q = 0; q < 2; ++q) { const size_t r_ = (size_t)(16 * (grp + gridDim.x) + 2 * wave + q);
#pragma unroll
                for (int j = 0; j < 4; ++j) { if (MODE == 0) vn[q][j] = ((const f32x4*)(src + r_ * D) + lane)[64 * j];
                    else { const u32x2 w_ = ((const u32x2*)(srcb + r_ * D) + lane)[64 * j]; vn[q][j] = (f32x4){bflo(w_.x), bfhi(w_.x), bflo(w_.y), bfhi(w_.y)}; } } } }
#pragma unroll
        for (int q = 0; q < 2; ++q) { const int lr = 2 * wave + q, row = 16 * grp + lr; float ss = 0.f;
#pragma unroll
            for (int j = 0; j < 4; ++j) ss += (v[q][j].x * v[q][j].x + v[q][j].y * v[q][j].y) + (v[q][j].z * v[q][j].z + v[q][j].w * v[q][j].w);
            const float r = rsqrtf(wave_sum(ss) * (1.f / D) + EPS);
            u32x2* o8 = (u32x2*)(dst + (size_t)row * D) + lane;
#pragma unroll
            for (int j = 0; j < 4; ++j) { const f32x4 y = v[q][j] * r * w4[j]; u32x2 hw, lw; hw.x = cvt_pk_bf16(y.x, y.y); hw.y = cvt_pk_bf16(y.z, y.w);
                lw.x = cvt_pk_bf16(y.x - bflo(hw.x), y.y - bfhi(hw.x)); lw.y = cvt_pk_bf16(y.z - bflo(hw.y), y.w - bfhi(hw.y));
                o8[64 * j] = hw;
                const int off = lr * 2048 + ((((lane >> 1) + 32 * j) ^ lr) << 4) + 8 * (lane & 1);
                *(LAS u32x2*)(XH + off) = hw; *(LAS u32x2*)(XL + off) = lw; } }
        __syncthreads();
        f32x4 acc = (f32x4){0.f, 0.f, 0.f, 0.f};
#pragma unroll
        for (int ks = 0; ks < 4; ++ks) { const int off = l15 * 2048 + (((16 * wave + 4 * ks + l4) ^ l15) << 4);
            const bf16x8 xh = *(const LAS bf16x8*)(XH + off), xl = *(const LAS bf16x8*)(XL + off);
            acc = MFMA16(xh, wh[ks], acc); acc = MFMA16(xh, wl[ks], acc); acc = MFMA16(xl, wh[ks], acc); }
#pragma unroll
        for (int r4 = 0; r4 < 4; ++r4) PART[(wave * 16 + 4 * l4 + r4) * 16 + l15] = acc[r4];
        __syncthreads();
        if (tid < 256) { float s = 0.f;
#pragma unroll
            for (int w8 = 0; w8 < 8; ++w8) s += PART[w8 * 256 + tid];
            float res;
            if (MODE == 0) { if (ec < 4 || (ec >= 8 && ec < 12)) res = -__expf(alog) * softplus_f(s + dtb); else res = sigmoid_f(s); }
            else { float mx = s;
#pragma unroll
                for (int o = 1; o < 16; o <<= 1) mx = fmaxf(mx, __shfl_xor(mx, o));
                const float e = __expf(s - mx); float sm = e;
#pragma unroll
                for (int o = 1; o < 16; o <<= 1) sm += __shfl_xor(sm, o);
                res = e / sm; }
            aux[(size_t)(16 * grp) * 16 + tid] = res; }
        __syncthreads();
    }
}

__device__ __forceinline__ void ph_prologue(const Args& a, LAS unsigned char* lds) {
    const int tid = tid_fresh(), lane = tid & 63, wave = tid >> 6;
    LAS float* scr = (LAS float*)(lds + wave * 8704);
    const int gw = blockIdx.x * NWAVE + wave, NGW = gridDim.x * NWAVE;
    bf16_t* Win = (bf16_t*)(a.ws + WS_WIN); bf16_t* Wmix = (bf16_t*)(a.ws + WS_WMIX);
    constexpr int I_A = 16 * 64, I_B = 16 * 16, I_C = 8 * 32;
    for (int it = gw; it < I_A + I_B + I_C; it += NGW) {
        int r = it;
        if (r < I_A) { const int kb = r / 64, nb = r % 64; transpose_item(a.in[2], INC, 64 * kb, 32 * nb, Win, (size_t)32 * nb, D, scr, lane); continue; } r -= I_A;
        if (r < I_B) { const int kb = r / 16, nb = r % 16; transpose_item(a.in[2] + 2064, INC, 64 * kb, 32 * nb, Win, (size_t)2048 + 32 * nb, D, scr, lane); continue; } r -= I_B;
        { const int kb = r / 32, nb = r % 32; transpose_item(a.in[11], D, 64 * kb, 32 * nb, Wmix, (size_t)32 * nb, D, scr, lane); }
    }
    __syncthreads();
    for (int task = blockIdx.x; task < 256; task += gridDim.x) {
        const int g = task >> 6, n0 = (task & 63) * 16;
        LAS float* Wsc = (LAS float*)lds;
        LAS float* Pw = (LAS float*)(lds + 8192);
        for (int idx = tid; idx < 128 * 16; idx += NTHR) { const int d = idx >> 4, n = idx & 15; Wsc[idx] = a.in[11][(size_t)(512 + 128 * g + d) * D + n0 + n] * a.in[10][128 * g + d]; }
        for (int idx = tid; idx < 128 * 128; idx += NTHR) Pw[(idx >> 7) * 129 + (idx & 127)] = a.in[9][(size_t)g * 16384 + idx];
        __syncthreads();
        const int n = tid & 15, cq = tid >> 4;
        float accv[4] = {0.f, 0.f, 0.f, 0.f};
        for (int d = 0; d < 128; ++d) { const float w = Wsc[d * 16 + n];
#pragma unroll
            for (int j = 0; j < 4; ++j) accv[j] += Pw[(cq * 4 + j) * 129 + d] * w; }
        u32x2 o; o.x = cvt_pk_bf16(accv[0], accv[1]); o.y = cvt_pk_bf16(accv[2], accv[3]);
        *(u32x2*)(Wmix + (size_t)(n0 + n) * D + 512 + 128 * g + cq * 4) = o;
        __syncthreads();
    }
    __syncthreads();
    row_pass<0>(a, lds);
}

constexpr int CVT_ITEMS = NE * 3072, CVT_SPLIT = (CVT_ITEMS * 9 / 10) & ~2047;
template <bool EARLY>
__device__ __forceinline__ void expert_weight_cvt(const Args& a, LAS unsigned char* lds, int it_lo, int it_hi, int wg0, int nwg, int bid) {
    const int tid = tid_fresh(), lane = tid & 63, wave = tid >> 6;
    LAS float* scr = (LAS float*)(lds + wave * 8704);
    const int gw = (bid - wg0) * NWAVE + wave, NGW = nwg * NWAVE;
    bf16_t* Wgu = (bf16_t*)(a.ws + WS_WGU); bf16_t* Wd = (bf16_t*)(a.ws + WS_WD); bf16_t* WdA = (bf16_t*)(a.ws + WS_WDA);
    if (bid < wg0 || bid >= wg0 + nwg) return;
    for (int it = it_lo + gw; it < it_hi; it += NGW) {
        if (EARLY) { const int e = it >> 10, q = it & 1023, kb = q >> 5, nb = q & 31;
            transpose_item(a.in[16] + (size_t)e * FF * D, D, 64 * kb, 32 * nb, WdA, (size_t)e * 1024 + 32 * nb, FF, scr, lane); continue; }
        const int e = it / 3072, r = it % 3072, which = r >> 10, q = r & 1023;
        if (which < 2) { const int kb = q >> 6, nb = q & 63, f0 = 32 * nb;
            const float* W = (which == 0 ? a.in[14] : a.in[15]) + (size_t)e * D * FF;
            transpose_item(W, FF, 64 * kb, f0, Wgu, (size_t)e * 4096 + (f0 >> 7) * 256 + which * 128 + (f0 & 127), D, scr, lane);
        } else if (e >= NEARLY) { const int kb = q >> 5, nb = q & 31;
            transpose_item(a.in[16] + (size_t)e * FF * D, D, 64 * kb, 32 * nb, Wd, (size_t)e * 1024 + 32 * nb, FF, scr, lane); }
    }
}

__device__ __forceinline__ int a128(int row, int col) { return row * 256 + ((((col >> 3) ^ (row & 15))) << 4) + ((col & 7) << 1); }
__device__ __forceinline__ int a64(int row, int col) { return row * 128 + ((((col >> 3) ^ ((row >> 1) & 7))) << 4) + ((col & 7) << 1); }
__device__ __forceinline__ bf16x8 frag128(LAS unsigned char* base, int row0, int k0, int lane) { return *(const LAS bf16x8*)(base + a128(row0 + (lane & 15), k0 + ((lane >> 4) << 3))); }
__device__ __forceinline__ bf16x8 frag64(LAS unsigned char* base, int row0, int k0, int lane) { return *(const LAS bf16x8*)(base + a64(row0 + (lane & 15), k0 + ((lane >> 4) << 3))); }
__device__ __forceinline__ u32x2 pack4(f32x4 v) { u32x2 w; w.x = cvt_pk_bf16(v[0], v[1]); w.y = cvt_pk_bf16(v[2], v[3]); return w; }

template <bool FRAG>
__device__ __forceinline__ void staged_store_16x64(LAS unsigned char* stg, const f32x4 (&t)[4], unsigned char* gmat, int tile16, int half, int lane) {
    const int l15 = lane & 15, l4 = lane >> 4;
#pragma unroll
    for (int k = 0; k < 4; ++k) *(LAS u32x2*)(stg + l15 * 128 + (((2 * k + (l4 >> 1)) ^ (l15 & 7)) << 4) + 8 * (l4 & 1)) = pack4(t[k]);
#pragma unroll
    for (int q = 0; q < 2; ++q) { const int idx = lane + 64 * q, row = idx >> 3, c = idx & 7;
        const u32x4 v = *(const LAS u32x4*)(stg + row * 128 + ((c ^ (row & 7)) << 4));
        const size_t off = FRAG ? (size_t)(tile16 * 4 + 2 * half + (c >> 2)) * 1024 + row * 64 + (c & 3) * 16
                                : (size_t)(tile16 * 8 + 4 * half + (c >> 1)) * 512 + row * 32 + (c & 1) * 16;
        *(u32x4*)(gmat + off) = v; }
}
constexpr int L_QM = 0, L_KM = 16384, L_KT = 32768, L_VT = 49152, L_WT = 114688, L_UT = 131072, L_SM = 147456;
#define L_PD(d)  (65536 + (d) * 24576)
#define L_PTD(d) (65536 + (d) * 24576 + 8192)
#define L_PQD(d) (65536 + (d) * 24576 + 16384)
#define L_TD(d)  (114688 + (d) * 8192)
__device__ __forceinline__ void ph_chunk_prep(const Args& a, LAS unsigned char* lds) {
    const int tid0 = tid_fresh(), wave = __builtin_amdgcn_readfirstlane(tid0 >> 6);
    const bf16_t* proj = (const bf16_t*)(a.ws + WS_PROJ);
    const float* gates = (const float*)(a.ws + WS_GATES);
    float* eglp = (float*)(a.ws + WS_EGL);
    LAS float* sm = (LAS float*)(lds + L_SM);
    const int tn = wave & 3, tm0 = 2 * (wave >> 2);
#define SEG_LANE() int tid = tid0; asm volatile("" : "+v"(tid)); const int lane = tid & 63, l15 = lane & 15, l4 = lane >> 4, ra = 16 * tn + l15; (void)l4; (void)ra; (void)lane
    u32x4 raw[3][6]; float graw[4];
#define PREP_FETCH(task_) do { const int n_ = (task_) & 31, h_ = ((task_) >> 5) & 3, b_ = (task_) >> 7; int tidf = tid0; asm volatile("" : "+v"(tidf)); \
        const int cch_ = tidf & 15, i0_ = 2 * (tidf >> 4); \
        _Pragma("unroll") for (int mtx = 0; mtx < 3; ++mtx) _Pragma("unroll") for (int jj = 0; jj < 6; ++jj) { const int tl_ = n_ * 64 + i0_ - 2 + jj; \
            raw[mtx][jj] = (u32x4){0u, 0u, 0u, 0u}; \
            if (tl_ >= 0 && tl_ < T) raw[mtx][jj] = *(const u32x4*)(proj + (size_t)(b_ * T + tl_) * NPROJ + mtx * 512 + h_ * HD + 8 * cch_); } \
        if (wave == 0) { const float* gp_ = gates + (size_t)(b_ * T + n_ * 64 + (tidf & 63)) * 16; graw[0] = gp_[h_]; graw[1] = gp_[4 + h_]; graw[2] = gp_[8 + h_]; graw[3] = gp_[12 + h_]; } } while (0)
    if ((int)blockIdx.x < NB * NH * NCH) PREP_FETCH((int)blockIdx.x);
    for (int task = blockIdx.x; task < NB * NH * NCH; task += gridDim.x) {
        const int n = task & 31, h = (task >> 5) & 3, b = task >> 7;
        { SEG_LANE();
        if (wave == 0) {
            const float gf = graw[0], bfv = graw[1], gb = graw[2], bbv = graw[3];
            float pf = gf, pb = gb;
#pragma unroll
            for (int o = 1; o < 64; o <<= 1) { const float tf = __shfl_up(pf, o), tb = __shfl_up(pb, o); if (lane >= o) { pf += tf; pb += tb; } }
            const float totb = __shfl(pb, 63);
            sm[lane] = pf; sm[64 + lane] = totb - pb + gb; sm[128 + lane] = bfv; sm[192 + lane] = bbv;
        }
        {
            const int cch = tid & 15, rp = tid >> 4, i0 = 2 * rp;
#pragma unroll
            for (int mtx = 0; mtx < 3; ++mtx) {
                const int colb = mtx * 512 + h * HD + 8 * cch;
                float in[6][8];
#pragma unroll
                for (int jj = 0; jj < 6; ++jj) { const u32x4 w = raw[mtx][jj];
                    in[jj][0] = bflo(w.x); in[jj][1] = bfhi(w.x); in[jj][2] = bflo(w.y); in[jj][3] = bfhi(w.y); in[jj][4] = bflo(w.z); in[jj][5] = bfhi(w.z); in[jj][6] = bflo(w.w); in[jj][7] = bfhi(w.w); }
                float val[2][8];
#pragma unroll
                for (int r = 0; r < 2; ++r)
#pragma unroll
                    for (int e = 0; e < 8; ++e) val[r][e] = 0.f;
#pragma unroll
                for (int j = 0; j < 5; ++j) { const f32x4 c0 = *(const f32x4*)(a.in[3] + (size_t)j * 1536 + colb), c1 = *(const f32x4*)(a.in[3] + (size_t)j * 1536 + colb + 4);
#pragma unroll
                    for (int r = 0; r < 2; ++r) {
#pragma unroll
                        for (int e = 0; e < 4; ++e) { val[r][e] += in[r + j][e] * c0[e]; val[r][4 + e] += in[r + j][4 + e] * c1[e]; } } }
#pragma unroll
                for (int r = 0; r < 2; ++r) { float ss = 0.f;
#pragma unroll
                    for (int e = 0; e < 8; ++e) { val[r][e] = silu_f(val[r][e]); ss += val[r][e] * val[r][e]; }
                    if (mtx < 2) { ss += __shfl_xor(ss, 1); ss += __shfl_xor(ss, 2); ss += __shfl_xor(ss, 4); ss += __shfl_xor(ss, 8);
                        const float sc = rsqrtf(ss + EPS) * (mtx == 0 ? 0.08838834764831845f : 1.f);
#pragma unroll
                        for (int e = 0; e < 8; ++e) val[r][e] *= sc; } }
                if (mtx < 2) {
#pragma unroll
                    for (int r = 0; r < 2; ++r) { u32x4 w; w.x = cvt_pk_bf16(val[r][0], val[r][1]); w.y = cvt_pk_bf16(val[r][2], val[r][3]); w.z = cvt_pk_bf16(val[r][4], val[r][5]); w.w = cvt_pk_bf16(val[r][6], val[r][7]);
                        *(LAS u32x4*)(lds + (mtx == 0 ? L_QM : L_KM) + a128(i0 + r, 8 * cch)) = w; } }
                if (mtx >= 1) {
#pragma unroll
                    for (int e = 0; e < 8; ++e) *(LAS unsigned*)(lds + (mtx == 1 ? L_KT : L_VT) + a64(8 * cch + e, i0)) = cvt_pk_bf16(val[0][e], val[1][e]); }
            }
        }
        }
        if (task + (int)gridDim.x < NB * NH * NCH) PREP_FETCH(task + (int)gridDim.x);
        __syncthreads();
        { SEG_LANE();
            f32x4 kk[2] = {(f32x4){0, 0, 0, 0}, (f32x4){0, 0, 0, 0}}, qk[2] = {(f32x4){0, 0, 0, 0}, (f32x4){0, 0, 0, 0}};
#pragma unroll
            for (int ks = 0; ks < 4; ++ks) { const bf16x8 yk = frag128(lds + L_KM, 16 * tn, 32 * ks, lane), yq = frag128(lds + L_QM, 16 * tn, 32 * ks, lane);
#pragma unroll
                for (int t2 = 0; t2 < 2; ++t2) { const bf16x8 xk = frag128(lds + L_KM, 16 * (tm0 + t2), 32 * ks, lane);
                    kk[t2] = MFMA16(xk, yk, kk[t2]); qk[t2] = MFMA16(xk, yq, qk[t2]); } }
#pragma unroll
            for (int dir = 0; dir < 2; ++dir) {
                LAS float* gc = sm + 64 * dir; LAS float* bet = sm + 128 + 64 * dir;
                const float gca = gc[ra], ba = bet[ra];
#pragma unroll
                for (int t2 = 0; t2 < 2; ++t2) { const int rb0 = 16 * (tm0 + t2) + 4 * l4;
                    f32x4 pv, ptv, pqv, tv;
#pragma unroll
                    for (int r = 0; r < 4; ++r) { const int rb = rb0 + r; const float gcb = gc[rb], bb = bet[rb];
                        const bool st_ab = dir ? (rb > ra) : (rb < ra), st_ba = dir ? (ra > rb) : (ra < rb), in_ab = st_ab || (rb == ra);
                        const float dab = __expf(fminf(gca - gcb, 0.f)), dba = __expf(fminf(gcb - gca, 0.f));
                        pv[r] = st_ab ? ba * kk[t2][r] * dab : 0.f;
                        ptv[r] = st_ba ? bb * kk[t2][r] * dba : 0.f;
                        pqv[r] = in_ab ? qk[t2][r] * dab : 0.f;
                        tv[r] = (rb == ra ? 1.f : 0.f) - pv[r]; }
                    *(LAS u32x2*)(lds + L_PD(dir) + a64(ra, rb0)) = pack4(pv);
                    *(LAS u32x2*)(lds + L_PTD(dir) + a64(ra, rb0)) = pack4(ptv);
                    *(LAS u32x2*)(lds + L_PQD(dir) + a64(ra, rb0)) = pack4(pqv);
                    *(LAS u32x2*)(lds + L_TD(dir) + a64(ra, rb0)) = pack4(tv); }
            }
        }
        __syncthreads();
        if (wave < 4) { SEG_LANE();
            const int d = wave >> 1, R = 32 * (wave & 1);
            LAS unsigned char* Pi = lds + L_PD(d); LAS unsigned char* PTi = lds + L_PTD(d); LAS unsigned char* Ti = lds + L_TD(d); LAS unsigned char* TTi = lds + L_UT + wave * 4096;
            LAS float* gc = sm + 64 * d; LAS float* bet = sm + 128 + 64 * d;
            f32x4 Ta[2][2], TTa[2][2];
#pragma unroll
            for (int mi = 0; mi < 2; ++mi)
#pragma unroll
                for (int ni = 0; ni < 2; ++ni) { const int ar = R + 16 * ni + l15, b0 = R + 16 * mi + 4 * l4;
                    const u32x2 p = *(const LAS u32x2*)(Pi + a64(ar, b0)), pt = *(const LAS u32x2*)(PTi + a64(ar, b0));
                    Ta[mi][ni][0] = (ar == b0 ? 1.f : 0.f) - bflo(p.x); Ta[mi][ni][1] = (ar == b0 + 1 ? 1.f : 0.f) - bfhi(p.x); Ta[mi][ni][2] = (ar == b0 + 2 ? 1.f : 0.f) - bflo(p.y); Ta[mi][ni][3] = (ar == b0 + 3 ? 1.f : 0.f) - bfhi(p.y);
                    TTa[mi][ni][0] = (ar == b0 ? 1.f : 0.f) - bflo(pt.x); TTa[mi][ni][1] = (ar == b0 + 1 ? 1.f : 0.f) - bfhi(pt.x); TTa[mi][ni][2] = (ar == b0 + 2 ? 1.f : 0.f) - bflo(pt.y); TTa[mi][ni][3] = (ar == b0 + 3 ? 1.f : 0.f) - bfhi(pt.y);
                    *(LAS u32x2*)(TTi + a64(16 * ni + l15, b0)) = pack4(TTa[mi][ni]); }
#pragma unroll 1
            for (int s5 = 0; s5 < 5; ++s5) {
                bf16x8 fp[2], fpt[2], ft[2], ftt[2];
#pragma unroll
                for (int mi = 0; mi < 2; ++mi) { fp[mi] = frag64(Pi, R + 16 * mi, R, lane); fpt[mi] = frag64(PTi, R + 16 * mi, R, lane); ft[mi] = frag64(Ti, R + 16 * mi, R, lane);
                    ftt[mi] = *(const LAS bf16x8*)(TTi + a64(16 * mi + l15, R + 8 * l4)); }
                f32x4 pn[2][2], pnt[2][2];
#pragma unroll
                for (int mi = 0; mi < 2; ++mi)
#pragma unroll
                    for (int ni = 0; ni < 2; ++ni) { pn[mi][ni] = (f32x4){0, 0, 0, 0}; pnt[mi][ni] = (f32x4){0, 0, 0, 0};
                        if (s5 < 4) { pn[mi][ni] = MFMA16(fpt[mi], fp[ni], pn[mi][ni]); pnt[mi][ni] = MFMA16(fp[mi], fpt[ni], pnt[mi][ni]); }
                        if (s5 > 0) { Ta[mi][ni] = MFMA16(fpt[mi], ft[ni], Ta[mi][ni]); TTa[mi][ni] = MFMA16(ft[mi], fpt[ni], TTa[mi][ni]); } }
                (void)ftt;
#pragma unroll
                for (int mi = 0; mi < 2; ++mi)
#pragma unroll
                    for (int ni = 0; ni < 2; ++ni) { const int ar = R + 16 * ni + l15, b0 = R + 16 * mi + 4 * l4;
                        if (s5 < 4) { *(LAS u32x2*)(Pi + a64(ar, b0)) = pack4(pn[mi][ni]); *(LAS u32x2*)(PTi + a64(ar, b0)) = pack4(pnt[mi][ni]); }
                        if (s5 > 0 && s5 < 4) *(LAS u32x2*)(Ti + a64(ar, b0)) = pack4(Ta[mi][ni]); }
            }
#pragma unroll
            for (int mi = 0; mi < 2; ++mi)
#pragma unroll
                for (int ni = 0; ni < 2; ++ni) { const int ar = R + 16 * ni + l15, b0 = R + 16 * mi + 4 * l4; f32x4 tw, tu;
#pragma unroll
                    for (int r = 0; r < 4; ++r) { const float bb = bet[b0 + r]; tu[r] = Ta[mi][ni][r] * bb; tw[r] = tu[r] * __expf(gc[b0 + r]); }
                    *(LAS u32x2*)(Ti + a64(ar, b0)) = pack4(Ta[mi][ni]); *(LAS u32x2*)(TTi + a64(16 * ni + l15, b0)) = pack4(TTa[mi][ni]);
                    *(LAS u32x2*)(Pi + a64(ar, b0)) = pack4(tw); *(LAS u32x2*)(PTi + a64(ar, b0)) = pack4(tu); }
        }
        __syncthreads();
        if (wave == 4 || wave == 5) { SEG_LANE();
            const int d = wave - 4, ab = d ? 0 : 1, bb_ = 1 - ab, Ra = 32 * ab, Rb = 32 * bb_;
            LAS unsigned char* Pi = lds + L_PD(d); LAS unsigned char* PTi = lds + L_PTD(d); LAS unsigned char* Ti = lds + L_TD(d);
            LAS unsigned char* TTb = lds + L_UT + (2 * d + bb_) * 4096; LAS unsigned char* Zi = lds + L_KM + d * 4096;
            LAS float* gc = sm + 64 * d; LAS float* bet = sm + 128 + 64 * d;
            bf16x8 x1[2], y1[2];
#pragma unroll
            for (int t = 0; t < 2; ++t) { x1[t] = frag64(PTi, Rb + 16 * t, Ra, lane); y1[t] = frag64(Ti, Ra + 16 * t, Ra, lane); }
#pragma unroll
            for (int mi = 0; mi < 2; ++mi)
#pragma unroll
                for (int ni = 0; ni < 2; ++ni) { f32x4 z = (f32x4){0, 0, 0, 0}; z = MFMA16(x1[mi], y1[ni], z);
                    *(LAS u32x2*)(Zi + a64(16 * ni + l15, Rb + 16 * mi + 4 * l4)) = pack4(z);
                    *(LAS u32x2*)(PTi + a64(Rb + 16 * ni + l15, Ra + 16 * mi + 4 * l4)) = (u32x2){0u, 0u}; }
            bf16x8 x2[2], y2[2];
#pragma unroll
            for (int t = 0; t < 2; ++t) { x2[t] = *(const LAS bf16x8*)(TTb + a64(16 * t + l15, Rb + 8 * l4)); y2[t] = *(const LAS bf16x8*)(Zi + a64(16 * t + l15, Rb + 8 * l4)); }
#pragma unroll
            for (int mj = 0; mj < 2; ++mj)
#pragma unroll
                for (int ni = 0; ni < 2; ++ni) { f32x4 t = (f32x4){0, 0, 0, 0}; t = MFMA16(x2[mj], y2[ni], t);
                    const int ir = Ra + 16 * ni + l15, j0 = Rb + 16 * mj + 4 * l4; f32x4 tw, tu;
#pragma unroll
                    for (int r = 0; r < 4; ++r) { const float bb = bet[j0 + r]; tu[r] = -t[r] * bb; tw[r] = tu[r] * __expf(gc[j0 + r]); }
                    *(LAS u32x2*)(Pi + a64(ir, j0)) = pack4(tw); *(LAS u32x2*)(PTi + a64(ir, j0)) = pack4(tu); }
        }
        __syncthreads();
#pragma unroll 1
        for (int dir = 0; dir < 2; ++dir) {
            LAS float* gc = sm + 64 * dir;
            const float gl = dir ? gc[0] : gc[63];
            { SEG_LANE(); const int d = tid >> 2, ib = (tid & 3) * 16;
#pragma unroll
                for (int cpart = 0; cpart < 2; ++cpart) { const int i = ib + 8 * cpart; const u32x4 w = *(const LAS u32x4*)(lds + L_KT + a64(d, i));
                    float f[8] = {bflo(w.x), bfhi(w.x), bflo(w.y), bfhi(w.y), bflo(w.z), bfhi(w.z), bflo(w.w), bfhi(w.w)};
#pragma unroll
                    for (int e = 0; e < 8; ++e) f[e] *= __expf(gl - gc[i + e]);
                    u32x4 o; o.x = cvt_pk_bf16(f[0], f[1]); o.y = cvt_pk_bf16(f[2], f[3]); o.z = cvt_pk_bf16(f[4], f[5]); o.w = cvt_pk_bf16(f[6], f[7]);
                    *(LAS u32x4*)(lds + L_KM + a64(d, i)) = o; } }
            { SEG_LANE();
                f32x4 wa[4], ua[4];
#pragma unroll
                for (int t4 = 0; t4 < 4; ++t4) { wa[t4] = (f32x4){0, 0, 0, 0}; ua[t4] = (f32x4){0, 0, 0, 0}; }
#pragma unroll
                for (int ks = 0; ks < 2; ++ks) { const bf16x8 yk = frag64(lds + L_KT, 16 * wave, 32 * ks, lane), yv = frag64(lds + L_VT, 16 * wave, 32 * ks, lane);
#pragma unroll
                    for (int t4 = 0; t4 < 4; ++t4) { const bf16x8 xw = frag64(lds + L_PD(dir), 16 * t4, 32 * ks, lane), xu = frag64(lds + L_PTD(dir), 16 * t4, 32 * ks, lane);
                        wa[t4] = MFMA16(xw, yk, wa[t4]); ua[t4] = MFMA16(xu, yv, ua[t4]); } }
                const int rd = 16 * wave + l15;
#pragma unroll
                for (int t4 = 0; t4 < 4; ++t4) { *(LAS u32x2*)(lds + L_WT + a64(rd, 16 * t4 + 4 * l4)) = pack4(wa[t4]); *(LAS u32x2*)(lds + L_UT + a64(rd, 16 * t4 + 4 * l4)) = pack4(ua[t4]); }
            }
            __syncthreads();
            { SEG_LANE();
                const int cd = ((b * NH + h) * NCH + n) * 2 + dir;
                unsigned char* pb = a.ws + WS_PREP + (size_t)cd * PREP_STRIDE;
                if (tid == 0) eglp[cd] = __expf(gl);
                LAS unsigned char* stg = lds + L_PD(dir) + wave * 2048;
                {
                    bf16x8 y[2]; y[0] = frag64(lds + L_KM, 16 * wave, 0, lane); y[1] = frag64(lds + L_KM, 16 * wave, 32, lane);
#pragma unroll
                    for (int hf = 0; hf < 2; ++hf) { f32x4 c[4];
#pragma unroll
                        for (int t4 = 0; t4 < 4; ++t4) { const int t8 = 4 * hf + t4; c[t4] = (f32x4){0, 0, 0, 0};
                            c[t4] = MFMA16(frag64(lds + L_WT, 16 * t8, 0, lane), y[0], c[t4]); c[t4] = MFMA16(frag64(lds + L_WT, 16 * t8, 32, lane), y[1], c[t4]); c[t4] = -c[t4]; }
                        staged_store_16x64<true>(stg, c, pb, wave, hf, lane); }
                }
                {
                    bf16x8 y[2]; y[0] = frag64(lds + L_UT, 16 * wave, 0, lane); y[1] = frag64(lds + L_UT, 16 * wave, 32, lane);
#pragma unroll
                    for (int hf = 0; hf < 2; ++hf) { f32x4 c[4];
#pragma unroll
                        for (int t4 = 0; t4 < 4; ++t4) { const int t8 = 4 * hf + t4; c[t4] = (f32x4){0, 0, 0, 0};
                            c[t4] = MFMA16(frag64(lds + L_KM, 16 * t8, 0, lane), y[0], c[t4]); c[t4] = MFMA16(frag64(lds + L_KM, 16 * t8, 32, lane), y[1], c[t4]); }
                        staged_store_16x64<false>(stg, c, pb + 32768, wave, hf, lane); }
                }
                {
                    bf16x8 y[2]; y[0] = frag64(lds + L_PQD(dir), 16 * tn, 0, lane); y[1] = frag64(lds + L_PQD(dir), 16 * tn, 32, lane);
                    const float eg = __expf(gc[ra]);
                    f32x4 cq[4], co[4];
#pragma unroll
                    for (int t4 = 0; t4 < 4; ++t4) { const int mt = 4 * (wave >> 2) + t4, c0 = 16 * mt + 4 * l4;
                        cq[t4] = (f32x4){0, 0, 0, 0}; co[t4] = (f32x4){0, 0, 0, 0};
                        cq[t4] = MFMA16(frag64(lds + L_WT, 16 * mt, 0, lane), y[0], cq[t4]); cq[t4] = MFMA16(frag64(lds + L_WT, 16 * mt, 32, lane), y[1], cq[t4]);
                        co[t4] = MFMA16(frag64(lds + L_UT, 16 * mt, 0, lane), y[0], co[t4]); co[t4] = MFMA16(frag64(lds + L_UT, 16 * mt, 32, lane), y[1], co[t4]);
                        const u32x2 qw = *(const LAS u32x2*)(lds + L_QM + a128(ra, c0));
                        cq[t4][0] = eg * bflo(qw.x) - cq[t4][0]; cq[t4][1] = eg * bfhi(qw.x) - cq[t4][1]; cq[t4][2] = eg * bflo(qw.y) - cq[t4][2]; cq[t4][3] = eg * bfhi(qw.y) - cq[t4][3]; }
                    staged_store_16x64<true>(stg, cq, pb + 65536, tn, wave >> 2, lane);
                    staged_store_16x64<false>(stg, co, pb + 81920, tn, wave >> 2, lane);
                }
            }
            __syncthreads();
        }
    }
#undef SEG_LANE
#undef PREP_FETCH
}

__device__ __forceinline__ void ph_pool(const Args& a, LAS unsigned char* lds) {
    const int tid = tid_fresh(), lane = tid & 63, wave = __builtin_amdgcn_readfirstlane(tid >> 6), l15 = lane & 15, l4 = lane >> 4;
    const bf16_t* proj = (const bf16_t*)(a.ws + WS_PROJ);
    bf16_t* amix = (bf16_t*)(a.ws + WS_AMIX);
    for (int tile = blockIdx.x; tile < MTOK / 64; tile += gridDim.x) {
        const int tok0 = tile * 64, tl0 = tok0 & (T - 1);
        __syncthreads();
#pragma unroll
        for (int q = 0; q < 10; ++q) { const int idx = tid + NTHR * q, r = idx >> 6, ch = idx & 63, tl = tl0 - 8 + r;
            u32x4 v = (u32x4){0u, 0u, 0u, 0u};
            if (tl >= 0 && tl < T) v = *(const u32x4*)(proj + (size_t)(tok0 - 8 + r) * NPROJ + 2048 + 8 * ch);
            *(LAS u32x4*)(lds + r * 1024 + ch * 16) = v; }
        __syncthreads();
        const int g = wave & 3, w = 2 << g, lo = w >> 1, hi = w - lo - 1, ch = 16 * g + l15;
#pragma unroll 2
        for (int q = 0; q < 8; ++q) {
            const int tk = 8 * q + 4 * (wave >> 2) + l4, tl = tl0 + tk;
            float sum[8] = {0, 0, 0, 0, 0, 0, 0, 0};
            for (int j = -lo; j <= hi; ++j) { const u32x4 v = *(const LAS u32x4*)(lds + (tk + 8 + j) * 1024 + ch * 16);
                sum[0] += bflo(v.x); sum[1] += bfhi(v.x); sum[2] += bflo(v.y); sum[3] += bfhi(v.y); sum[4] += bflo(v.z); sum[5] += bfhi(v.z); sum[6] += bflo(v.w); sum[7] += bfhi(v.w); }
            const u32x4 v = *(const LAS u32x4*)(lds + (tk + 8) * 1024 + ch * 16);
            const int s0 = max(tl - lo, 0), e0 = min(tl + hi + 1, T);
            const float inv = 1.f / (float)(e0 - s0);
            u32x4 o; o.x = cvt_pk_bf16(sum[0] * inv - bflo(v.x), sum[1] * inv - bfhi(v.x)); o.y = cvt_pk_bf16(sum[2] * inv - bflo(v.y), sum[3] * inv - bfhi(v.y));
            o.z = cvt_pk_bf16(sum[4] * inv - bflo(v.z), sum[5] * inv - bfhi(v.z)); o.w = cvt_pk_bf16(sum[6] * inv - bflo(v.w), sum[7] * inv - bfhi(v.w));
            *(u32x4*)(amix + (size_t)(tok0 + tk) * D + 512 + 8 * ch) = o;
        }
    }
    __syncthreads();
}

struct ScanSet { bf16x8 xm[4]; bf16x8 yq[4]; u32x2 cw[2]; u32x2 ow; float egl; };
template <int VAR>
__device__ __forceinline__ void ph_scan(const Args& a, LAS unsigned char* lds, int vb) {
    const int tid = tid_fresh(), lane = tid & 63, wave = __builtin_amdgcn_readfirstlane(tid >> 6), l15 = lane & 15, l4 = lane >> 4;
    const float* eglp = (const float*)(a.ws + WS_EGL);
    bf16_t* od = (bf16_t*)(a.ws + (VAR == 0 ? WS_OD : (size_t)464 * MiB));
    const int tn = wave & 3, eo = wave >> 2;
    for (int job = vb; job < 256; job += gridDim.x) {
        const int x = job & 7, j = job >> 3, chain = x * 8 + (j >> 2), sl = j & 3, dir = chain & 1, bh = chain >> 1, b = bh >> 2, h = bh & 3;
        if (VAR == 1 && sl != 0) continue;
        f32x4 acc[2] = {(f32x4){0, 0, 0, 0}, (f32x4){0, 0, 0, 0}};
        const unsigned offx = (unsigned)(wave * 4) * 1024u + (unsigned)l15 * 64u + (unsigned)l4 * 16u;
        const unsigned offc = 32768u + (unsigned)((2 * sl) * 8 + wave) * 512u + (unsigned)l15 * 32u + (unsigned)l4 * 8u;
        const unsigned offq = 65536u + (unsigned)(tn * 4) * 1024u + (unsigned)l15 * 64u + (unsigned)l4 * 16u;
        const unsigned offo = 81920u + (unsigned)(tn * 8 + 2 * sl + eo) * 512u + (unsigned)l15 * 32u + (unsigned)l4 * 8u;
        const long dstep = dir ? -(long)(2 * PREP_STRIDE) : (long)(2 * PREP_STRIDE);
        const int cd0 = (bh * NCH + (dir ? NCH - 1 : 0)) * 2 + dir;
        const GAS unsigned char* pld = (const GAS unsigned char*)(a.ws + WS_PREP + (size_t)cd0 * PREP_STRIDE);
        const GAS float* pegl = (const GAS float*)(eglp + cd0);
        GAS bf16_t* pod = (GAS bf16_t*)od + ((size_t)dir * MTOK + (size_t)(b * T + (dir ? NCH - 1 : 0) * 64 + 16 * tn + l15)) * 512 + h * HD + 32 * sl + 16 * eo + 4 * l4;
        const long ostep = dir ? -(long)(64 * 512) : (long)(64 * 512);
        const long gstep = dir ? -2 : 2;
#define SCAN_LOAD(S) do { asm volatile("" : "+s"(pld), "+s"(pegl)); \
        _Pragma("unroll") for (int ks = 0; ks < 4; ++ks) { S.xm[ks] = *(const GAS bf16x8*)(pld + offx + 1024 * ks); S.yq[ks] = *(const GAS bf16x8*)(pld + offq + 1024 * ks); } \
        _Pragma("unroll") for (int et = 0; et < 2; ++et) S.cw[et] = *(const GAS u32x2*)(pld + offc + 4096 * et); \
        S.ow = *(const GAS u32x2*)(pld + offo); S.egl = *pegl; pld += dstep; pegl += gstep; } while (0)
#define SCAN_STEP(S, SN, step) do { const int cur_ = (step) & 1; \
        _Pragma("unroll") for (int et = 0; et < 2; ++et) *(LAS u32x2*)(lds + cur_ * 8192 + a128(16 * et + l15, 16 * wave + 4 * l4)) = pack4(acc[et]); \
        asm volatile("s_waitcnt lgkmcnt(0)" ::: "memory"); __builtin_amdgcn_s_barrier(); asm volatile("" ::: "memory"); \
        if ((step) + 3 < NCH) SCAN_LOAD(SN); \
        bf16x8 st_[2][4]; \
        _Pragma("unroll") for (int et = 0; et < 2; ++et) _Pragma("unroll") for (int ks = 0; ks < 4; ++ks) st_[et][ks] = frag128(lds + cur_ * 8192, 16 * et, 32 * ks, lane); \
        f32x4 o_; o_[0] = bflo(S.ow.x); o_[1] = bfhi(S.ow.x); o_[2] = bflo(S.ow.y); o_[3] = bfhi(S.ow.y); \
        _Pragma("unroll") for (int ks = 0; ks < 4; ++ks) o_ = MFMA16(eo ? st_[1][ks] : st_[0][ks], S.yq[ks], o_); \
        _Pragma("unroll") for (int et = 0; et < 2; ++et) { \
            acc[et][0] = S.egl * acc[et][0] + bflo(S.cw[et].x); acc[et][1] = S.egl * acc[et][1] + bfhi(S.cw[et].x); acc[et][2] = S.egl * acc[et][2] + bflo(S.cw[et].y); acc[et][3] = S.egl * acc[et][3] + bfhi(S.cw[et].y); \
            _Pragma("unroll") for (int ks = 0; ks < 4; ++ks) acc[et] = MFMA16(S.xm[ks], st_[et][ks], acc[et]); } \
        asm volatile("" : "+v"(pod)); *(GAS u32x2*)pod = pack4(o_); pod += ostep; } while (0)
        ScanSet s0, s1, s2, s3;
        SCAN_LOAD(s0); SCAN_LOAD(s1); SCAN_LOAD(s2);
        __syncthreads();
#pragma unroll
        for (int step = 0; step < NCH; step += 4) {
            SCAN_STEP(s0, s3, step); SCAN_STEP(s1, s0, step + 1); SCAN_STEP(s2, s1, step + 2); SCAN_STEP(s3, s2, step + 3);
        }
#undef SCAN_LOAD
#undef SCAN_STEP
    }
}

__device__ __forceinline__ void ph_delta_out(const Args& a, LAS unsigned char* lds) {
    const int tid = tid_fresh(), lane = tid & 63, wave = tid >> 6, l15 = lane & 15, l4 = lane >> 4;
    const bf16_t* proj = (const bf16_t*)(a.ws + WS_PROJ); const bf16_t* od = (const bf16_t*)(a.ws + WS_OD);
    bf16_t* amix = (bf16_t*)(a.ws + WS_AMIX);
    const f32x4 hw0 = *(const f32x4*)(a.in[8] + 8 * l15), hw1 = *(const f32x4*)(a.in[8] + 8 * l15 + 4);
    const int gw = blockIdx.x * NWAVE + wave, NGW = gridDim.x * NWAVE;
    u32x4 fn = (u32x4){0u, 0u, 0u, 0u}, gn = fn, zn = fn;
    if (gw < MTOK) { const size_t base = (size_t)gw * 512 + 128 * l4 + 8 * l15; fn = *(const u32x4*)(od + base); gn = *(const u32x4*)(od + (size_t)MTOK * 512 + base);
        zn = *(const u32x4*)(proj + (size_t)gw * NPROJ + 1536 + 128 * l4 + 8 * l15); }
    for (int it = gw; it < MTOK; it += NGW) {
        const u32x4 f = fn, g = gn, z = zn;
        if (it + NGW < MTOK) { const size_t base = (size_t)(it + NGW) * 512 + 128 * l4 + 8 * l15; fn = *(const u32x4*)(od + base); gn = *(const u32x4*)(od + (size_t)MTOK * 512 + base);
            zn = *(const u32x4*)(proj + (size_t)(it + NGW) * NPROJ + 1536 + 128 * l4 + 8 * l15); }
        float o[8] = {bflo(f.x) + bflo(g.x), bfhi(f.x) + bfhi(g.x), bflo(f.y) + bflo(g.y), bfhi(f.y) + bfhi(g.y), bflo(f.z) + bflo(g.z), bfhi(f.z) + bfhi(g.z), bflo(f.w) + bflo(g.w), bfhi(f.w) + bfhi(g.w)};
        float ss = 0.f;
#pragma unroll
        for (int e = 0; e < 8; ++e) ss += o[e] * o[e];
        ss += __shfl_xor(ss, 1); ss += __shfl_xor(ss, 2); ss += __shfl_xor(ss, 4); ss += __shfl_xor(ss, 8);
        const float r = rsqrtf(ss * (1.f / HD) + EPS);
        const float zf[8] = {bflo(z.x), bfhi(z.x), bflo(z.y), bfhi(z.y), bflo(z.z), bfhi(z.z), bflo(z.w), bfhi(z.w)};
        u32x4 w;
        w.x = cvt_pk_bf16(o[0] * r * hw0[0] * silu_f(zf[0]), o[1] * r * hw0[1] * silu_f(zf[1])); w.y = cvt_pk_bf16(o[2] * r * hw0[2] * silu_f(zf[2]), o[3] * r * hw0[3] * silu_f(zf[3]));
        w.z = cvt_pk_bf16(o[4] * r * hw1[0] * silu_f(zf[4]), o[5] * r * hw1[1] * silu_f(zf[5])); w.w = cvt_pk_bf16(o[6] * r * hw1[2] * silu_f(zf[6]), o[7] * r * hw1[3] * silu_f(zf[7]));
        *(u32x4*)(amix + (size_t)it * D + 128 * l4 + 8 * l15) = w;
    }
}

__device__ __forceinline__ int block_sum(int v, LAS int* slot8, int wave, int lane) {
#pragma unroll
    for (int o = 1; o < 64; o <<= 1) v += __shfl_xor(v, o);
    if (lane == 0) slot8[wave] = v;
    __syncthreads();
    int s = 0;
#pragma unroll
    for (int w = 0; w < 8; ++w) s += slot8[w];
    return s;
}
__device__ __forceinline__ int block_excl_scan(int v, LAS int* slot8, int wave, int lane) {
    int inc = v;
#pragma unroll
    for (int o = 1; o < 64; o <<= 1) { const int t = __shfl_up(inc, o); if (lane >= o) inc += t; }
    if (lane == 63) slot8[wave] = inc;
    __syncthreads();
    int off = 0;
#pragma unroll
    for (int w = 0; w < 8; ++w) off += (w < wave) ? slot8[w] : 0;
    return off + inc - v;
}
__device__ __forceinline__ void ph_topk_gather(const Args& a, LAS unsigned char* lds) {
    const int tid = tid_fresh(), lane = tid & 63, wave = tid >> 6;
    const float* probs = (const float*)(a.ws + WS_PROBS);
    int* inv = (int*)(a.ws + WS_INV); int* seli = (int*)(a.ws + WS_SELI); float* selg = (float*)(a.ws + WS_SELG);
    LAS int* red = (LAS int*)lds;
    for (int job = blockIdx.x; job < NB * NE; job += gridDim.x) {
        const int be = job, b = be >> 4, e = be & 15;
        unsigned v[4];
#pragma unroll
        for (int j = 0; j < 4; ++j) v[j] = __float_as_uint(probs[(size_t)(b * T + 4 * tid + j) * 16 + e]);
        __syncthreads();
        unsigned thr = 0u;
#pragma unroll 1
        for (int rd = 0; rd < 8; ++rd) { const int sh = 28 - 4 * rd;
            LAS int* slot = red + 128 * (rd & 1);
#pragma unroll
            for (int i = 1; i < 16; ++i) { const unsigned cand = thr | ((unsigned)i << sh); int c = 0;
#pragma unroll
                for (int j = 0; j < 4; ++j) c += (int)__builtin_popcountll(__ballot(v[j] >= cand));
                if (lane == 0) slot[wave * 16 + i] = c; }
            __syncthreads();
            int best = 0;
#pragma unroll
            for (int i = 1; i < 16; ++i) { int c = 0;
#pragma unroll
                for (int w8 = 0; w8 < 8; ++w8) c += slot[w8 * 16 + i];
                best = (c >= CAP) ? i : best; }
            thr |= (unsigned)best << sh; }
        __syncthreads();
        int cgt = 0, ceq = 0;
#pragma unroll
        for (int j = 0; j < 4; ++j) { cgt += (v[j] > thr) ? 1 : 0; ceq += (v[j] == thr) ? 1 : 0; }
        const int tot_gt = block_sum(cgt, red + 8 * 32, wave, lane);
        const int need_eq = CAP - tot_gt;
        const int eq_before = block_excl_scan(ceq, red + 8 * 33, wave, lane);
        int sel[4], nsel = 0, eqc = eq_before;
#pragma unroll
        for (int j = 0; j < 4; ++j) { const bool iseq = (v[j] == thr); sel[j] = (v[j] > thr) || (iseq && eqc < need_eq); eqc += iseq ? 1 : 0; nsel += sel[j]; }
        int slot = block_excl_scan(nsel, red + 8 * 34, wave, lane);
#pragma unroll
        for (int j = 0; j < 4; ++j) { const int t = 4 * tid + j;
            if (sel[j]) { seli[be * CAP + slot] = b * T + t; selg[be * CAP + slot] = __uint_as_float(v[j]); }
            inv[(size_t)(b * T + t) * 16 + e] = sel[j] ? slot : -1;
            slot += sel[j]; }
        __syncthreads();
    }
}

__device__ __forceinline__ void ph_final(const Args& a, bool with_ffn) {
    const int tid = tid_fresh(), lane = tid & 63, wave = tid >> 6;
    const int* inv = (const int*)(a.ws + WS_INV); const bf16_t* y = (const bf16_t*)(a.ws + WS_Y); const float* selg = (const float*)(a.ws + WS_SELG);
    const f32x4* nw4 = (const f32x4*)a.in[17] + lane;
    f32x4 w4[4];
#pragma unroll
    for (int j = 0; j < 4; ++j) w4[j] = nw4[64 * j];
    const int gw = blockIdx.x * NWAVE + wave, NGW = gridDim.x * NWAVE;
    const bf16_t* hb = (const bf16_t*)(a.ws + WS_HB);
    u32x2 hn[4]; int invn = -1;
    if (gw < MTOK) { const u32x2* xr0 = (const u32x2*)(hb + (size_t)gw * D) + lane;
#pragma unroll
        for (int j = 0; j < 4; ++j) hn[j] = xr0[64 * j];
        if (with_ffn && lane < NE) invn = inv[(size_t)gw * 16 + lane]; }
    for (int row = gw; row < MTOK; row += NGW) {
        f32x4* xr = (f32x4*)(a.out + (size_t)row * D) + lane;
        f32x4 v[4];
#pragma unroll
        for (int j = 0; j < 4; ++j) v[j] = (f32x4){bflo(hn[j].x), bfhi(hn[j].x), bflo(hn[j].y), bfhi(hn[j].y)};
        const int myinv = invn;
        if (row + NGW < MTOK) { const u32x2* xr1 = (const u32x2*)(hb + (size_t)(row + NGW) * D) + lane;
#pragma unroll
            for (int j = 0; j < 4; ++j) hn[j] = xr1[64 * j];
            invn = (with_ffn && lane < NE) ? inv[(size_t)(row + NGW) * 16 + lane] : -1; }
        if (with_ffn) {
            const int b = row >> 11;
            unsigned long long mask = __ballot(myinv >= 0);
            while (mask) {
                int yrow[4]; float gq[4];
#pragma unroll
                for (int q = 0; q < 4; ++q) { const bool ok = mask != 0ull; const int e = ok ? (int)__builtin_ctzll(mask) : 0; if (ok) mask &= mask - 1ull;
                    const int sl = __shfl(myinv, e); yrow[q] = (b * NE + e) * CAP + (ok ? sl : 0); gq[q] = ok ? selg[yrow[q]] : 0.f; }
                u32x2 wq[4][4];
#pragma unroll
                for (int q = 0; q < 4; ++q) { const u32x2* yr = (const u32x2*)(y + (size_t)yrow[q] * D) + lane;
#pragma unroll
                    for (int j = 0; j < 4; ++j) wq[q][j] = yr[64 * j]; }
#pragma unroll
                for (int q = 0; q < 4; ++q)
#pragma unroll
                    for (int j = 0; j < 4; ++j) { v[j].x += gq[q] * bflo(wq[q][j].x); v[j].y += gq[q] * bfhi(wq[q][j].x); v[j].z += gq[q] * bflo(wq[q][j].y); v[j].w += gq[q] * bfhi(wq[q][j].y); }
            }
        }
        float ss = 0.f;
#pragma unroll
        for (int j = 0; j < 4; ++j) ss += (v[j].x * v[j].x + v[j].y * v[j].y) + (v[j].z * v[j].z + v[j].w * v[j].w);
        const float r = rsqrtf(wave_sum(ss) * (1.f / D) + EPS);
#pragma unroll
        for (int j = 0; j < 4; ++j) xr[64 * j] = v[j] * r * w4[j];
    }
}

#ifndef EXP_VAR
#define EXP_VAR 0
#endif
#ifndef DBL_MASK
#define DBL_MASK 0
#endif
#ifndef PH_PER_LAUNCH
#define PH_PER_LAUNCH 1
#endif
#ifndef PLAIN_LAUNCH
#define PLAIN_LAUNCH 0
#endif
#ifndef USE_CG_SYNC
#define USE_CG_SYNC 0
#endif
#ifndef ONE_LAUNCH
#define ONE_LAUNCH 1
#endif
#ifndef DBG_STAGE
#define DBG_STAGE 3
#endif
#define XB_TMO      128
#define XB_XCNT(j)  (256  + 64 * (j))
#define XB_XSUB(j)  (1280 + 64 * (j))
#define XB_XGEN(j)  (2304 + 64 * (j))
#define XB_TOP      3328
#define XB_TOPGEN   3392
#define XCD_BAR_WORDS 3456
#define XB_SPIN_CAP (1u << 20)
__device__ __forceinline__ unsigned xb_ld(unsigned* p)              { return __hip_atomic_load(p, __ATOMIC_RELAXED, __HIP_MEMORY_SCOPE_AGENT); }
__device__ __forceinline__ unsigned xb_add(unsigned* p, unsigned v) { return __hip_atomic_fetch_add(p, v, __ATOMIC_RELAXED, __HIP_MEMORY_SCOPE_AGENT); }
__device__ __forceinline__ unsigned xb_xcc_id() { return (unsigned)__builtin_amdgcn_s_getreg((3 << 11) | 20) & 0xFu; }
#define XB_SPIN(cond, bar) do { unsigned _sp = 0; while (cond) { __builtin_amdgcn_s_sleep(1); \
    if ((++_sp & 255u) == 0u) { if (xb_ld(&(bar)[XB_TMO])) break; if (_sp > XB_SPIN_CAP) { atomicAdd(&(bar)[XB_TMO], 1u); break; } } } } while (0)
struct XcdBarrier { unsigned* bar; unsigned x; volatile LAS unsigned* st; };
__device__ __forceinline__ XcdBarrier xcd_barrier_post(unsigned* bar, volatile LAS unsigned* st) {
    XcdBarrier b; b.bar = bar; b.x = xb_xcc_id(); b.st = st;
    if (threadIdx.x == 0) st[2] = xb_add(&bar[XB_XCNT(b.x)], 1u);
    return b;
}
__device__ __forceinline__ void xcd_barrier_complete(unsigned* bar, unsigned x, unsigned& nloc, unsigned& nx) {
    const unsigned G = gridDim.x * gridDim.y * gridDim.z;
    unsigned sum, cnt, mine, sp = 0u;
    for (;;) {
        sum = 0u; cnt = 0u; mine = 0u;
#pragma unroll
        for (unsigned j = 0; j < 16; ++j) { const unsigned c = xb_ld(&bar[XB_XCNT(j)]); sum += c; cnt += (c > 0u) ? 1u : 0u; mine = (j == x) ? c : mine; }
        if (sum == G) break;
        __builtin_amdgcn_s_sleep(1);
        if ((++sp & 255u) == 0u) { if (xb_ld(&bar[XB_TMO])) break; if (sp > XB_SPIN_CAP) { atomicAdd(&bar[XB_TMO], 1u); break; } }
    }
    nloc = mine > 0u ? mine : 1u; nx = cnt > 0u ? cnt : 1u;
}
__device__ __forceinline__ void xcd_barrier(const XcdBarrier& b) {
    asm volatile("s_waitcnt vmcnt(0)" ::: "memory");
    __syncthreads();
    if (threadIdx.x == 0) {
        unsigned* bar = b.bar;
        __builtin_amdgcn_s_waitcnt(0);
        unsigned nloc = b.st[0], nx = b.st[1];
        if (nloc == 0u) { xcd_barrier_complete(bar, b.x, nloc, nx); b.st[0] = nloc; b.st[1] = nx; }
        const unsigned old = xb_add(&bar[XB_XSUB(b.x)], 1u);
        const unsigned gen = old / nloc;
        if (old + 1u == (gen + 1u) * nloc) {
            __builtin_amdgcn_fence(__ATOMIC_RELEASE, "agent");
            asm volatile("s_waitcnt vmcnt(0)" ::: "memory");
            const unsigned og = xb_add(&bar[XB_TOP], 1u);
            const unsigned tg = og / nx;
            if (og + 1u == (tg + 1u) * nx) xb_add(&bar[XB_TOPGEN], 1u);
            else XB_SPIN(xb_ld(&bar[XB_TOPGEN]) == tg, bar);
            __builtin_amdgcn_fence(__ATOMIC_ACQUIRE, "agent");
            xb_add(&bar[XB_XGEN(b.x)], 1u);
            asm volatile("s_waitcnt vmcnt(0)" ::: "memory");
        } else {
            XB_SPIN(xb_ld(&bar[XB_XGEN(b.x)]) == gen, bar);
            __builtin_amdgcn_fence(__ATOMIC_ACQUIRE, "agent");
            asm volatile("s_waitcnt vmcnt(0)" ::: "memory");
        }
    }
    __syncthreads();
}

typedef const __attribute__((address_space(4))) Args* CArgsP;
__device__ __forceinline__ Args fresh_args() {
    Args r{};
#if defined(__HIP_DEVICE_COMPILE__)
    const __attribute__((address_space(4))) unsigned long long* p = (const __attribute__((address_space(4))) unsigned long long*)__builtin_amdgcn_kernarg_segment_ptr();
    asm volatile("" : "+s"(p));
#pragma unroll
    for (int i = 0; i < 18; ++i) r.in[i] = (const float*)(const __attribute__((address_space(1))) float*)p[i];
    r.out = (float*)(__attribute__((address_space(1))) float*)p[18]; r.ws = (unsigned char*)(__attribute__((address_space(1))) unsigned char*)p[19]; r.ph_lo = (int)(unsigned)p[20]; r.ph_hi = (int)(p[20] >> 32);
#endif
    return r;
}
template <int LO, int HI>
__global__ void __launch_bounds__(NTHR, 2) fwd_kernel(Args a_unused) {
    extern __shared__ __attribute__((aligned(16))) unsigned char lds_raw[];
    LAS unsigned char* lds = (LAS unsigned char*)lds_raw;
    int rlo = LO, rhi = HI;
    if constexpr (HI - LO > 1) { const Args a = fresh_args(); rlo = a.ph_lo; rhi = a.ph_hi; }
#define IN(k) (LO <= (k) && (k) < HI)
#define RIN(k) (rlo <= (k) && (k) < rhi)
    XcdBarrier bar; bar.bar = nullptr; bar.x = 0; bar.st = nullptr;
    if constexpr (HI - LO > 1) {
        volatile LAS unsigned* st = (volatile LAS unsigned*)(lds + LDS_BYTES - 16);
        if (threadIdx.x == 0) { st[0] = 0u; st[1] = 0u; }
        __syncthreads();
        const Args a = fresh_args();
        bar = xcd_barrier_post((unsigned*)(a.ws + WS_CTL), st);
    }
#if USE_CG_SYNC
#define SEAM(k) do { if constexpr (IN(k) && IN((k) + 1)) { cooperative_groups::this_grid().sync(); } } while (0)
#else
#define SEAM(k) do { if constexpr (IN(k) && IN((k) + 1)) { if (RIN(k) && RIN((k) + 1)) xcd_barrier(bar); } } while (0)
#endif
    if constexpr (IN(0)) if (RIN(0)) { const Args a = fresh_args(); ph_prologue(a, lds); }
    SEAM(0);
    int vb = blockIdx.x;
    if constexpr (HI - LO > 1) {
        if (RIN(0) && RIN(1)) {
            volatile LAS unsigned* st = (volatile LAS unsigned*)(lds + LDS_BYTES - 16);
            if (threadIdx.x == 0) { bool ok = gridDim.x == 256;
                for (unsigned j = 0; j < 16; ++j) { const unsigned c = xb_ld(&bar.bar[XB_XCNT(j)]); ok = ok && (j < 8 ? c == 32u : c == 0u); }
                st[3] = ok ? (bar.x + 8u * st[2]) : blockIdx.x; }
            __syncthreads();
            vb = __builtin_amdgcn_readfirstlane((int)st[3]);
        }
    }
    if constexpr (IN(1)) if (RIN(1)) { const Args a = fresh_args(); pg8::Gemm g{(const bf16_t*)(a.ws + WS_XN), (const bf16_t*)(a.ws + WS_WIN), D, nullptr}; pg8::StaticOrder S; S.init(MTOK, NPROJ, gridDim.x, vb);
        pg8::EpiProj E{(bf16_t*)(a.ws + WS_PROJ), NPROJ}; pg8::gemm_phase(lds, g, S, E);
        if (DBG_STAGE >= 3) { if (gridDim.x == 256) expert_weight_cvt<true>(a, lds, 0, NEARLY * 1024, 128, 128, vb); else expert_weight_cvt<true>(a, lds, 0, NEARLY * 1024, 0, gridDim.x, blockIdx.x); } }
    SEAM(1);
    if constexpr (IN(2)) if (RIN(2)) { const Args a = fresh_args(); ph_pool(a, lds); if (DBG_STAGE >= 2) ph_chunk_prep(a, lds); }
    SEAM(2);
    if constexpr (IN(3)) if (RIN(3)) { const Args a = fresh_args(); if (DBG_STAGE >= 2) ph_scan<0>(a, lds, vb); }
    SEAM(3);
    if constexpr (IN(4)) if (RIN(4)) { const Args a = fresh_args(); if (DBG_STAGE >= 2) ph_delta_out(a, lds); }
    SEAM(4);
    if constexpr (IN(5)) if (RIN(5)) { { const Args a = fresh_args(); pg8::Gemm g{(const bf16_t*)(a.ws + WS_AMIX), (const bf16_t*)(a.ws + WS_WMIX), D, nullptr}; pg8::StaticOrder S; S.init(MTOK, D, gridDim.x, vb);
        pg8::EpiResid E{a.in[0], (bf16_t*)(a.ws + WS_HB), D}; pg8::gemm_phase(lds, g, S, E); }
        if (DBG_STAGE >= 3) { const Args a = fresh_args(); expert_weight_cvt<false>(a, lds, 0, CVT_SPLIT, 0, gridDim.x, blockIdx.x); } }
    SEAM(5);
    if constexpr (IN(6)) if (RIN(6)) { const Args a = fresh_args(); if (DBG_STAGE >= 3) row_pass<1>(a, lds); }
    SEAM(6);
    if constexpr (IN(7)) if (RIN(7)) { const Args a = fresh_args(); if (DBG_STAGE >= 3) { ph_topk_gather(a, lds); if (gridDim.x > NB * NE) expert_weight_cvt<false>(a, lds, CVT_SPLIT, CVT_ITEMS, NB * NE, gridDim.x - NB * NE, blockIdx.x); else expert_weight_cvt<false>(a, lds, CVT_SPLIT, CVT_ITEMS, 0, gridDim.x, blockIdx.x); } }
    SEAM(7);
    if constexpr (IN(8)) if (RIN(8)) { if (DBG_STAGE >= 3) { const Args a = fresh_args(); pg8::Gemm g{(const bf16_t*)(a.ws + WS_XN), (const bf16_t*)(a.ws + WS_WGU), D, (const int*)(a.ws + WS_SELI)}; pg8::ExpertOrder S; S.init(vb, 16);
        pg8::EpiSwiglu E{(bf16_t*)(a.ws + WS_HMID)}; pg8::gemm_phase<pg8::EpiSwiglu, pg8::ExpertOrder, true>(lds, g, S, E); } }
    SEAM(8);
    if constexpr (IN(9)) if (RIN(9)) { if (DBG_STAGE >= 3) { const Args a = fresh_args(); pg8::Gemm g{(const bf16_t*)(a.ws + WS_HMID), (const bf16_t*)(a.ws + WS_WD), FF, nullptr}; pg8::ExpertOrder S; S.init(vb, 4, NEARLY, (int)((WS_WDA - WS_WD) / ((size_t)256 * FF * 2)));
        pg8::EpiDown E{(bf16_t*)(a.ws + WS_Y)}; pg8::gemm_phase(lds, g, S, E); } }
    SEAM(9);
    if constexpr (IN(10)) if (RIN(10)) { const Args a = fresh_args(); ph_final(a, DBG_STAGE >= 3); }
#undef IN
#undef SEAM
}
template <int VAR> __global__ void __launch_bounds__(NTHR, 2) exp_scan_kernel(Args a_unused) {
    extern __shared__ __attribute__((aligned(16))) unsigned char lds_raw[];
    const Args a = fresh_args(); ph_scan<VAR>(a, (LAS unsigned char*)lds_raw, blockIdx.x);
}
template <int P> static void launch_phase(const Args& a, hipStream_t stream) {
    static bool attr = false;
    if (!attr) { (void)hipFuncSetAttribute((const void*)fwd_kernel<P, P + 1>, hipFuncAttributeMaxDynamicSharedMemorySize, LDS_BYTES); attr = true; }
    hipLaunchKernelGGL((fwd_kernel<P, P + 1>), dim3(NBLK), dim3(NTHR), LDS_BYTES, stream, a);
}

extern "C" void kernel_launch(void* const* d_in, const int* in_sizes, int n_in, void* d_out, int out_size, void* d_ws, size_t ws_size, hipStream_t stream) {
    if (n_in != 18 || out_size != MTOK * D || ws_size < WS_END) { fprintf(stderr, "kernel_launch: unexpected shapes (n_in %d out %d ws %zu)\n", n_in, out_size, ws_size); return; }
    Args a{};
    for (int i = 0; i < 18; ++i) a.in[i] = (const float*)d_in[i];
    a.out = (float*)d_out; a.ws = (unsigned char*)d_ws;
    if (DBG_STAGE < 2) (void)hipMemsetAsync((char*)d_ws + WS_AMIX, 0, 32 * MiB, stream);
#if ONE_LAUNCH
    static int grid = 0;
    if (!grid) {
        int dev = 0, cus = 0, per_cu = 0;
        (void)hipGetDevice(&dev); (void)hipDeviceGetAttribute(&cus, hipDeviceAttributeMultiprocessorCount, dev);
        (void)hipFuncSetAttribute((const void*)fwd_kernel<0, 11>, hipFuncAttributeMaxDynamicSharedMemorySize, LDS_BYTES);
        (void)hipOccupancyMaxActiveBlocksPerMultiprocessor(&per_cu, (const void*)fwd_kernel<0, 11>, NTHR, LDS_BYTES);
        grid = (per_cu >= 1 && cus >= NBLK) ? NBLK : -1;
        if (grid < 0) fprintf(stderr, "kernel_launch: needs %d co-resident workgroups (cus %d, per_cu %d)\n", NBLK, cus, per_cu);
    }
    if (grid < 0) return;
    (void)hipMemsetAsync((char*)d_ws + WS_CTL, 0, 16384, stream);
    void* kargs[] = {(void*)&a};
#if PLAIN_LAUNCH
    (void)kargs;
    for (int p = 0; p < 11; p += PH_PER_LAUNCH) { a.ph_lo = p; a.ph_hi = (p + PH_PER_LAUNCH < 11) ? p + PH_PER_LAUNCH : 11;
        for (int rep = 0; rep < (((DBL_MASK >> p) & 1) ? 2 : 1); ++rep) hipLaunchKernelGGL((fwd_kernel<0, 11>), dim3(NBLK), dim3(NTHR), LDS_BYTES, stream, a);
#if EXP_VAR
        if (p == 3) { static bool at = false; if (!at) { (void)hipFuncSetAttribute((const void*)exp_scan_kernel<EXP_VAR>, hipFuncAttributeMaxDynamicSharedMemorySize, LDS_BYTES); at = true; }
            hipLaunchKernelGGL((exp_scan_kernel<EXP_VAR>), dim3(NBLK), dim3(NTHR), LDS_BYTES, stream, a); }
#endif
    }
#else
    a.ph_lo = 0; a.ph_hi = 11;
    hipError_t e = hipLaunchCooperativeKernel((const void*)fwd_kernel<0, 11>, dim3(NBLK), dim3(NTHR), kargs, LDS_BYTES, stream);
    if (e != hipSuccess) fprintf(stderr, "cooperative launch failed: %s\n", hipGetErrorString(e));
#endif
#else
    launch_phase<0>(a, stream); launch_phase<1>(a, stream); launch_phase<2>(a, stream); launch_phase<3>(a, stream); launch_phase<4>(a, stream); launch_phase<5>(a, stream);
    launch_phase<6>(a, stream); launch_phase<7>(a, stream); launch_phase<8>(a, stream); launch_phase<9>(a, stream); launch_phase<10>(a, stream);
#endif
}
#ifdef TEST_LO
template __global__ void fwd_kernel<TEST_LO, TEST_HI>(Args);
#endif
```

```cpp
#include <hip/hip_runtime.h>
#include <hip/hip_cooperative_groups.h>
#include <cstdio>
#include <cstdint>

#define LAS __attribute__((address_space(3)))
#define GAS __attribute__((address_space(1)))
typedef unsigned short bf16_t;
typedef short bf16x8 __attribute__((ext_vector_type(8)));
typedef float f32x4 __attribute__((ext_vector_type(4)));
typedef float f32x2 __attribute__((ext_vector_type(2)));
typedef unsigned u32x4 __attribute__((ext_vector_type(4)));
typedef unsigned u32x2 __attribute__((ext_vector_type(2)));
typedef int i32x4 __attribute__((ext_vector_type(4)));
typedef int i32x8 __attribute__((ext_vector_type(8)));

constexpr int NB = 8, T = 2048, D = 1024, MTOK = NB * T;
constexpr int INC = 2576, NPROJ = 2560;
constexpr int NH = 4, HD = 128, NCH = T / 64;
constexpr int NE = 16, CAP = 256, FF = 2048;
constexpr float EPS = 1e-6f;
constexpr int NBLK = 256, NTHR = 512, NWAVE = 8;
constexpr int LDS_BYTES = 155648;

constexpr size_t MiB = (size_t)1 << 20;
constexpr size_t WS_CTL = 0;
constexpr size_t WS_WIN = 1 * MiB;
constexpr size_t WS_WMIX = 6 * MiB;
constexpr size_t WS_PREP = 8 * MiB;
constexpr size_t WS_WGU = 8 * MiB;
constexpr size_t WS_WD = 136 * MiB;
constexpr size_t WS_XN = 200 * MiB;
constexpr size_t WS_AMIX = 232 * MiB;
constexpr size_t WS_Y = 200 * MiB;
constexpr size_t WS_GATES = 264 * MiB;
constexpr size_t WS_PROBS = 265 * MiB;
constexpr size_t WS_INV = 266 * MiB;
constexpr size_t WS_SELI = 267 * MiB;
constexpr size_t WS_SELG = 267 * MiB + 131072;
constexpr size_t WS_EGL = 267 * MiB + 262144;
constexpr size_t WS_PROJ = 268 * MiB;
constexpr size_t WS_XG = 268 * MiB;
constexpr size_t WS_OD = 348 * MiB;
constexpr size_t WS_HB = 268 * MiB;
constexpr size_t WS_HMID = 332 * MiB;
constexpr size_t WS_WDA = 460 * MiB;
constexpr int NEARLY = 5;
constexpr size_t WS_END = 480 * MiB;
constexpr size_t PREP_STRIDE = 98304;

struct Args { const float* in[18]; float* out; unsigned char* ws; int ph_lo, ph_hi; };

typedef __bf16 bf16v2_t __attribute__((ext_vector_type(2)));
__device__ __forceinline__ unsigned cvt_pk_bf16_asm(float lo, float hi) { unsigned r; asm volatile("v_cvt_pk_bf16_f32 %0, %1, %2" : "=v"(r) : "v"(lo), "v"(hi)); return r; }
__device__ __forceinline__ unsigned cvt_pk_bf16(float lo, float hi) { f32x2 f = {lo, hi}; return __builtin_bit_cast(unsigned, __builtin_convertvector(f, bf16v2_t)); }
constexpr float F8_ACT = 16.f, F8_WGT = 512.f;
constexpr float F8_DESCALE = 1.f / (F8_ACT * F8_WGT);
__device__ __forceinline__ void mfma_f8_acc(f32x4& c, const i32x8 a, const i32x8 b) { asm volatile("v_mfma_f32_16x16x128_f8f6f4 %0, %1, %2, %0" : "+v"(c) : "v"(a), "v"(b)); }
__device__ __forceinline__ float f8clamp(float v) { return __builtin_amdgcn_fmed3f(v, -448.f, 448.f); }
__device__ __forceinline__ unsigned pk4_fp8(float a, float b, float c, float d) { int w = 0; w = __builtin_amdgcn_cvt_pk_fp8_f32(f8clamp(a), f8clamp(b), w, false); w = __builtin_amdgcn_cvt_pk_fp8_f32(f8clamp(c), f8clamp(d), w, true); return (unsigned)w; }
__device__ __forceinline__ float bf2f(unsigned h) { return __uint_as_float(h << 16); }
__device__ __forceinline__ float bflo(unsigned w) { return __uint_as_float(w << 16); }
__device__ __forceinline__ float bfhi(unsigned w) { return __uint_as_float(w & 0xffff0000u); }
__device__ __forceinline__ float wave_sum(float v) {
#pragma unroll
    for (int o = 1; o < 64; o <<= 1) v += __shfl_xor(v, o);
    return v;
}
__device__ __forceinline__ int tid_fresh() { int t = threadIdx.x; asm volatile("" : "+v"(t)); return t; }
__device__ __forceinline__ float silu_f(float x) { return x * __builtin_amdgcn_rcpf(1.f + __expf(-x)); }
__device__ __forceinline__ float sigmoid_f(float x) { return __builtin_amdgcn_rcpf(1.f + __expf(-x)); }
__device__ __forceinline__ float softplus_f(float x) { return fmaxf(x, 0.f) + log1pf(__expf(-fabsf(x))); }

namespace pg8 {
constexpr int BM = 256, BK = 64, HALF = 128, HTB = HALF * BK * 2, STAGE_BYTES = 8 * HTB, NXCD = 8, WGM = 8;
__host__ __device__ __forceinline__ int lds_byte(int r, int c) { const int st = (r >> 4) * 2 + (c >> 5), rr = r & 15, cc = c & 31, ob = rr * 64 + cc * 2; return st * 1024 + (ob ^ (((ob >> 9) & 1) << 5)); }
__host__ __device__ __forceinline__ void stage_rc(int b, int& R, int& C) { const int st = b / 1024, sb = b % 1024, swz = sb ^ (((sb >> 9) & 1) << 5); R = (st >> 1) * 16 + swz / 64; C = (st & 1) * 32 + (swz % 64) / 2; }
__host__ __device__ __forceinline__ int perm32(int rho) { const int n = rho >> 4, i = rho & 15; return 8 * (i >> 2) + 4 * n + (i & 3); }

struct Unit { int pm, pn; };
struct Gemm { const bf16_t* A; const bf16_t* Bt; int K; const int* gidx; };

struct StaticOrder {
    int nM, nN, nwg, G, c;
    __device__ void init(int M, int N, int G_, int c_) { nM = M / BM; nN = N / BM; nwg = nM * nN; G = G_; c = c_; }
    __device__ int pm_of(int) const { return 0; }
    __device__ bool next(int i, Unit& u) const {
        const long L = (long)i * G + c; if (L >= nwg) return false;
        int wgid = (int)L; { const int q = nwg / NXCD, r = nwg % NXCD, xcd = wgid % NXCD, off = wgid / NXCD; wgid = (xcd < r ? xcd * (q + 1) : r * (q + 1) + (xcd - r) * q) + off; }
        const int nig = WGM * nN, gid = wgid / nig, fm = gid * WGM, gsz = (nM - fm) < WGM ? (nM - fm) : WGM;
        u.pm = fm + ((wgid % nig) % gsz); u.pn = (wgid % nig) / gsz; return true;
    }
};
struct ExpertOrder {
    int x, b, pnq, ntile, rounds, rpe, early, eshift;
    __device__ void init(int c, int ntile_, int early_ = 0, int eshift_ = 0) { x = c & 7; const int j = c >> 3; b = j & 7; pnq = j >> 3; ntile = ntile_; rpe = ntile_ >> 2; rounds = 2 * rpe; early = early_; eshift = eshift_; }
    __device__ bool next(int i, Unit& u) const { if (i >= rounds) return false; const int e = 2 * x + (i / rpe); u.pm = b * NE + e; u.pn = e * ntile + 4 * (i % rpe) + pnq + (e < early ? eshift : 0); return true; }
    __device__ int pm_of(int k) const { return b * NE + 2 * x + k; }
};

template <class Epi, class Sched, bool GATHER = false, bool F8 = false>
__device__ __forceinline__ void gemm_phase(LAS unsigned char* lds, const Gemm g, const Sched& S, const Epi& E) {
    const int tid = tid_fresh(), wid = __builtin_amdgcn_readfirstlane(tid >> 6), lane = tid & 63, wr = wid >> 2, wc = wid & 3, fr = lane & 15, fq = lane >> 4;
    const int K = g.K, nt = K / BK;
    unsigned voffA[2], voffB[2];
#pragma unroll
    for (int i = 0; i < 2; ++i) { int R, C; stage_rc(tid * 16 + i * 8192, R, C); const int Rb = Epi::PERM ? ((R & ~31) + perm32(R & 31)) : R;
        voffA[i] = (unsigned)(R * K + C) * 2u; voffB[i] = (unsigned)(Rb * K + C) * 2u; }
    const size_t kstep = (size_t)(BK * 2);
    const size_t hstep = (size_t)HALF * K * 2;
    const size_t tstep = 2 * hstep;
    const size_t tstepA = GATHER ? 0 : tstep;
    unsigned tab[2][2][2];
    const int pmB = S.pm_of(1);
    if constexpr (GATHER) {
#pragma unroll
        for (int ei = 0; ei < 2; ++ei)
#pragma unroll
            for (int hf = 0; hf < 2; ++hf)
#pragma unroll
                for (int i = 0; i < 2; ++i) { int R, C; stage_rc(tid * 16 + i * 8192, R, C); tab[ei][hf][i] = (unsigned)(g.gidx[S.pm_of(ei) * BM + hf * HALF + R] * K + C) * 2u; }
    }
#define PG8_STAGE_A(bufoff, gbase, hf, ei) do { if constexpr (GATHER) { unsigned v_[2]; v_[0] = (ei) ? tab[1][hf][0] : tab[0][hf][0]; v_[1] = (ei) ? tab[1][hf][1] : tab[0][hf][1]; PG8_STAGE(bufoff, gbase, v_); } \
        else { PG8_STAGE(bufoff, (gbase) + (hf) * hstep, voffA); } } while (0)
    const unsigned ldsw = (unsigned)wid * 1024u;
    const int aoff = lds_byte(wr * 64 + fr, fq * 8), boff = lds_byte(wc * 32 + fr, fq * 8);
#define PG8_SA(b, h) (((b) * 2 + (h)) * HTB)
#define PG8_SB(b, h) ((4 + (b) * 2 + (h)) * HTB)
#define PG8_STAGE(bufoff, gbase, voff) do { _Pragma("unroll") for (int _i = 0; _i < 2; ++_i) \
        __builtin_amdgcn_global_load_lds((const unsigned*)((const char*)(gbase) + (voff)[_i]), (LAS unsigned*)(lds + (bufoff) + ldsw + _i * 8192), 16, 0, 0); } while (0)
#define PG8_LDA(dst, b, h) do { _Pragma("unroll") for (int m = 0; m < 4; ++m) _Pragma("unroll") for (int k = 0; k < 2; ++k) dst[m][k] = *(const LAS bf16x8*)(lds + PG8_SA(b, h) + aoff + m * 2048 + k * 1024); } while (0)
#define PG8_LDB(dst, b, h) do { _Pragma("unroll") for (int n = 0; n < 2; ++n) _Pragma("unroll") for (int k = 0; k < 2; ++k) dst[n][k] = *(const LAS bf16x8*)(lds + PG8_SB(b, h) + boff + n * 2048 + k * 1024); } while (0)
#define PG8_CAT(x) __builtin_shufflevector(__builtin_bit_cast(i32x4, (x)[0]), __builtin_bit_cast(i32x4, (x)[1]), 0, 1, 2, 3, 4, 5, 6, 7)
#define PG8_MMA(ai, bj, At, Bt) do { __builtin_amdgcn_s_setprio(1); _Pragma("unroll") for (int m = 0; m < 4; ++m) _Pragma("unroll") for (int n = 0; n < 2; ++n) { \
        if constexpr (F8) mfma_f8_acc(acc[ai][bj][m][n], PG8_CAT(Bt[n]), PG8_CAT(At[m])); \
        else { _Pragma("unroll") for (int k = 0; k < 2; ++k) acc[ai][bj][m][n] = __builtin_amdgcn_mfma_f32_16x16x32_bf16(Bt[n][k], At[m][k], acc[ai][bj][m][n], 0, 0, 0); } } \
        __builtin_amdgcn_s_setprio(0); } while (0)
#define PG8_WAIT_V(n) asm volatile("s_waitcnt vmcnt(" #n ")" ::: "memory")
#define PG8_WAIT_L(n) asm volatile("s_waitcnt lgkmcnt(" #n ")" ::: "memory")
#define PG8_BAR __builtin_amdgcn_s_barrier()
#define PG8_SCHED __builtin_amdgcn_sched_barrier(0)
    Unit cur, nxt; int ui = 0;
    if (!S.next(0, cur)) return;
    f32x4 acc[2][2][4][2];
#pragma unroll
    for (int a = 0; a < 2; ++a)
#pragma unroll
        for (int b = 0; b < 2; ++b)
#pragma unroll
            for (int m = 0; m < 4; ++m)
#pragma unroll
                for (int n = 0; n < 2; ++n) acc[a][b][m][n] = (f32x4){0.f, 0.f, 0.f, 0.f};
    bf16x8 At[4][2], B0[2][2], B1[2][2];
    const char* cA = (const char*)g.A + (size_t)cur.pm * tstepA; const char* cB = (const char*)g.Bt + (size_t)cur.pn * tstep;
    bool cur_ei = GATHER && cur.pm == pmB, nxt_ei = cur_ei;
    PG8_STAGE(PG8_SB(0, 0), cB, voffB); PG8_STAGE(PG8_SB(0, 1), cB + hstep, voffB); PG8_STAGE_A(PG8_SA(0, 0), cA, 0, cur_ei); PG8_STAGE_A(PG8_SA(0, 1), cA, 1, cur_ei);
    if (wr == 1) PG8_BAR;
    PG8_WAIT_V(2); PG8_BAR;
    PG8_STAGE(PG8_SB(1, 0), cB + kstep, voffB); PG8_STAGE_A(PG8_SA(1, 0), cA + kstep, 0, cur_ei); PG8_STAGE(PG8_SB(1, 1), cB + hstep + kstep, voffB);
    PG8_WAIT_V(6); PG8_BAR;
    for (;;) {
        const bool has_next = S.next(ui + 1, nxt);
        const char* nA = has_next ? (const char*)g.A + (size_t)nxt.pm * tstepA : cA; const char* nB = has_next ? (const char*)g.Bt + (size_t)nxt.pn * tstep : cB;
        nxt_ei = has_next ? (GATHER && nxt.pm == pmB) : cur_ei;
        for (int t = 0; t < nt; t += 2) {
            const bool last = (t == nt - 2);
            const char* a1 = cA + (size_t)(t + 1) * kstep;
            const char* a2 = last ? nA : cA + (size_t)(t + 2) * kstep; const char* b2 = last ? nB : cB + (size_t)(t + 2) * kstep;
            const char* a3 = a2 + kstep; const char* b3 = b2 + kstep;
            const bool e2 = last ? nxt_ei : cur_ei;
            PG8_LDB(B0, 0, 0); PG8_LDB(B1, 0, 1); PG8_SCHED; PG8_LDA(At, 0, 0); PG8_STAGE_A(PG8_SA(1, 1), a1, 1, cur_ei);
            PG8_WAIT_V(8); PG8_WAIT_L(0); PG8_BAR; PG8_MMA(0, 0, At, B0); PG8_MMA(0, 1, At, B1); PG8_BAR; PG8_SCHED;
            PG8_LDA(At, 0, 1); PG8_STAGE(PG8_SB(0, 0), b2, voffB); PG8_STAGE(PG8_SB(0, 1), b2 + hstep, voffB); PG8_STAGE_A(PG8_SA(0, 0), a2, 0, e2);
            PG8_WAIT_V(8); PG8_WAIT_L(0); PG8_BAR; PG8_MMA(1, 0, At, B0); PG8_MMA(1, 1, At, B1); PG8_BAR; PG8_SCHED;
            PG8_LDB(B0, 1, 0); PG8_LDB(B1, 1, 1); PG8_SCHED; PG8_LDA(At, 1, 0); PG8_STAGE_A(PG8_SA(0, 1), a2, 1, e2);
            PG8_WAIT_V(8); PG8_WAIT_L(0); PG8_BAR; PG8_MMA(0, 0, At, B0); PG8_MMA(0, 1, At, B1); PG8_BAR; PG8_SCHED;
            PG8_LDA(At, 1, 1); PG8_STAGE(PG8_SB(1, 0), b3, voffB); PG8_STAGE(PG8_SB(1, 1), b3 + hstep, voffB); PG8_STAGE_A(PG8_SA(1, 0), a3, 0, e2);
            PG8_WAIT_V(8); PG8_WAIT_L(0); PG8_BAR; PG8_MMA(1, 0, At, B0); PG8_MMA(1, 1, At, B1); PG8_BAR; PG8_SCHED;
        }
        if (wr == 0) PG8_BAR;
        if constexpr (F8) { asm volatile("s_nop 15\n\ts_nop 15" ::: "memory");
#pragma unroll
            for (int a = 0; a < 2; ++a)
#pragma unroll
                for (int b = 0; b < 2; ++b)
#pragma unroll
                    for (int m = 0; m < 4; ++m)
#pragma unroll
                        for (int n = 0; n < 2; ++n) asm volatile("" : "+v"(acc[a][b][m][n])); }
        E(acc, cur, wr, wc, fr, fq);
        if (!has_next) break;
#pragma unroll
        for (int a = 0; a < 2; ++a)
#pragma unroll
            for (int b = 0; b < 2; ++b)
#pragma unroll
                for (int m = 0; m < 4; ++m)
#pragma unroll
                    for (int n = 0; n < 2; ++n) acc[a][b][m][n] = (f32x4){0.f, 0.f, 0.f, 0.f};
        cur = nxt; cA = nA; cB = nB; cur_ei = nxt_ei; ++ui;
        if (wr == 1) PG8_BAR;
    }
    PG8_WAIT_V(0);
    PG8_BAR;
#undef PG8_SA
#undef PG8_SB
#undef PG8_STAGE
#undef PG8_STAGE_A
#undef PG8_LDA
#undef PG8_LDB
#undef PG8_MMA
#undef PG8_CAT
#undef PG8_WAIT_V
#undef PG8_WAIT_L
#undef PG8_BAR
#undef PG8_SCHED
}
struct EpiProj {
    static constexpr bool PERM = true;
    bf16_t* O; int ldc;
    __device__ __forceinline__ void operator()(const f32x4 (&acc)[2][2][4][2], const Unit& u, int wr, int wc, int fr, int fq) const {
        const int row0 = u.pm * BM + wr * 64 + fr, col0 = u.pn * BM + wc * 32 + 8 * fq;
#pragma unroll
        for (int ai = 0; ai < 2; ++ai)
#pragma unroll
            for (int m = 0; m < 4; ++m) { bf16_t* rowp = O + (size_t)(row0 + ai * HALF + m * 16) * ldc + col0;
#pragma unroll
                for (int bj = 0; bj < 2; ++bj) { const f32x4 v0 = acc[ai][bj][m][0], v1 = acc[ai][bj][m][1];
                    u32x4 w; w.x = cvt_pk_bf16_asm(v0[0], v0[1]); w.y = cvt_pk_bf16_asm(v0[2], v0[3]); w.z = cvt_pk_bf16_asm(v1[0], v1[1]); w.w = cvt_pk_bf16_asm(v1[2], v1[3]);
                    *(u32x4*)(rowp + bj * HALF) = w; } }
    }
};
struct EpiResid {
    static constexpr bool PERM = true;
    const float* base; bf16_t* C; int ldc;
    __device__ __forceinline__ void operator()(const f32x4 (&acc)[2][2][4][2], const Unit& u, int wr, int wc, int fr, int fq) const {
        const int row0 = u.pm * BM + wr * 64 + fr, col0 = u.pn * BM + wc * 32 + 8 * fq;
#pragma unroll
        for (int ai = 0; ai < 2; ++ai)
#pragma unroll
            for (int m = 0; m < 4; ++m) { const size_t off = (size_t)(row0 + ai * HALF + m * 16) * ldc + col0;
#pragma unroll
                for (int bj = 0; bj < 2; ++bj) { const f32x4 b0 = *(const f32x4*)(base + off + bj * HALF), b1 = *(const f32x4*)(base + off + bj * HALF + 4);
                    const f32x4 v0 = b0 + acc[ai][bj][m][0], v1 = b1 + acc[ai][bj][m][1];
                    u32x4 w; w.x = cvt_pk_bf16_asm(v0[0], v0[1]); w.y = cvt_pk_bf16_asm(v0[2], v0[3]); w.z = cvt_pk_bf16_asm(v1[0], v1[1]); w.w = cvt_pk_bf16_asm(v1[2], v1[3]);
                    *(u32x4*)(C + off + bj * HALF) = w; }
                asm volatile("" ::: "memory"); }
    }
};
struct EpiSwiglu {
    static constexpr bool PERM = true;
    unsigned char* O;
    __device__ __forceinline__ void operator()(const f32x4 (&acc)[2][2][4][2], const Unit& u, int wr, int wc, int fr, int fq) const {
        const int row0 = u.pm * BM + wr * 64 + fr, col0 = (u.pn & 15) * HALF + wc * 32 + 8 * fq;
#pragma unroll
        for (int ai = 0; ai < 2; ++ai)
#pragma unroll
            for (int m = 0; m < 4; ++m) { unsigned char* rowp = O + (size_t)(row0 + ai * HALF + m * 16) * FF + col0;
                float h[8];
#pragma unroll
                for (int n = 0; n < 2; ++n)
#pragma unroll
                    for (int j = 0; j < 4; ++j) { const float gt = acc[ai][0][m][n][j], up = acc[ai][1][m][n][j]; h[4 * n + j] = silu_f(gt * F8_DESCALE) * (up * (F8_DESCALE * F8_ACT)); }
                u32x2 w; w.x = pk4_fp8(h[0], h[1], h[2], h[3]); w.y = pk4_fp8(h[4], h[5], h[6], h[7]);
                *(u32x2*)rowp = w; }
    }
};
struct EpiDown {
    static constexpr bool PERM = true;
    bf16_t* O;
    __device__ __forceinline__ void operator()(const f32x4 (&acc)[2][2][4][2], const Unit& u, int wr, int wc, int fr, int fq) const {
        const int row0 = u.pm * BM + wr * 64 + fr, col0 = (u.pn & 3) * BM + wc * 32 + 8 * fq;
#pragma unroll
        for (int ai = 0; ai < 2; ++ai)
#pragma unroll
            for (int m = 0; m < 4; ++m) { bf16_t* rowp = O + (size_t)(row0 + ai * HALF + m * 16) * D + col0;
#pragma unroll
                for (int bj = 0; bj < 2; ++bj) { const f32x4 v0 = acc[ai][bj][m][0] * F8_DESCALE, v1 = acc[ai][bj][m][1] * F8_DESCALE;
                    u32x4 w; w.x = cvt_pk_bf16_asm(v0[0], v0[1]); w.y = cvt_pk_bf16_asm(v0[2], v0[3]); w.z = cvt_pk_bf16_asm(v1[0], v1[1]); w.w = cvt_pk_bf16_asm(v1[2], v1[3]);
                    *(u32x4*)(rowp + bj * HALF) = w; } }
    }
};
}

__device__ __forceinline__ void transpose_item(const float* W, int ld, int k0, int n0, bf16_t* WT, size_t dst_row0, int ldt, LAS float* scr, int lane) {
#pragma unroll 8
    for (int i = 0; i < 32; ++i) { const int kk = 2 * i + (lane >> 5); scr[kk * 33 + (lane & 31)] = W[(size_t)(k0 + kk) * ld + n0 + (lane & 31)]; }
    asm volatile("s_waitcnt lgkmcnt(0)" ::: "memory");
    const int c = lane & 7;
#pragma unroll
    for (int j = 0; j < 4; ++j) { const int n = (lane >> 3) + 8 * j; const LAS float* s = scr + (8 * c) * 33 + n;
        u32x4 o; o.x = cvt_pk_bf16(s[0 * 33], s[1 * 33]); o.y = cvt_pk_bf16(s[2 * 33], s[3 * 33]); o.z = cvt_pk_bf16(s[4 * 33], s[5 * 33]); o.w = cvt_pk_bf16(s[6 * 33], s[7 * 33]);
        *(u32x4*)(WT + (dst_row0 + n) * (size_t)ldt + k0 + 8 * c) = o; }
    asm volatile("s_waitcnt lgkmcnt(0)" ::: "memory");
}

__device__ __forceinline__ void transpose_item8(const float* W, int ld, int k0, int n0, unsigned char* WT, size_t dst_row0, int ldt, LAS float* scr, int lane) {
#pragma unroll 8
    for (int i = 0; i < 32; ++i) { const int kk = 2 * i + (lane >> 5); scr[kk * 33 + (lane & 31)] = W[(size_t)(k0 + kk) * ld + n0 + (lane & 31)]; }
    asm volatile("s_waitcnt lgkmcnt(0)" ::: "memory");
    const int c = lane & 3;
#pragma unroll
    for (int j = 0; j < 2; ++j) { const int n = (lane >> 2) + 16 * j; const LAS float* s = scr + (16 * c) * 33 + n;
        u32x4 o;
        o.x = pk4_fp8(s[0 * 33] * F8_WGT, s[1 * 33] * F8_WGT, s[2 * 33] * F8_WGT, s[3 * 33] * F8_WGT); o.y = pk4_fp8(s[4 * 33] * F8_WGT, s[5 * 33] * F8_WGT, s[6 * 33] * F8_WGT, s[7 * 33] * F8_WGT);
        o.z = pk4_fp8(s[8 * 33] * F8_WGT, s[9 * 33] * F8_WGT, s[10 * 33] * F8_WGT, s[11 * 33] * F8_WGT); o.w = pk4_fp8(s[12 * 33] * F8_WGT, s[13 * 33] * F8_WGT, s[14 * 33] * F8_WGT, s[15 * 33] * F8_WGT);
        *(u32x4*)(WT + (dst_row0 + n) * (size_t)ldt + k0 + 16 * c) = o; }
    asm volatile("s_waitcnt lgkmcnt(0)" ::: "memory");
}

#define MFMA16(A, B, C) __builtin_amdgcn_mfma_f32_16x16x32_bf16(A, B, C, 0, 0, 0)
template <int MODE>
__device__ __forceinline__ void row_pass(const Args& a, LAS unsigned char* lds) {
    const int tid = tid_fresh(), lane = tid & 63, wave = __builtin_amdgcn_readfirstlane(tid >> 6), l15 = lane & 15, l4 = lane >> 4;
    const float* src = a.in[0]; const bf16_t* srcb = (const bf16_t*)(a.ws + WS_HB);
    const float* nw = MODE == 0 ? a.in[1] : a.in[12];
    const float* wsm = MODE == 0 ? a.in[2] + 2048 : a.in[13];
    const int ld = MODE == 0 ? INC : NE;
    bf16_t* dst = (bf16_t*)(a.ws + WS_XN);
    float* aux = (float*)(a.ws + (MODE == 0 ? WS_GATES : WS_PROBS));
    LAS unsigned char* XH = lds; LAS unsigned char* XL = lds + 32768; LAS float* PART = (LAS float*)(lds + 65536);
    bf16x8 wh[4], wl[4];
#pragma unroll
    for (int ks = 0; ks < 4; ++ks) { float f[8];
#pragma unroll
        for (int j = 0; j < 8; ++j) f[j] = wsm[(size_t)(128 * wave + 32 * ks + 8 * l4 + j) * ld + l15];
        unsigned hw[4], lw[4];
#pragma unroll
        for (int j = 0; j < 4; ++j) { hw[j] = cvt_pk_bf16(f[2 * j], f[2 * j + 1]); lw[j] = cvt_pk_bf16(f[2 * j] - bflo(hw[j]), f[2 * j + 1] - bfhi(hw[j])); }
        u32x4 hv = (u32x4){hw[0], hw[1], hw[2], hw[3]}, lv = (u32x4){lw[0], lw[1], lw[2], lw[3]};
        wh[ks] = __builtin_bit_cast(bf16x8, hv); wl[ks] = __builtin_bit_cast(bf16x8, lv); }
    const f32x4* nw4 = (const f32x4*)nw + lane;
    f32x4 w4[4];
#pragma unroll
    for (int j = 0; j < 4; ++j) w4[j] = nw4[64 * j];
    const int ec = tid & 15;
    float alog = 0.f, dtb = 0.f;
    if (MODE == 0) { const int h = ec & 3; if (ec < 4) { alog = a.in[4][h]; dtb = a.in[5][h]; } else if (ec >= 8 && ec < 12) { alog = a.in[6][h]; dtb = a.in[7][h]; } }
    constexpr int NGRP = MTOK / 16;
    f32x4 vn[2][4];
    if ((int)blockIdx.x < NGRP) {
#pragma unroll
        for (int q = 0; q < 2; ++q) { const size_t r_ = (size_t)(16 * blockIdx.x + 2 * wave + q);
#pragma unroll
            for (int j = 0; j < 4; ++j) { if (MODE == 0) vn[q][j] = ((const f32x4*)(src + r_ * D) + lane)[64 * j];
                else { const u32x2 w_ = ((const u32x2*)(srcb + r_ * D) + lane)[64 * j]; vn[q][j] = (f32x4){bflo(w_.x), bfhi(w_.x), bflo(w_.y), bfhi(w_.y)}; } } } }
    for (int grp = blockIdx.x; grp < NGRP; grp += gridDim.x) {
        f32x4 v[2][4];
#pragma unroll
        for (int q = 0; q < 2; ++q)
#pragma unroll
            for (int j = 0; j < 4; ++j) v[q][j] = vn[q][j];
        if (grp + (int)gridDim.x < NGRP) {
#pragma unroll
            for (int q = 0; q < 2; ++q) { const size_t r_ = (size_t)(16 * (grp + gridDim.x) + 2 * wave + q);
#pragma unroll
                for (int j = 0; j < 4; ++j) { if (MODE == 0) vn[q][j] = ((const f32x4*)(src + r_ * D) + lane)[64 * j];
                    else { const u32x2 w_ = ((const u32x2*)(srcb + r_ * D) + lane)[64 * j]; vn[q][j] = (f32x4){bflo(w_.x), bfhi(w_.x), bflo(w_.y), bfhi(w_.y)}; } } } }
#pragma unroll
        for (int q = 0; q < 2; ++q) { const int lr = 2 * wave + q, row = 16 * grp + lr; float ss = 0.f;
#pragma unroll
            for (int j = 0; j < 4; ++j) ss += (v[q][j].x * v[q][j].x + v[q][j].y * v[q][j].y) + (v[q][j].z * v[q][j].z + v[q][j].w * v[q][j].w);
            const float r = rsqrtf(wave_sum(ss) * (1.f / D) + EPS);
            u32x2* o8 = (u32x2*)(dst + (size_t)row * D) + lane;
#pragma unroll
            for (int j = 0; j < 4; ++j) { const f32x4 y = v[q][j] * r * w4[j]; u32x2 hw, lw; hw.x = cvt_pk_bf16(y.x, y.y); hw.y = cvt_pk_bf16(y.z, y.w);
                lw.x = cvt_pk_bf16(y.x - bflo(hw.x), y.y - bfhi(hw.x)); lw.y = cvt_pk_bf16(y.z - bflo(hw.y), y.w - bfhi(hw.y));
                if (MODE == 0) o8[64 * j] = hw; else ((unsigned*)((unsigned char*)dst + (size_t)row * D) + lane)[64 * j] = pk4_fp8(y.x * F8_ACT, y.y * F8_ACT, y.z * F8_ACT, y.w * F8_ACT);
                const int off = lr * 2048 + ((((lane >> 1) + 32 * j) ^ lr) << 4) + 8 * (lane & 1);
                *(LAS u32x2*)(XH + off) = hw; *(LAS u32x2*)(XL + off) = lw; } }
        __syncthreads();
        f32x4 acc = (f32x4){0.f, 0.f, 0.f, 0.f};
#pragma unroll
        for (int ks = 0; ks < 4; ++ks) { const int off = l15 * 2048 + (((16 * wave + 4 * ks + l4) ^ l15) << 4);
            const bf16x8 xh = *(const LAS bf16x8*)(XH + off), xl = *(const LAS bf16x8*)(XL + off);
            acc = MFMA16(xh, wh[ks], acc); acc = MFMA16(xh, wl[ks], acc); acc = MFMA16(xl, wh[ks], acc); }
#pragma unroll
        for (int r4 = 0; r4 < 4; ++r4) PART[(wave * 16 + 4 * l4 + r4) * 16 + l15] = acc[r4];
        __syncthreads();
        if (tid < 256) { float s = 0.f;
#pragma unroll
            for (int w8 = 0; w8 < 8; ++w8) s += PART[w8 * 256 + tid];
            float res;
            if (MODE == 0) { if (ec < 4 || (ec >= 8 && ec < 12)) res = -__expf(alog) * softplus_f(s + dtb); else res = sigmoid_f(s); }
            else { float mx = s;
#pragma unroll
                for (int o = 1; o < 16; o <<= 1) mx = fmaxf(mx, __shfl_xor(mx, o));
                const float e = __expf(s - mx); float sm = e;
#pragma unroll
                for (int o = 1; o < 16; o <<= 1) sm += __shfl_xor(sm, o);
                res = e / sm; }
            aux[(size_t)(16 * grp) * 16 + tid] = res; }
        __syncthreads();
    }
}

__device__ __forceinline__ void ph_prologue(const Args& a, LAS unsigned char* lds) {
    const int tid = tid_fresh(), lane = tid & 63, wave = tid >> 6;
    LAS float* scr = (LAS float*)(lds + wave * 8704);
    const int gw = blockIdx.x * NWAVE + wave, NGW = gridDim.x * NWAVE;
    bf16_t* Win = (bf16_t*)(a.ws + WS_WIN); bf16_t* Wmix = (bf16_t*)(a.ws + WS_WMIX);
    constexpr int I_A = 16 * 64, I_B = 16 * 16, I_C = 8 * 32;
    for (int it = gw; it < I_A + I_B + I_C; it += NGW) {
        int r = it;
        if (r < I_A) { const int kb = r / 64, nb = r % 64; transpose_item(a.in[2], INC, 64 * kb, 32 * nb, Win, (size_t)32 * nb, D, scr, lane); continue; } r -= I_A;
        if (r < I_B) { const int kb = r / 16, nb = r % 16; transpose_item(a.in[2] + 2064, INC, 64 * kb, 32 * nb, Win, (size_t)2048 + 32 * nb, D, scr, lane); continue; } r -= I_B;
        { const int kb = r / 32, nb = r % 32; transpose_item(a.in[11], D, 64 * kb, 32 * nb, Wmix, (size_t)32 * nb, D, scr, lane); }
    }
    __syncthreads();
    for (int task = blockIdx.x; task < 256; task += gridDim.x) {
        const int g = task >> 6, n0 = (task & 63) * 16;
        LAS float* Wsc = (LAS float*)lds;
        LAS float* Pw = (LAS float*)(lds + 8192);
        for (int idx = tid; idx < 128 * 16; idx += NTHR) { const int d = idx >> 4, n = idx & 15; Wsc[idx] = a.in[11][(size_t)(512 + 128 * g + d) * D + n0 + n] * a.in[10][128 * g + d]; }
        for (int idx = tid; idx < 128 * 128; idx += NTHR) Pw[(idx >> 7) * 129 + (idx & 127)] = a.in[9][(size_t)g * 16384 + idx];
        __syncthreads();
        const int n = tid & 15, cq = tid >> 4;
        float accv[4] = {0.f, 0.f, 0.f, 0.f};
        for (int d = 0; d < 128; ++d) { const float w = Wsc[d * 16 + n];
#pragma unroll
            for (int j = 0; j < 4; ++j) accv[j] += Pw[(cq * 4 + j) * 129 + d] * w; }
        u32x2 o; o.x = cvt_pk_bf16(accv[0], accv[1]); o.y = cvt_pk_bf16(accv[2], accv[3]);
        *(u32x2*)(Wmix + (size_t)(n0 + n) * D + 512 + 128 * g + cq * 4) = o;
        __syncthreads();
    }
    __syncthreads();
    row_pass<0>(a, lds);
}

constexpr int CVT_ITEMS = NE * 3072, CVT_SPLIT = (CVT_ITEMS * 9 / 10) & ~2047;
template <bool EARLY>
__device__ __forceinline__ void expert_weight_cvt(const Args& a, LAS unsigned char* lds, int it_lo, int it_hi, int wg0, int nwg, int bid) {
    const int tid = tid_fresh(), lane = tid & 63, wave = tid >> 6;
    LAS float* scr = (LAS float*)(lds + wave * 8704);
    const int gw = (bid - wg0) * NWAVE + wave, NGW = nwg * NWAVE;
    unsigned char* Wgu = a.ws + WS_WGU; unsigned char* Wd = a.ws + WS_WD; unsigned char* WdA = a.ws + WS_WDA;
    if (bid < wg0 || bid >= wg0 + nwg) return;
    for (int it = it_lo + gw; it < it_hi; it += NGW) {
        if (EARLY) { const int e = it >> 10, q = it & 1023, kb = q >> 5, nb = q & 31;
            transpose_item8(a.in[16] + (size_t)e * FF * D, D, 64 * kb, 32 * nb, WdA, (size_t)e * 1024 + 32 * nb, FF, scr, lane); continue; }
        const int e = it / 3072, r = it % 3072, which = r >> 10, q = r & 1023;
        if (which < 2) { const int kb = q >> 6, nb = q & 63, f0 = 32 * nb;
            const float* W = (which == 0 ? a.in[14] : a.in[15]) + (size_t)e * D * FF;
            transpose_item8(W, FF, 64 * kb, f0, Wgu, (size_t)e * 4096 + (f0 >> 7) * 256 + which * 128 + (f0 & 127), D, scr, lane);
        } else if (e >= NEARLY) { const int kb = q >> 5, nb = q & 31;
            transpose_item8(a.in[16] + (size_t)e * FF * D, D, 64 * kb, 32 * nb, Wd, (size_t)e * 1024 + 32 * nb, FF, scr, lane); }
    }
}

__device__ __forceinline__ int a128(int row, int col) { return row * 256 + ((((col >> 3) ^ (row & 15))) << 4) + ((col & 7) << 1); }
__device__ __forceinline__ int a64(int row, int col) { return row * 128 + ((((col >> 3) ^ ((row >> 1) & 7))) << 4) + ((col & 7) << 1); }
__device__ __forceinline__ bf16x8 frag128(LAS unsigned char* base, int row0, int k0, int lane) { return *(const LAS bf16x8*)(base + a128(row0 + (lane & 15), k0 + ((lane >> 4) << 3))); }
__device__ __forceinline__ bf16x8 frag64(LAS unsigned char* base, int row0, int k0, int lane) { return *(const LAS bf16x8*)(base + a64(row0 + (lane & 15), k0 + ((lane >> 4) << 3))); }
__device__ __forceinline__ u32x2 pack4(f32x4 v) { u32x2 w; w.x = cvt_pk_bf16(v[0], v[1]); w.y = cvt_pk_bf16(v[2], v[3]); return w; }

template <bool FRAG>
__device__ __forceinline__ void staged_store_16x64(LAS unsigned char* stg, const f32x4 (&t)[4], unsigned char* gmat, int tile16, int half, int lane) {
    const int l15 = lane & 15, l4 = lane >> 4;
#pragma unroll
    for (int k = 0; k < 4; ++k) *(LAS u32x2*)(stg + l15 * 128 + (((2 * k + (l4 >> 1)) ^ (l15 & 7)) << 4) + 8 * (l4 & 1)) = pack4(t[k]);
#pragma unroll
    for (int q = 0; q < 2; ++q) { const int idx = lane + 64 * q, row = idx >> 3, c = idx & 7;
        const u32x4 v = *(const LAS u32x4*)(stg + row * 128 + ((c ^ (row & 7)) << 4));
        const size_t off = FRAG ? (size_t)(tile16 * 4 + 2 * half + (c >> 2)) * 1024 + row * 64 + (c & 3) * 16
                                : (size_t)(tile16 * 8 + 4 * half + (c >> 1)) * 512 + row * 32 + (c & 1) * 16;
        *(u32x4*)(gmat + off) = v; }
}
constexpr int L_QM = 0, L_KM = 16384, L_KT = 32768, L_VT = 49152, L_WT = 114688, L_UT = 131072, L_SM = 147456;
#define L_PD(d)  (65536 + (d) * 24576)
#define L_PTD(d) (65536 + (d) * 24576 + 8192)
#define L_PQD(d) (65536 + (d) * 24576 + 16384)
#define L_TD(d)  (114688 + (d) * 8192)
__device__ __forceinline__ void ph_chunk_prep(const Args& a, LAS unsigned char* lds) {
    const int tid0 = tid_fresh(), wave = __builtin_amdgcn_readfirstlane(tid0 >> 6);
    const bf16_t* proj = (const bf16_t*)(a.ws + WS_PROJ);
    const float* gates = (const float*)(a.ws + WS_GATES);
    float* eglp = (float*)(a.ws + WS_EGL);
    LAS float* sm = (LAS float*)(lds + L_SM);
    const int tn = wave & 3, tm0 = 2 * (wave >> 2);
#define SEG_LANE() int tid = tid0; asm volatile("" : "+v"(tid)); const int lane = tid & 63, l15 = lane & 15, l4 = lane >> 4, ra = 16 * tn + l15; (void)l4; (void)ra; (void)lane
    u32x4 raw[3][6]; float graw[4];
#define PREP_FETCH(task_) do { const int n_ = (task_) & 31, h_ = ((task_) >> 5) & 3, b_ = (task_) >> 7; int tidf = tid0; asm volatile("" : "+v"(tidf)); \
        const int cch_ = tidf & 15, i0_ = 2 * (tidf >> 4); \
        _Pragma("unroll") for (int mtx = 0; mtx < 3; ++mtx) _Pragma("unroll") for (int jj = 0; jj < 6; ++jj) { const int tl_ = n_ * 64 + i0_ - 2 + jj; \
            raw[mtx][jj] = (u32x4){0u, 0u, 0u, 0u}; \
            if (tl_ >= 0 && tl_ < T) raw[mtx][jj] = *(const u32x4*)(proj + (size_t)(b_ * T + tl_) * NPROJ + mtx * 512 + h_ * HD + 8 * cch_); } \
        if (wave == 0) { const float* gp_ = gates + (size_t)(b_ * T + n_ * 64 + (tidf & 63)) * 16; graw[0] = gp_[h_]; graw[1] = gp_[4 + h_]; graw[2] = gp_[8 + h_]; graw[3] = gp_[12 + h_]; } } while (0)
    if ((int)blockIdx.x < NB * NH * NCH) PREP_FETCH((int)blockIdx.x);
    for (int task = blockIdx.x; task < NB * NH * NCH; task += gridDim.x) {
        const int n = task & 31, h = (task >> 5) & 3, b = task >> 7;
        { SEG_LANE();
        if (wave == 0) {
            const float gf = graw[0], bfv = graw[1], gb = graw[2], bbv = graw[3];
            float pf = gf, pb = gb;
#pragma unroll
            for (int o = 1; o < 64; o <<= 1) { const float tf = __shfl_up(pf, o), tb = __shfl_up(pb, o); if (lane >= o) { pf += tf; pb += tb; } }
            const float totb = __shfl(pb, 63);
            sm[lane] = pf; sm[64 + lane] = totb - pb + gb; sm[128 + lane] = bfv; sm[192 + lane] = bbv;
        }
        {
            const int cch = tid & 15, rp = tid >> 4, i0 = 2 * rp;
#pragma unroll
            for (int mtx = 0; mtx < 3; ++mtx) {
                const int colb = mtx * 512 + h * HD + 8 * cch;
                float in[6][8];
#pragma unroll
                for (int jj = 0; jj < 6; ++jj) { const u32x4 w = raw[mtx][jj];
                    in[jj][0] = bflo(w.x); in[jj][1] = bfhi(w.x); in[jj][2] = bflo(w.y); in[jj][3] = bfhi(w.y); in[jj][4] = bflo(w.z); in[jj][5] = bfhi(w.z); in[jj][6] = bflo(w.w); in[jj][7] = bfhi(w.w); }
                float val[2][8];
#pragma unroll
                for (int r = 0; r < 2; ++r)
#pragma unroll
                    for (int e = 0; e < 8; ++e) val[r][e] = 0.f;
#pragma unroll
                for (int j = 0; j < 5; ++j) { const f32x4 c0 = *(const f32x4*)(a.in[3] + (size_t)j * 1536 + colb), c1 = *(const f32x4*)(a.in[3] + (size_t)j * 1536 + colb + 4);
#pragma unroll
                    for (int r = 0; r < 2; ++r) {
#pragma unroll
                        for (int e = 0; e < 4; ++e) { val[r][e] += in[r + j][e] * c0[e]; val[r][4 + e] += in[r + j][4 + e] * c1[e]; } } }
#pragma unroll
                for (int r = 0; r < 2; ++r) { float ss = 0.f;
#pragma unroll
                    for (int e = 0; e < 8; ++e) { val[r][e] = silu_f(val[r][e]); ss += val[r][e] * val[r][e]; }
                    if (mtx < 2) { ss += __shfl_xor(ss, 1); ss += __shfl_xor(ss, 2); ss += __shfl_xor(ss, 4); ss += __shfl_xor(ss, 8);
                        const float sc = rsqrtf(ss + EPS) * (mtx == 0 ? 0.08838834764831845f : 1.f);
#pragma unroll
                        for (int e = 0; e < 8; ++e) val[r][e] *= sc; } }
                if (mtx < 2) {
#pragma unroll
                    for (int r = 0; r < 2; ++r) { u32x4 w; w.x = cvt_pk_bf16(val[r][0], val[r][1]); w.y = cvt_pk_bf16(val[r][2], val[r][3]); w.z = cvt_pk_bf16(val[r][4], val[r][5]); w.w = cvt_pk_bf16(val[r][6], val[r][7]);
                        *(LAS u32x4*)(lds + (mtx == 0 ? L_QM : L_KM) + a128(i0 + r, 8 * cch)) = w; } }
                if (mtx >= 1) {
#pragma unroll
                    for (int e = 0; e < 8; ++e) *(LAS unsigned*)(lds + (mtx == 1 ? L_KT : L_VT) + a64(8 * cch + e, i0)) = cvt_pk_bf16(val[0][e], val[1][e]); }
            }
        }
        }
        if (task + (int)gridDim.x < NB * NH * NCH) PREP_FETCH(task + (int)gridDim.x);
        __syncthreads();
        { SEG_LANE();
            f32x4 kk[2] = {(f32x4){0, 0, 0, 0}, (f32x4){0, 0, 0, 0}}, qk[2] = {(f32x4){0, 0, 0, 0}, (f32x4){0, 0, 0, 0}};
#pragma unroll
            for (int ks = 0; ks < 4; ++ks) { const bf16x8 yk = frag128(lds + L_KM, 16 * tn, 32 * ks, lane), yq = frag128(lds + L_QM, 16 * tn, 32 * ks, lane);
#pragma unroll
                for (int t2 = 0; t2 < 2; ++t2) { const bf16x8 xk = frag128(lds + L_KM, 16 * (tm0 + t2), 32 * ks, lane);
                    kk[t2] = MFMA16(xk, yk, kk[t2]); qk[t2] = MFMA16(xk, yq, qk[t2]); } }
#pragma unroll
            for (int dir = 0; dir < 2; ++dir) {
                LAS float* gc = sm + 64 * dir; LAS float* bet = sm + 128 + 64 * dir;
                const float gca = gc[ra], ba = bet[ra];
#pragma unroll
                for (int t2 = 0; t2 < 2; ++t2) { const int rb0 = 16 * (tm0 + t2) + 4 * l4;
                    f32x4 pv, ptv, pqv, tv;
#pragma unroll
                    for (int r = 0; r < 4; ++r) { const int rb = rb0 + r; const float gcb = gc[rb], bb = bet[rb];
                        const bool st_ab = dir ? (rb > ra) : (rb < ra), st_ba = dir ? (ra > rb) : (ra < rb), in_ab = st_ab || (rb == ra);
                        const float dab = __expf(fminf(gca - gcb, 0.f)), dba = __expf(fminf(gcb - gca, 0.f));
                        pv[r] = st_ab ? ba * kk[t2][r] * dab : 0.f;
                        ptv[r] = st_ba ? bb * kk[t2][r] * dba : 0.f;
                        pqv[r] = in_ab ? qk[t2][r] * dab : 0.f;
                        tv[r] = (rb == ra ? 1.f : 0.f) - pv[r]; }
                    *(LAS u32x2*)(lds + L_PD(dir) + a64(ra, rb0)) = pack4(pv);
                    *(LAS u32x2*)(lds + L_PTD(dir) + a64(ra, rb0)) = pack4(ptv);
                    *(LAS u32x2*)(lds + L_PQD(dir) + a64(ra, rb0)) = pack4(pqv);
                    *(LAS u32x2*)(lds + L_TD(dir) + a64(ra, rb0)) = pack4(tv); }
            }
        }
        __syncthreads();
        if (wave < 4) { SEG_LANE();
            const int d = wave >> 1, R = 32 * (wave & 1);
            LAS unsigned char* Pi = lds + L_PD(d); LAS unsigned char* PTi = lds + L_PTD(d); LAS unsigned char* Ti = lds + L_TD(d); LAS unsigned char* TTi = lds + L_UT + wave * 4096;
            LAS float* gc = sm + 64 * d; LAS float* bet = sm + 128 + 64 * d;
            f32x4 Ta[2][2], TTa[2][2];
#pragma unroll
            for (int mi = 0; mi < 2; ++mi)
#pragma unroll
                for (int ni = 0; ni < 2; ++ni) { const int ar = R + 16 * ni + l15, b0 = R + 16 * mi + 4 * l4;
                    const u32x2 p = *(const LAS u32x2*)(Pi + a64(ar, b0)), pt = *(const LAS u32x2*)(PTi + a64(ar, b0));
                    Ta[mi][ni][0] = (ar == b0 ? 1.f : 0.f) - bflo(p.x); Ta[mi][ni][1] = (ar == b0 + 1 ? 1.f : 0.f) - bfhi(p.x); Ta[mi][ni][2] = (ar == b0 + 2 ? 1.f : 0.f) - bflo(p.y); Ta[mi][ni][3] = (ar == b0 + 3 ? 1.f : 0.f) - bfhi(p.y);
                    TTa[mi][ni][0] = (ar == b0 ? 1.f : 0.f) - bflo(pt.x); TTa[mi][ni][1] = (ar == b0 + 1 ? 1.f : 0.f) - bfhi(pt.x); TTa[mi][ni][2] = (ar == b0 + 2 ? 1.f : 0.f) - bflo(pt.y); TTa[mi][ni][3] = (ar == b0 + 3 ? 1.f : 0.f) - bfhi(pt.y);
                    *(LAS u32x2*)(TTi + a64(16 * ni + l15, b0)) = pack4(TTa[mi][ni]); }
#pragma unroll 1
            for (int s5 = 0; s5 < 5; ++s5) {
                bf16x8 fp[2], fpt[2], ft[2], ftt[2];
#pragma unroll
                for (int mi = 0; mi < 2; ++mi) { fp[mi] = frag64(Pi, R + 16 * mi, R, lane); fpt[mi] = frag64(PTi, R + 16 * mi, R, lane); ft[mi] = frag64(Ti, R + 16 * mi, R, lane);
                    ftt[mi] = *(const LAS bf16x8*)(TTi + a64(16 * mi + l15, R + 8 * l4)); }
                f32x4 pn[2][2], pnt[2][2];
#pragma unroll
                for (int mi = 0; mi < 2; ++mi)
#pragma unroll
                    for (int ni = 0; ni < 2; ++ni) { pn[mi][ni] = (f32x4){0, 0, 0, 0}; pnt[mi][ni] = (f32x4){0, 0, 0, 0};
                        if (s5 < 4) { pn[mi][ni] = MFMA16(fpt[mi], fp[ni], pn[mi][ni]); pnt[mi][ni] = MFMA16(fp[mi], fpt[ni], pnt[mi][ni]); }
                        if (s5 > 0) { Ta[mi][ni] = MFMA16(fpt[mi], ft[ni], Ta[mi][ni]); TTa[mi][ni] = MFMA16(ft[mi], fpt[ni], TTa[mi][ni]); } }
                (void)ftt;
#pragma unroll
                for (int mi = 0; mi < 2; ++mi)
#pragma unroll
                    for (int ni = 0; ni < 2; ++ni) { const int ar = R + 16 * ni + l15, b0 = R + 16 * mi + 4 * l4;
                        if (s5 < 4) { *(LAS u32x2*)(Pi + a64(ar, b0)) = pack4(pn[mi][ni]); *(LAS u32x2*)(PTi + a64(ar, b0)) = pack4(pnt[mi][ni]); }
                        if (s5 > 0 && s5 < 4) *(LAS u32x2*)(Ti + a64(ar, b0)) = pack4(Ta[mi][ni]); }
            }
#pragma unroll
            for (int mi = 0; mi < 2; ++mi)
#pragma unroll
                for (int ni = 0; ni < 2; ++ni) { const int ar = R + 16 * ni + l15, b0 = R + 16 * mi + 4 * l4; f32x4 tw, tu;
#pragma unroll
                    for (int r = 0; r < 4; ++r) { const float bb = bet[b0 + r]; tu[r] = Ta[mi][ni][r] * bb; tw[r] = tu[r] * __expf(gc[b0 + r]); }
                    *(LAS u32x2*)(Ti + a64(ar, b0)) = pack4(Ta[mi][ni]); *(LAS u32x2*)(TTi + a64(16 * ni + l15, b0)) = pack4(TTa[mi][ni]);
                    *(LAS u32x2*)(Pi + a64(ar, b0)) = pack4(tw); *(LAS u32x2*)(PTi + a64(ar, b0)) = pack4(tu); }
        }
        __syncthreads();
        if (wave == 4 || wave == 5) { SEG_LANE();
            const int d = wave - 4, ab = d ? 0 : 1, bb_ = 1 - ab, Ra = 32 * ab, Rb = 32 * bb_;
            LAS unsigned char* Pi = lds + L_PD(d); LAS unsigned char* PTi = lds + L_PTD(d); LAS unsigned char* Ti = lds + L_TD(d);
            LAS unsigned char* TTb = lds + L_UT + (2 * d + bb_) * 4096; LAS unsigned char* Zi = lds + L_KM + d * 4096;
            LAS float* gc = sm + 64 * d; LAS float* bet = sm + 128 + 64 * d;
            bf16x8 x1[2], y1[2];
#pragma unroll
            for (int t = 0; t < 2; ++t) { x1[t] = frag64(PTi, Rb + 16 * t, Ra, lane); y1[t] = frag64(Ti, Ra + 16 * t, Ra, lane); }
#pragma unroll
            for (int mi = 0; mi < 2; ++mi)
#pragma unroll
                for (int ni = 0; ni < 2; ++ni) { f32x4 z = (f32x4){0, 0, 0, 0}; z = MFMA16(x1[mi], y1[ni], z);
                    *(LAS u32x2*)(Zi + a64(16 * ni + l15, Rb + 16 * mi + 4 * l4)) = pack4(z);
                    *(LAS u32x2*)(PTi + a64(Rb + 16 * ni + l15, Ra + 16 * mi + 4 * l4)) = (u32x2){0u, 0u}; }
            bf16x8 x2[2], y2[2];
#pragma unroll
            for (int t = 0; t < 2; ++t) { x2[t] = *(const LAS bf16x8*)(TTb + a64(16 * t + l15, Rb + 8 * l4)); y2[t] = *(const LAS bf16x8*)(Zi + a64(16 * t + l15, Rb + 8 * l4)); }
#pragma unroll
            for (int mj = 0; mj < 2; ++mj)
#pragma unroll
                for (int ni = 0; ni < 2; ++ni) { f32x4 t = (f32x4){0, 0, 0, 0}; t = MFMA16(x2[mj], y2[ni], t);
                    const int ir = Ra + 16 * ni + l15, j0 = Rb + 16 * mj + 4 * l4; f32x4 tw, tu;
#pragma unroll
                    for (int r = 0; r < 4; ++r) { const float bb = bet[j0 + r]; tu[r] = -t[r] * bb; tw[r] = tu[r] * __expf(gc[j0 + r]); }
                    *(LAS u32x2*)(Pi + a64(ir, j0)) = pack4(tw); *(LAS u32x2*)(PTi + a64(ir, j0)) = pack4(tu); }
        }
        __syncthreads();
#pragma unroll 1
        for (int dir = 0; dir < 2; ++dir) {
            LAS float* gc = sm + 64 * dir;
            const float gl = dir ? gc[0] : gc[63];
            { SEG_LANE(); const int d = tid >> 2, ib = (tid & 3) * 16;
#pragma unroll
                for (int cpart = 0; cpart < 2; ++cpart) { const int i = ib + 8 * cpart; const u32x4 w = *(const LAS u32x4*)(lds + L_KT + a64(d, i));
                    float f[8] = {bflo(w.x), bfhi(w.x), bflo(w.y), bfhi(w.y), bflo(w.z), bfhi(w.z), bflo(w.w), bfhi(w.w)};
#pragma unroll
                    for (int e = 0; e < 8; ++e) f[e] *= __expf(gl - gc[i + e]);
                    u32x4 o; o.x = cvt_pk_bf16(f[0], f[1]); o.y = cvt_pk_bf16(f[2], f[3]); o.z = cvt_pk_bf16(f[4], f[5]); o.w = cvt_pk_bf16(f[6], f[7]);
                    *(LAS u32x4*)(lds + L_KM + a64(d, i)) = o; } }
            { SEG_LANE();
                f32x4 wa[4], ua[4];
#pragma unroll
                for (int t4 = 0; t4 < 4; ++t4) { wa[t4] = (f32x4){0, 0, 0, 0}; ua[t4] = (f32x4){0, 0, 0, 0}; }
#pragma unroll
                for (int ks = 0; ks < 2; ++ks) { const bf16x8 yk = frag64(lds + L_KT, 16 * wave, 32 * ks, lane), yv = frag64(lds + L_VT, 16 * wave, 32 * ks, lane);
#pragma unroll
                    for (int t4 = 0; t4 < 4; ++t4) { const bf16x8 xw = frag64(lds + L_PD(dir), 16 * t4, 32 * ks, lane), xu = frag64(lds + L_PTD(dir), 16 * t4, 32 * ks, lane);
                        wa[t4] = MFMA16(xw, yk, wa[t4]); ua[t4] = MFMA16(xu, yv, ua[t4]); } }
                const int rd = 16 * wave + l15;
#pragma unroll
                for (int t4 = 0; t4 < 4; ++t4) { *(LAS u32x2*)(lds + L_WT + a64(rd, 16 * t4 + 4 * l4)) = pack4(wa[t4]); *(LAS u32x2*)(lds + L_UT + a64(rd, 16 * t4 + 4 * l4)) = pack4(ua[t4]); }
            }
            __syncthreads();
            { SEG_LANE();
                const int cd = ((b * NH + h) * NCH + n) * 2 + dir;
                unsigned char* pb = a.ws + WS_PREP + (size_t)cd * PREP_STRIDE;
                if (tid == 0) eglp[cd] = __expf(gl);
                LAS unsigned char* stg = lds + L_PD(dir) + wave * 2048;
                {
                    bf16x8 y[2]; y[0] = frag64(lds + L_KM, 16 * wave, 0, lane); y[1] = frag64(lds + L_KM, 16 * wave, 32, lane);
#pragma unroll
                    for (int hf = 0; hf < 2; ++hf) { f32x4 c[4];
#pragma unroll
                        for (int t4 = 0; t4 < 4; ++t4) { const int t8 = 4 * hf + t4; c[t4] = (f32x4){0, 0, 0, 0};
                            c[t4] = MFMA16(frag64(lds + L_WT, 16 * t8, 0, lane), y[0], c[t4]); c[t4] = MFMA16(frag64(lds + L_WT, 16 * t8, 32, lane), y[1], c[t4]); c[t4] = -c[t4]; }
                        staged_store_16x64<true>(stg, c, pb, wave, hf, lane); }
                }
                {
                    bf16x8 y[2]; y[0] = frag64(lds + L_UT, 16 * wave, 0, lane); y[1] = frag64(lds + L_UT, 16 * wave, 32, lane);
#pragma unroll
                    for (int hf = 0; hf < 2; ++hf) { f32x4 c[4];
#pragma unroll
                        for (int t4 = 0; t4 < 4; ++t4) { const int t8 = 4 * hf + t4; c[t4] = (f32x4){0, 0, 0, 0};
                            c[t4] = MFMA16(frag64(lds + L_KM, 16 * t8, 0, lane), y[0], c[t4]); c[t4] = MFMA16(frag64(lds + L_KM, 16 * t8, 32, lane), y[1], c[t4]); }
                        staged_store_16x64<false>(stg, c, pb + 32768, wave, hf, lane); }
                }
                {
                    bf16x8 y[2]; y[0] = frag64(lds + L_PQD(dir), 16 * tn, 0, lane); y[1] = frag64(lds + L_PQD(dir), 16 * tn, 32, lane);
                    const float eg = __expf(gc[ra]);
                    f32x4 cq[4], co[4];
#pragma unroll
                    for (int t4 = 0; t4 < 4; ++t4) { const int mt = 4 * (wave >> 2) + t4, c0 = 16 * mt + 4 * l4;
                        cq[t4] = (f32x4){0, 0, 0, 0}; co[t4] = (f32x4){0, 0, 0, 0};
                        cq[t4] = MFMA16(frag64(lds + L_WT, 16 * mt, 0, lane), y[0], cq[t4]); cq[t4] = MFMA16(frag64(lds + L_WT, 16 * mt, 32, lane), y[1], cq[t4]);
                        co[t4] = MFMA16(frag64(lds + L_UT, 16 * mt, 0, lane), y[0], co[t4]); co[t4] = MFMA16(frag64(lds + L_UT, 16 * mt, 32, lane), y[1], co[t4]);
                        const u32x2 qw = *(const LAS u32x2*)(lds + L_QM + a128(ra, c0));
                        cq[t4][0] = eg * bflo(qw.x) - cq[t4][0]; cq[t4][1] = eg * bfhi(qw.x) - cq[t4][1]; cq[t4][2] = eg * bflo(qw.y) - cq[t4][2]; cq[t4][3] = eg * bfhi(qw.y) - cq[t4][3]; }
                    staged_store_16x64<true>(stg, cq, pb + 65536, tn, wave >> 2, lane);
                    staged_store_16x64<false>(stg, co, pb + 81920, tn, wave >> 2, lane);
                }
            }
            __syncthreads();
        }
    }
#undef SEG_LANE
#undef PREP_FETCH
}

__device__ __forceinline__ void ph_pool(const Args& a, LAS unsigned char* lds) {
    const int tid = tid_fresh(), lane = tid & 63, wave = __builtin_amdgcn_readfirstlane(tid >> 6), l15 = lane & 15, l4 = lane >> 4;
    const bf16_t* proj = (const bf16_t*)(a.ws + WS_PROJ);
    bf16_t* amix = (bf16_t*)(a.ws + WS_AMIX);
    for (int tile = blockIdx.x; tile < MTOK / 64; tile += gridDim.x) {
        const int tok0 = tile * 64, tl0 = tok0 & (T - 1);
        __syncthreads();
#pragma unroll
        for (int q = 0; q < 10; ++q) { const int idx = tid + NTHR * q, r = idx >> 6, ch = idx & 63, tl = tl0 - 8 + r;
            u32x4 v = (u32x4){0u, 0u, 0u, 0u};
            if (tl >= 0 && tl < T) v = *(const u32x4*)(proj + (size_t)(tok0 - 8 + r) * NPROJ + 2048 + 8 * ch);
            *(LAS u32x4*)(lds + r * 1024 + ch * 16) = v; }
        __syncthreads();
        const int g = wave & 3, w = 2 << g, lo = w >> 1, hi = w - lo - 1, ch = 16 * g + l15;
#pragma unroll 2
        for (int q = 0; q < 8; ++q) {
            const int tk = 8 * q + 4 * (wave >> 2) + l4, tl = tl0 + tk;
            float sum[8] = {0, 0, 0, 0, 0, 0, 0, 0};
            for (int j = -lo; j <= hi; ++j) { const u32x4 v = *(const LAS u32x4*)(lds + (tk + 8 + j) * 1024 + ch * 16);
                sum[0] += bflo(v.x); sum[1] += bfhi(v.x); sum[2] += bflo(v.y); sum[3] += bfhi(v.y); sum[4] += bflo(v.z); sum[5] += bfhi(v.z); sum[6] += bflo(v.w); sum[7] += bfhi(v.w); }
            const u32x4 v = *(const LAS u32x4*)(lds + (tk + 8) * 1024 + ch * 16);
            const int s0 = max(tl - lo, 0), e0 = min(tl + hi + 1, T);
            const float inv = 1.f / (float)(e0 - s0);
            u32x4 o; o.x = cvt_pk_bf16(sum[0] * inv - bflo(v.x), sum[1] * inv - bfhi(v.x)); o.y = cvt_pk_bf16(sum[2] * inv - bflo(v.y), sum[3] * inv - bfhi(v.y));
            o.z = cvt_pk_bf16(sum[4] * inv - bflo(v.z), sum[5] * inv - bfhi(v.z)); o.w = cvt_pk_bf16(sum[6] * inv - bflo(v.w), sum[7] * inv - bfhi(v.w));
            *(u32x4*)(amix + (size_t)(tok0 + tk) * D + 512 + 8 * ch) = o;
        }
    }
    __syncthreads();
}

struct ScanSet { bf16x8 xm[4]; bf16x8 yq[4]; u32x2 cw[2]; u32x2 ow; float egl; };
template <int VAR>
__device__ __forceinline__ void ph_scan(const Args& a, LAS unsigned char* lds, int vb) {
    const int tid = tid_fresh(), lane = tid & 63, wave = __builtin_amdgcn_readfirstlane(tid >> 6), l15 = lane & 15, l4 = lane >> 4;
    const float* eglp = (const float*)(a.ws + WS_EGL);
    bf16_t* od = (bf16_t*)(a.ws + (VAR == 0 ? WS_OD : (size_t)464 * MiB));
    const int tn = wave & 3, eo = wave >> 2;
    for (int job = vb; job < 256; job += gridDim.x) {
        const int x = job & 7, j = job >> 3, chain = x * 8 + (j >> 2), sl = j & 3, dir = chain & 1, bh = chain >> 1, b = bh >> 2, h = bh & 3;
        if (VAR == 1 && sl != 0) continue;
        f32x4 acc[2] = {(f32x4){0, 0, 0, 0}, (f32x4){0, 0, 0, 0}};
        const unsigned offx = (unsigned)(wave * 4) * 1024u + (unsigned)l15 * 64u + (unsigned)l4 * 16u;
        const unsigned offc = 32768u + (unsigned)((2 * sl) * 8 + wave) * 512u + (unsigned)l15 * 32u + (unsigned)l4 * 8u;
        const unsigned offq = 65536u + (unsigned)(tn * 4) * 1024u + (unsigned)l15 * 64u + (unsigned)l4 * 16u;
        const unsigned offo = 81920u + (unsigned)(tn * 8 + 2 * sl + eo) * 512u + (unsigned)l15 * 32u + (unsigned)l4 * 8u;
        const long dstep = dir ? -(long)(2 * PREP_STRIDE) : (long)(2 * PREP_STRIDE);
        const int cd0 = (bh * NCH + (dir ? NCH - 1 : 0)) * 2 + dir;
        const GAS unsigned char* pld = (const GAS unsigned char*)(a.ws + WS_PREP + (size_t)cd0 * PREP_STRIDE);
        const GAS float* pegl = (const GAS float*)(eglp + cd0);
        GAS bf16_t* pod = (GAS bf16_t*)od + ((size_t)dir * MTOK + (size_t)(b * T + (dir ? NCH - 1 : 0) * 64 + 16 * tn + l15)) * 512 + h * HD + 32 * sl + 16 * eo + 4 * l4;
        const long ostep = dir ? -(long)(64 * 512) : (long)(64 * 512);
        const long gstep = dir ? -2 : 2;
#define SCAN_LOAD(S) do { asm volatile("" : "+s"(pld), "+s"(pegl)); \
        _Pragma("unroll") for (int ks = 0; ks < 4; ++ks) { S.xm[ks] = *(const GAS bf16x8*)(pld + offx + 1024 * ks); S.yq[ks] = *(const GAS bf16x8*)(pld + offq + 1024 * ks); } \
        _Pragma("unroll") for (int et = 0; et < 2; ++et) S.cw[et] = *(const GAS u32x2*)(pld + offc + 4096 * et); \
        S.ow = *(const GAS u32x2*)(pld + offo); S.egl = *pegl; pld += dstep; pegl += gstep; } while (0)
#define SCAN_STEP(S, SN, step) do { const int cur_ = (step) & 1; \
        _Pragma("unroll") for (int et = 0; et < 2; ++et) *(LAS u32x2*)(lds + cur_ * 8192 + a128(16 * et + l15, 16 * wave + 4 * l4)) = pack4(acc[et]); \
        asm volatile("s_waitcnt lgkmcnt(0)" ::: "memory"); __builtin_amdgcn_s_barrier(); asm volatile("" ::: "memory"); \
        if ((step) + 3 < NCH) SCAN_LOAD(SN); \
        bf16x8 st_[2][4]; \
        _Pragma("unroll") for (int et = 0; et < 2; ++et) _Pragma("unroll") for (int ks = 0; ks < 4; ++ks) st_[et][ks] = frag128(lds + cur_ * 8192, 16 * et, 32 * ks, lane); \
        f32x4 o_; o_[0] = bflo(S.ow.x); o_[1] = bfhi(S.ow.x); o_[2] = bflo(S.ow.y); o_[3] = bfhi(S.ow.y); \
        _Pragma("unroll") for (int ks = 0; ks < 4; ++ks) o_ = MFMA16(eo ? st_[1][ks] : st_[0][ks], S.yq[ks], o_); \
        _Pragma("unroll") for (int et = 0; et < 2; ++et) { \
            acc[et][0] = S.egl * acc[et][0] + bflo(S.cw[et].x); acc[et][1] = S.egl * acc[et][1] + bfhi(S.cw[et].x); acc[et][2] = S.egl * acc[et][2] + bflo(S.cw[et].y); acc[et][3] = S.egl * acc[et][3] + bfhi(S.cw[et].y); \
            _Pragma("unroll") for (int ks = 0; ks < 4; ++ks) acc[et] = MFMA16(S.xm[ks], st_[et][ks], acc[et]); } \
        asm volatile("" : "+v"(pod)); *(GAS u32x2*)pod = pack4(o_); pod += ostep; } while (0)
        ScanSet s0, s1, s2, s3;
        SCAN_LOAD(s0); SCAN_LOAD(s1); SCAN_LOAD(s2);
        __syncthreads();
#pragma unroll
        for (int step = 0; step < NCH; step += 4) {
            SCAN_STEP(s0, s3, step); SCAN_STEP(s1, s0, step + 1); SCAN_STEP(s2, s1, step + 2); SCAN_STEP(s3, s2, step + 3);
        }
#undef SCAN_LOAD
#undef SCAN_STEP
    }
}

__device__ __forceinline__ void ph_delta_out(const Args& a, LAS unsigned char* lds) {
    const int tid = tid_fresh(), lane = tid & 63, wave = tid >> 6, l15 = lane & 15, l4 = lane >> 4;
    const bf16_t* proj = (const bf16_t*)(a.ws + WS_PROJ); const bf16_t* od = (const bf16_t*)(a.ws + WS_OD);
    bf16_t* amix = (bf16_t*)(a.ws + WS_AMIX);
    const f32x4 hw0 = *(const f32x4*)(a.in[8] + 8 * l15), hw1 = *(const f32x4*)(a.in[8] + 8 * l15 + 4);
    const int gw = blockIdx.x * NWAVE + wave, NGW = gridDim.x * NWAVE;
    u32x4 fn = (u32x4){0u, 0u, 0u, 0u}, gn = fn, zn = fn;
    if (gw < MTOK) { const size_t base = (size_t)gw * 512 + 128 * l4 + 8 * l15; fn = *(const u32x4*)(od + base); gn = *(const u32x4*)(od + (size_t)MTOK * 512 + base);
        zn = *(const u32x4*)(proj + (size_t)gw * NPROJ + 1536 + 128 * l4 + 8 * l15); }
    for (int it = gw; it < MTOK; it += NGW) {
        const u32x4 f = fn, g = gn, z = zn;
        if (it + NGW < MTOK) { const size_t base = (size_t)(it + NGW) * 512 + 128 * l4 + 8 * l15; fn = *(const u32x4*)(od + base); gn = *(const u32x4*)(od + (size_t)MTOK * 512 + base);
            zn = *(const u32x4*)(proj + (size_t)(it + NGW) * NPROJ + 1536 + 128 * l4 + 8 * l15); }
        float o[8] = {bflo(f.x) + bflo(g.x), bfhi(f.x) + bfhi(g.x), bflo(f.y) + bflo(g.y), bfhi(f.y) + bfhi(g.y), bflo(f.z) + bflo(g.z), bfhi(f.z) + bfhi(g.z), bflo(f.w) + bflo(g.w), bfhi(f.w) + bfhi(g.w)};
        float ss = 0.f;
#pragma unroll
        for (int e = 0; e < 8; ++e) ss += o[e] * o[e];
        ss += __shfl_xor(ss, 1); ss += __shfl_xor(ss, 2); ss += __shfl_xor(ss, 4); ss += __shfl_xor(ss, 8);
        const float r = rsqrtf(ss * (1.f / HD) + EPS);
        const float zf[8] = {bflo(z.x), bfhi(z.x), bflo(z.y), bfhi(z.y), bflo(z.z), bfhi(z.z), bflo(z.w), bfhi(z.w)};
        u32x4 w;
        w.x = cvt_pk_bf16(o[0] * r * hw0[0] * silu_f(zf[0]), o[1] * r * hw0[1] * silu_f(zf[1])); w.y = cvt_pk_bf16(o[2] * r * hw0[2] * silu_f(zf[2]), o[3] * r * hw0[3] * silu_f(zf[3]));
        w.z = cvt_pk_bf16(o[4] * r * hw1[0] * silu_f(zf[4]), o[5] * r * hw1[1] * silu_f(zf[5])); w.w = cvt_pk_bf16(o[6] * r * hw1[2] * silu_f(zf[6]), o[7] * r * hw1[3] * silu_f(zf[7]));
        *(u32x4*)(amix + (size_t)it * D + 128 * l4 + 8 * l15) = w;
    }
}

__device__ __forceinline__ int block_sum(int v, LAS int* slot8, int wave, int lane) {
#pragma unroll
    for (int o = 1; o < 64; o <<= 1) v += __shfl_xor(v, o);
    if (lane == 0) slot8[wave] = v;
    __syncthreads();
    int s = 0;
#pragma unroll
    for (int w = 0; w < 8; ++w) s += slot8[w];
    return s;
}
__device__ __forceinline__ int block_excl_scan(int v, LAS int* slot8, int wave, int lane) {
    int inc = v;
#pragma unroll
    for (int o = 1; o < 64; o <<= 1) { const int t = __shfl_up(inc, o); if (lane >= o) inc += t; }
    if (lane == 63) slot8[wave] = inc;
    __syncthreads();
    int off = 0;
#pragma unroll
    for (int w = 0; w < 8; ++w) off += (w < wave) ? slot8[w] : 0;
    return off + inc - v;
}
__device__ __forceinline__ void ph_topk_gather(const Args& a, LAS unsigned char* lds) {
    const int tid = tid_fresh(), lane = tid & 63, wave = tid >> 6;
    const float* probs = (const float*)(a.ws + WS_PROBS);
    int* inv = (int*)(a.ws + WS_INV); int* seli = (int*)(a.ws + WS_SELI); float* selg = (float*)(a.ws + WS_SELG);
    LAS int* red = (LAS int*)lds;
    for (int job = blockIdx.x; job < NB * NE; job += gridDim.x) {
        const int be = job, b = be >> 4, e = be & 15;
        unsigned v[4];
#pragma unroll
        for (int j = 0; j < 4; ++j) v[j] = __float_as_uint(probs[(size_t)(b * T + 4 * tid + j) * 16 + e]);
        __syncthreads();
        unsigned thr = 0u;
#pragma unroll 1
        for (int rd = 0; rd < 8; ++rd) { const int sh = 28 - 4 * rd;
            LAS int* slot = red + 128 * (rd & 1);
#pragma unroll
            for (int i = 1; i < 16; ++i) { const unsigned cand = thr | ((unsigned)i << sh); int c = 0;
#pragma unroll
                for (int j = 0; j < 4; ++j) c += (int)__builtin_popcountll(__ballot(v[j] >= cand));
                if (lane == 0) slot[wave * 16 + i] = c; }
            __syncthreads();
            int best = 0;
#pragma unroll
            for (int i = 1; i < 16; ++i) { int c = 0;
#pragma unroll
                for (int w8 = 0; w8 < 8; ++w8) c += slot[w8 * 16 + i];
                best = (c >= CAP) ? i : best; }
            thr |= (unsigned)best << sh; }
        __syncthreads();
        int cgt = 0, ceq = 0;
#pragma unroll
        for (int j = 0; j < 4; ++j) { cgt += (v[j] > thr) ? 1 : 0; ceq += (v[j] == thr) ? 1 : 0; }
        const int tot_gt = block_sum(cgt, red + 8 * 32, wave, lane);
        const int need_eq = CAP - tot_gt;
        const int eq_before = block_excl_scan(ceq, red + 8 * 33, wave, lane);
        int sel[4], nsel = 0, eqc = eq_before;
#pragma unroll
        for (int j = 0; j < 4; ++j) { const bool iseq = (v[j] == thr); sel[j] = (v[j] > thr) || (iseq && eqc < need_eq); eqc += iseq ? 1 : 0; nsel += sel[j]; }
        int slot = block_excl_scan(nsel, red + 8 * 34, wave, lane);
#pragma unroll
        for (int j = 0; j < 4; ++j) { const int t = 4 * tid + j;
            if (sel[j]) { seli[be * CAP + slot] = b * T + t; selg[be * CAP + slot] = __uint_as_float(v[j]); }
            inv[(size_t)(b * T + t) * 16 + e] = sel[j] ? slot : -1;
            slot += sel[j]; }
        __syncthreads();
    }
}

__device__ __forceinline__ void ph_final(const Args& a, bool with_ffn) {
    const int tid = tid_fresh(), lane = tid & 63, wave = tid >> 6;
    const int* inv = (const int*)(a.ws + WS_INV); const bf16_t* y = (const bf16_t*)(a.ws + WS_Y); const float* selg = (const float*)(a.ws + WS_SELG);
    const f32x4* nw4 = (const f32x4*)a.in[17] + lane;
    f32x4 w4[4];
#pragma unroll
    for (int j = 0; j < 4; ++j) w4[j] = nw4[64 * j];
    const int gw = blockIdx.x * NWAVE + wave, NGW = gridDim.x * NWAVE;
    const bf16_t* hb = (const bf16_t*)(a.ws + WS_HB);
    u32x2 hn[4]; int invn = -1;
    if (gw < MTOK) { const u32x2* xr0 = (const u32x2*)(hb + (size_t)gw * D) + lane;
#pragma unroll
        for (int j = 0; j < 4; ++j) hn[j] = xr0[64 * j];
        if (with_ffn && lane < NE) invn = inv[(size_t)gw * 16 + lane]; }
    for (int row = gw; row < MTOK; row += NGW) {
        f32x4* xr = (f32x4*)(a.out + (size_t)row * D) + lane;
        f32x4 v[4];
#pragma unroll
        for (int j = 0; j < 4; ++j) v[j] = (f32x4){bflo(hn[j].x), bfhi(hn[j].x), bflo(hn[j].y), bfhi(hn[j].y)};
        const int myinv = invn;
        if (row + NGW < MTOK) { const u32x2* xr1 = (const u32x2*)(hb + (size_t)(row + NGW) * D) + lane;
#pragma unroll
            for (int j = 0; j < 4; ++j) hn[j] = xr1[64 * j];
            invn = (with_ffn && lane < NE) ? inv[(size_t)(row + NGW) * 16 + lane] : -1; }
        if (with_ffn) {
            const int b = row >> 11;
            unsigned long long mask = __ballot(myinv >= 0);
            while (mask) {
                int yrow[4]; float gq[4];
#pragma unroll
                for (int q = 0; q < 4; ++q) { const bool ok = mask != 0ull; const int e = ok ? (int)__builtin_ctzll(mask) : 0; if (ok) mask &= mask - 1ull;
                    const int sl = __shfl(myinv, e); yrow[q] = (b * NE + e) * CAP + (ok ? sl : 0); gq[q] = ok ? selg[yrow[q]] : 0.f; }
                u32x2 wq[4][4];
#pragma unroll
                for (int q = 0; q < 4; ++q) { const u32x2* yr = (const u32x2*)(y + (size_t)yrow[q] * D) + lane;
#pragma unroll
                    for (int j = 0; j < 4; ++j) wq[q][j] = yr[64 * j]; }
#pragma unroll
                for (int q = 0; q < 4; ++q)
#pragma unroll
                    for (int j = 0; j < 4; ++j) { v[j].x += gq[q] * bflo(wq[q][j].x); v[j].y += gq[q] * bfhi(wq[q][j].x); v[j].z += gq[q] * bflo(wq[q][j].y); v[j].w += gq[q] * bfhi(wq[q][j].y); }
            }
        }
        float ss = 0.f;
#pragma unroll
        for (int j = 0; j < 4; ++j) ss += (v[j].x * v[j].x + v[j].y * v[j].y) + (v[j].z * v[j].z + v[j].w * v[j].w);
        const float r = rsqrtf(wave_sum(ss) * (1.f / D) + EPS);
#pragma unroll
        for (int j = 0; j < 4; ++j) xr[64 * j] = v[j] * r * w4[j];
    }
}

#ifndef EXP_VAR
#define EXP_VAR 0
#endif
#ifndef DBL_MASK
#define DBL_MASK 0
#endif
#ifndef PH_PER_LAUNCH
#define PH_PER_LAUNCH 1
#endif
#ifndef PLAIN_LAUNCH
#define PLAIN_LAUNCH 0
#endif
#ifndef USE_CG_SYNC
#define USE_CG_SYNC 0
#endif
#ifndef ONE_LAUNCH
#define ONE_LAUNCH 1
#endif
#ifndef DBG_STAGE
#define DBG_STAGE 3
#endif
#define XB_TMO      128
#define XB_XCNT(j)  (256  + 64 * (j))
#define XB_XSUB(j)  (1280 + 64 * (j))
#define XB_XGEN(j)  (2304 + 64 * (j))
#define XB_TOP      3328
#define XB_TOPGEN   3392
#define XCD_BAR_WORDS 3456
#define XB_SPIN_CAP (1u << 20)
__device__ __forceinline__ unsigned xb_ld(unsigned* p)              { return __hip_atomic_load(p, __ATOMIC_RELAXED, __HIP_MEMORY_SCOPE_AGENT); }
__device__ __forceinline__ unsigned xb_add(unsigned* p, unsigned v) { return __hip_atomic_fetch_add(p, v, __ATOMIC_RELAXED, __HIP_MEMORY_SCOPE_AGENT); }
__device__ __forceinline__ unsigned xb_xcc_id() { return (unsigned)__builtin_amdgcn_s_getreg((3 << 11) | 20) & 0xFu; }
#define XB_SPIN(cond, bar) do { unsigned _sp = 0; while (cond) { __builtin_amdgcn_s_sleep(1); \
    if ((++_sp & 255u) == 0u) { if (xb_ld(&(bar)[XB_TMO])) break; if (_sp > XB_SPIN_CAP) { atomicAdd(&(bar)[XB_TMO], 1u); break; } } } } while (0)
struct XcdBarrier { unsigned* bar; unsigned x; volatile LAS unsigned* st; };
__device__ __forceinline__ XcdBarrier xcd_barrier_post(unsigned* bar, volatile LAS unsigned* st) {
    XcdBarrier b; b.bar = bar; b.x = xb_xcc_id(); b.st = st;
    if (threadIdx.x == 0) st[2] = xb_add(&bar[XB_XCNT(b.x)], 1u);
    return b;
}
__device__ __forceinline__ void xcd_barrier_complete(unsigned* bar, unsigned x, unsigned& nloc, unsigned& nx) {
    const unsigned G = gridDim.x * gridDim.y * gridDim.z;
    unsigned sum, cnt, mine, sp = 0u;
    for (;;) {
        sum = 0u; cnt = 0u; mine = 0u;
#pragma unroll
        for (unsigned j = 0; j < 16; ++j) { const unsigned c = xb_ld(&bar[XB_XCNT(j)]); sum += c; cnt += (c > 0u) ? 1u : 0u; mine = (j == x) ? c : mine; }
        if (sum == G) break;
        __builtin_amdgcn_s_sleep(1);
        if ((++sp & 255u) == 0u) { if (xb_ld(&bar[XB_TMO])) break; if (sp > XB_SPIN_CAP) { atomicAdd(&bar[XB_TMO], 1u); break; } }
    }
    nloc = mine > 0u ? mine : 1u; nx = cnt > 0u ? cnt : 1u;
}
__device__ __forceinline__ void xcd_barrier(const XcdBarrier& b) {
    asm volatile("s_waitcnt vmcnt(0)" ::: "memory");
    __syncthreads();
    if (threadIdx.x == 0) {
        unsigned* bar = b.bar;
        __builtin_amdgcn_s_waitcnt(0);
        unsigned nloc = b.st[0], nx = b.st[1];
        if (nloc == 0u) { xcd_barrier_complete(bar, b.x, nloc, nx); b.st[0] = nloc; b.st[1] = nx; }
        const unsigned old = xb_add(&bar[XB_XSUB(b.x)], 1u);
        const unsigned gen = old / nloc;
        if (old + 1u == (gen + 1u) * nloc) {
            __builtin_amdgcn_fence(__ATOMIC_RELEASE, "agent");
            asm volatile("s_waitcnt vmcnt(0)" ::: "memory");
            const unsigned og = xb_add(&bar[XB_TOP], 1u);
            const unsigned tg = og / nx;
            if (og + 1u == (tg + 1u) * nx) xb_add(&bar[XB_TOPGEN], 1u);
            else XB_SPIN(xb_ld(&bar[XB_TOPGEN]) == tg, bar);
            __builtin_amdgcn_fence(__ATOMIC_ACQUIRE, "agent");
            xb_add(&bar[XB_XGEN(b.x)], 1u);
            asm volatile("s_waitcnt vmcnt(0)" ::: "memory");
        } else {
            XB_SPIN(xb_ld(&bar[XB_XGEN(b.x)]) == gen, bar);
            __builtin_amdgcn_fence(__ATOMIC_ACQUIRE, "agent");
            asm volatile("s_waitcnt vmcnt(0)" ::: "memory");
        }
    }
    __syncthreads();
}

typedef const __attribute__((address_space(4))) Args* CArgsP;
__device__ __forceinline__ Args fresh_args() {
    Args r{};
#if defined(__HIP_DEVICE_COMPILE__)
    const __attribute__((address_space(4))) unsigned long long* p = (const __attribute__((address_space(4))) unsigned long long*)__builtin_amdgcn_kernarg_segment_ptr();
    asm volatile("" : "+s"(p));
#pragma unroll
    for (int i = 0; i < 18; ++i) r.in[i] = (const float*)(const __attribute__((address_space(1))) float*)p[i];
    r.out = (float*)(__attribute__((address_space(1))) float*)p[18]; r.ws = (unsigned char*)(__attribute__((address_space(1))) unsigned char*)p[19]; r.ph_lo = (int)(unsigned)p[20]; r.ph_hi = (int)(p[20] >> 32);
#endif
    return r;
}
template <int LO, int HI>
__global__ void __launch_bounds__(NTHR, 2) fwd_kernel(Args a_unused) {
    extern __shared__ __attribute__((aligned(16))) unsigned char lds_raw[];
    LAS unsigned char* lds = (LAS unsigned char*)lds_raw;
    int rlo = LO, rhi = HI;
    if constexpr (HI - LO > 1) { const Args a = fresh_args(); rlo = a.ph_lo; rhi = a.ph_hi; }
#define IN(k) (LO <= (k) && (k) < HI)
#define RIN(k) (rlo <= (k) && (k) < rhi)
    XcdBarrier bar; bar.bar = nullptr; bar.x = 0; bar.st = nullptr;
    if constexpr (HI - LO > 1) {
        volatile LAS unsigned* st = (volatile LAS unsigned*)(lds + LDS_BYTES - 16);
        if (threadIdx.x == 0) { st[0] = 0u; st[1] = 0u; }
        __syncthreads();
        const Args a = fresh_args();
        bar = xcd_barrier_post((unsigned*)(a.ws + WS_CTL), st);
    }
#if USE_CG_SYNC
#define SEAM(k) do { if constexpr (IN(k) && IN((k) + 1)) { cooperative_groups::this_grid().sync(); } } while (0)
#else
#define SEAM(k) do { if constexpr (IN(k) && IN((k) + 1)) { if (RIN(k) && RIN((k) + 1)) xcd_barrier(bar); } } while (0)
#endif
    if constexpr (IN(0)) if (RIN(0)) { const Args a = fresh_args(); ph_prologue(a, lds); }
    SEAM(0);
    int vb = blockIdx.x;
    if constexpr (HI - LO > 1) {
        if (RIN(0) && RIN(1)) {
            volatile LAS unsigned* st = (volatile LAS unsigned*)(lds + LDS_BYTES - 16);
            if (threadIdx.x == 0) { bool ok = gridDim.x == 256;
                for (unsigned j = 0; j < 16; ++j) { const unsigned c = xb_ld(&bar.bar[XB_XCNT(j)]); ok = ok && (j < 8 ? c == 32u : c == 0u); }
                st[3] = ok ? (bar.x + 8u * st[2]) : blockIdx.x; }
            __syncthreads();
            vb = __builtin_amdgcn_readfirstlane((int)st[3]);
        }
    }
    if constexpr (IN(1)) if (RIN(1)) { const Args a = fresh_args(); pg8::Gemm g{(const bf16_t*)(a.ws + WS_XN), (const bf16_t*)(a.ws + WS_WIN), D, nullptr}; pg8::StaticOrder S; S.init(MTOK, NPROJ, gridDim.x, vb);
        pg8::EpiProj E{(bf16_t*)(a.ws + WS_PROJ), NPROJ}; pg8::gemm_phase(lds, g, S, E);
        if (DBG_STAGE >= 3) { if (gridDim.x == 256) expert_weight_cvt<true>(a, lds, 0, NEARLY * 1024, 128, 128, vb); else expert_weight_cvt<true>(a, lds, 0, NEARLY * 1024, 0, gridDim.x, blockIdx.x); } }
    SEAM(1);
    if constexpr (IN(2)) if (RIN(2)) { const Args a = fresh_args(); ph_pool(a, lds); if (DBG_STAGE >= 2) ph_chunk_prep(a, lds); }
    SEAM(2);
    if constexpr (IN(3)) if (RIN(3)) { const Args a = fresh_args(); if (DBG_STAGE >= 2) ph_scan<0>(a, lds, vb); }
    SEAM(3);
    if constexpr (IN(4)) if (RIN(4)) { const Args a = fresh_args(); if (DBG_STAGE >= 2) ph_delta_out(a, lds); }
    SEAM(4);
    if constexpr (IN(5)) if (RIN(5)) { { const Args a = fresh_args(); pg8::Gemm g{(const bf16_t*)(a.ws + WS_AMIX), (const bf16_t*)(a.ws + WS_WMIX), D, nullptr}; pg8::StaticOrder S; S.init(MTOK, D, gridDim.x, vb);
        pg8::EpiResid E{a.in[0], (bf16_t*)(a.ws + WS_HB), D}; pg8::gemm_phase(lds, g, S, E); }
        if (DBG_STAGE >= 3) { const Args a = fresh_args(); expert_weight_cvt<false>(a, lds, 0, CVT_SPLIT, 0, gridDim.x, blockIdx.x); } }
    SEAM(5);
    if constexpr (IN(6)) if (RIN(6)) { const Args a = fresh_args(); if (DBG_STAGE >= 3) row_pass<1>(a, lds); }
    SEAM(6);
    if constexpr (IN(7)) if (RIN(7)) { const Args a = fresh_args(); if (DBG_STAGE >= 3) { ph_topk_gather(a, lds); if (gridDim.x > NB * NE) expert_weight_cvt<false>(a, lds, CVT_SPLIT, CVT_ITEMS, NB * NE, gridDim.x - NB * NE, blockIdx.x); else expert_weight_cvt<false>(a, lds, CVT_SPLIT, CVT_ITEMS, 0, gridDim.x, blockIdx.x); } }
    SEAM(7);
    if constexpr (IN(8)) if (RIN(8)) { if (DBG_STAGE >= 3) { const Args a = fresh_args(); pg8::Gemm g{(const bf16_t*)(a.ws + WS_XN), (const bf16_t*)(a.ws + WS_WGU), D / 2, (const int*)(a.ws + WS_SELI)}; pg8::ExpertOrder S; S.init(vb, 16);
        pg8::EpiSwiglu E{a.ws + WS_HMID}; pg8::gemm_phase<pg8::EpiSwiglu, pg8::ExpertOrder, true, true>(lds, g, S, E); } }
    SEAM(8);
    if constexpr (IN(9)) if (RIN(9)) { if (DBG_STAGE >= 3) { const Args a = fresh_args(); pg8::Gemm g{(const bf16_t*)(a.ws + WS_HMID), (const bf16_t*)(a.ws + WS_WD), FF / 2, nullptr}; pg8::ExpertOrder S; S.init(vb, 4, NEARLY, (int)((WS_WDA - WS_WD) / ((size_t)256 * FF)));
        pg8::EpiDown E{(bf16_t*)(a.ws + WS_Y)}; pg8::gemm_phase<pg8::EpiDown, pg8::ExpertOrder, false, true>(lds, g, S, E); } }
    SEAM(9);
    if constexpr (IN(10)) if (RIN(10)) { const Args a = fresh_args(); ph_final(a, DBG_STAGE >= 3); }
#undef IN
#undef SEAM
}
template <int VAR> __global__ void __launch_bounds__(NTHR, 2) exp_scan_kernel(Args a_unused) {
    extern __shared__ __attribute__((aligned(16))) unsigned char lds_raw[];
    const Args a = fresh_args(); ph_scan<VAR>(a, (LAS unsigned char*)lds_raw, blockIdx.x);
}
template <int P> static void launch_phase(const Args& a, hipStream_t stream) {
    static bool attr = false;
    if (!attr) { (void)hipFuncSetAttribute((const void*)fwd_kernel<P, P + 1>, hipFuncAttributeMaxDynamicSharedMemorySize, LDS_BYTES); attr = true; }
    hipLaunchKernelGGL((fwd_kernel<P, P + 1>), dim3(NBLK), dim3(NTHR), LDS_BYTES, stream, a);
}

extern "C" void kernel_launch(void* const* d_in, const int* in_sizes, int n_in, void* d_out, int out_size, void* d_ws, size_t ws_size, hipStream_t stream) {
    if (n_in != 18 || out_size != MTOK * D || ws_size < WS_END) { fprintf(stderr, "kernel_launch: unexpected shapes (n_in %d out %d ws %zu)\n", n_in, out_size, ws_size); return; }
    Args a{};
    for (int i = 0; i < 18; ++i) a.in[i] = (const float*)d_in[i];
    a.out = (float*)d_out; a.ws = (unsigned char*)d_ws;
    if (DBG_STAGE < 2) (void)hipMemsetAsync((char*)d_ws + WS_AMIX, 0, 32 * MiB, stream);
#if ONE_LAUNCH
    static int grid = 0;
    if (!grid) {
        int dev = 0, cus = 0, per_cu = 0;
        (void)hipGetDevice(&dev); (void)hipDeviceGetAttribute(&cus, hipDeviceAttributeMultiprocessorCount, dev);
        (void)hipFuncSetAttribute((const void*)fwd_kernel<0, 11>, hipFuncAttributeMaxDynamicSharedMemorySize, LDS_BYTES);
        (void)hipOccupancyMaxActiveBlocksPerMultiprocessor(&per_cu, (const void*)fwd_kernel<0, 11>, NTHR, LDS_BYTES);
        grid = (per_cu >= 1 && cus >= NBLK) ? NBLK : -1;
        if (grid < 0) fprintf(stderr, "kernel_launch: needs %d co-resident workgroups (cus %d, per_cu %d)\n", NBLK, cus, per_cu);
    }
    if (grid < 0) return;
    (void)hipMemsetAsync((char*)d_ws + WS_CTL, 0, 16384, stream);
    void* kargs[] = {(void*)&a};
#if PLAIN_LAUNCH
    (void)kargs;
    for (int p = 0; p < 11; p += PH_PER_LAUNCH) { a.ph_lo = p; a.ph_hi = (p + PH_PER_LAUNCH < 11) ? p + PH_PER_LAUNCH : 11;
        for (int rep = 0; rep < (((DBL_MASK >> p) & 1) ? 2 : 1); ++rep) hipLaunchKernelGGL((fwd_kernel<0, 11>), dim3(NBLK), dim3(NTHR), LDS_BYTES, stream, a);
#if EXP_VAR
        if (p == 3) { static bool at = false; if (!at) { (void)hipFuncSetAttribute((const void*)exp_scan_kernel<EXP_VAR>, hipFuncAttributeMaxDynamicSharedMemorySize, LDS_BYTES); at = true; }
            hipLaunchKernelGGL((exp_scan_kernel<EXP_VAR>), dim3(NBLK), dim3(NTHR), LDS_BYTES, stream, a); }
#endif
    }
#else
    a.ph_lo = 0; a.ph_hi = 11;
    hipError_t e = hipLaunchCooperativeKernel((const void*)fwd_kernel<0, 11>, dim3(NBLK), dim3(NTHR), kargs, LDS_BYTES, stream);
    if (e != hipSuccess) fprintf(stderr, "cooperative launch failed: %s\n", hipGetErrorString(e));
#endif
#else
    launch_phase<0>(a, stream); launch_phase<1>(a, stream); launch_phase<2>(a, stream); launch_phase<3>(a, stream); launch_phase<4>(a, stream); launch_phase<5>(a, stream);
    launch_phase<6>(a, stream); launch_phase<7>(a, stream); launch_phase<8>(a, stream); launch_phase<9>(a, stream); launch_phase<10>(a, stream);
#endif
}
#ifdef TEST_LO
template __global__ void fwd_kernel<TEST_LO, TEST_HI>(Args);
#endif
```

```cpp
#include <hip/hip_runtime.h>
#include <hip/hip_cooperative_groups.h>
#include <cstdio>
#include <cstdint>

#define LAS __attribute__((address_space(3)))
#define GAS __attribute__((address_space(1)))
typedef unsigned short bf16_t;
typedef short bf16x8 __attribute__((ext_vector_type(8)));
typedef float f32x4 __attribute__((ext_vector_type(4)));
typedef float f32x2 __attribute__((ext_vector_type(2)));
typedef unsigned u32x4 __attribute__((ext_vector_type(4)));
typedef unsigned u32x2 __attribute__((ext_vector_type(2)));
typedef int i32x4 __attribute__((ext_vector_type(4)));
typedef int i32x8 __attribute__((ext_vector_type(8)));

constexpr int NB = 8, T = 2048, D = 1024, MTOK = NB * T;
constexpr int INC = 2576, NPROJ = 2560;
constexpr int NH = 4, HD = 128, NCH = T / 64;
constexpr int NE = 16, CAP = 256, FF = 2048;
constexpr float EPS = 1e-6f;
constexpr int NBLK = 256, NTHR = 512, NWAVE = 8;
constexpr int LDS_BYTES = 155648;

constexpr size_t MiB = (size_t)1 << 20;
constexpr size_t WS_CTL = 0;
constexpr size_t WS_WIN = 1 * MiB;
constexpr size_t WS_WMIX = 6 * MiB;
constexpr size_t WS_PREP = 8 * MiB;
constexpr size_t WS_WGU = 8 * MiB;
constexpr size_t WS_WD = 136 * MiB;
constexpr size_t WS_XN = 200 * MiB;
constexpr size_t WS_AMIX = 232 * MiB;
constexpr size_t WS_Y = 200 * MiB;
constexpr size_t WS_GATES = 264 * MiB;
constexpr size_t WS_PROBS = 265 * MiB;
constexpr size_t WS_INV = 266 * MiB;
constexpr size_t WS_SELI = 267 * MiB;
constexpr size_t WS_SELG = 267 * MiB + 131072;
constexpr size_t WS_EGL = 267 * MiB + 262144;
constexpr size_t WS_PROJ = 268 * MiB;
constexpr size_t WS_XG = 268 * MiB;
constexpr size_t WS_OD = 348 * MiB;
constexpr size_t WS_HB = 268 * MiB;
constexpr size_t WS_HMID = 332 * MiB;
constexpr size_t WS_WDA = 460 * MiB;
constexpr int NEARLY = 5;
constexpr size_t WS_END = 480 * MiB;
constexpr size_t PREP_STRIDE = 98304;

struct Args { const float* in[18]; float* out; unsigned char* ws; int ph_lo, ph_hi; };

typedef __bf16 bf16v2_t __attribute__((ext_vector_type(2)));
__device__ __forceinline__ unsigned cvt_pk_bf16_asm(float lo, float hi) { unsigned r; asm volatile("v_cvt_pk_bf16_f32 %0, %1, %2" : "=v"(r) : "v"(lo), "v"(hi)); return r; }
__device__ __forceinline__ unsigned cvt_pk_bf16(float lo, float hi) { f32x2 f = {lo, hi}; return __builtin_bit_cast(unsigned, __builtin_convertvector(f, bf16v2_t)); }
constexpr float F8_ACT = 16.f, F8_WGT = 512.f;
constexpr float F8_DESCALE = 1.f / (F8_ACT * F8_WGT);
__device__ __forceinline__ void mfma_f8_acc(f32x4& c, const i32x8 a, const i32x8 b) { asm volatile("v_mfma_f32_16x16x128_f8f6f4 %0, %1, %2, %0" : "+v"(c) : "v"(a), "v"(b)); }
__device__ __forceinline__ float f8clamp(float v) { return __builtin_amdgcn_fmed3f(v, -448.f, 448.f); }
__device__ __forceinline__ unsigned pk4_fp8(float a, float b, float c, float d) { int w = 0; w = __builtin_amdgcn_cvt_pk_fp8_f32(f8clamp(a), f8clamp(b), w, false); w = __builtin_amdgcn_cvt_pk_fp8_f32(f8clamp(c), f8clamp(d), w, true); return (unsigned)w; }
__device__ __forceinline__ float bf2f(unsigned h) { return __uint_as_float(h << 16); }
__device__ __forceinline__ float bflo(unsigned w) { return __uint_as_float(w << 16); }
__device__ __forceinline__ float bfhi(unsigned w) { return __uint_as_float(w & 0xffff0000u); }
__device__ __forceinline__ float wave_sum(float v) {
#pragma unroll
    for (int o = 1; o < 64; o <<= 1) v += __shfl_xor(v, o);
    return v;
}
__device__ __forceinline__ int tid_fresh() { int t = threadIdx.x; asm volatile("" : "+v"(t)); return t; }
__device__ __forceinline__ float silu_f(float x) { return x * __builtin_amdgcn_rcpf(1.f + __expf(-x)); }
__device__ __forceinline__ float sigmoid_f(float x) { return __builtin_amdgcn_rcpf(1.f + __expf(-x)); }
__device__ __forceinline__ float softplus_f(float x) { return fmaxf(x, 0.f) + log1pf(__expf(-fabsf(x))); }

namespace pg8 {
constexpr int BM = 256, BK = 64, HALF = 128, HTB = HALF * BK * 2, STAGE_BYTES = 8 * HTB, NXCD = 8, WGM = 8;
__host__ __device__ __forceinline__ int lds_byte(int r, int c) { const int st = (r >> 4) * 2 + (c >> 5), rr = r & 15, cc = c & 31, ob = rr * 64 + cc * 2; return st * 1024 + (ob ^ (((ob >> 9) & 1) << 5)); }
__host__ __device__ __forceinline__ void stage_rc(int b, int& R, int& C) { const int st = b / 1024, sb = b % 1024, swz = sb ^ (((sb >> 9) & 1) << 5); R = (st >> 1) * 16 + swz / 64; C = (st & 1) * 32 + (swz % 64) / 2; }
__host__ __device__ __forceinline__ int perm32(int rho) { const int n = rho >> 4, i = rho & 15; return 8 * (i >> 2) + 4 * n + (i & 3); }

struct Unit { int pm, pn; };
struct Gemm { const bf16_t* A; const bf16_t* Bt; int K; const int* gidx; };

struct StaticOrder {
    int nM, nN, nwg, G, c;
    __device__ void init(int M, int N, int G_, int c_) { nM = M / BM; nN = N / BM; nwg = nM * nN; G = G_; c = c_; }
    __device__ int pm_of(int) const { return 0; }
    __device__ bool next(int i, Unit& u) const {
        const long L = (long)i * G + c; if (L >= nwg) return false;
        int wgid = (int)L; { const int q = nwg / NXCD, r = nwg % NXCD, xcd = wgid % NXCD, off = wgid / NXCD; wgid = (xcd < r ? xcd * (q + 1) : r * (q + 1) + (xcd - r) * q) + off; }
        const int nig = WGM * nN, gid = wgid / nig, fm = gid * WGM, gsz = (nM - fm) < WGM ? (nM - fm) : WGM;
        u.pm = fm + ((wgid % nig) % gsz); u.pn = (wgid % nig) / gsz; return true;
    }
};
struct ExpertOrder {
    int x, b, pnq, ntile, rounds, rpe, early, eshift;
    __device__ void init(int c, int ntile_, int early_ = 0, int eshift_ = 0) { x = c & 7; const int j = c >> 3; b = j & 7; pnq = j >> 3; ntile = ntile_; rpe = ntile_ >> 2; rounds = 2 * rpe; early = early_; eshift = eshift_; }
    __device__ bool next(int i, Unit& u) const { if (i >= rounds) return false; const int e = 2 * x + (i / rpe); u.pm = b * NE + e; u.pn = e * ntile + 4 * (i % rpe) + pnq + (e < early ? eshift : 0); return true; }
    __device__ int pm_of(int k) const { return b * NE + 2 * x + k; }
};

template <class Epi, class Sched, bool GATHER = false, bool F8 = false>
__device__ __forceinline__ void gemm_phase(LAS unsigned char* lds, const Gemm g, const Sched& S, const Epi& E) {
    const int tid = tid_fresh(), wid = __builtin_amdgcn_readfirstlane(tid >> 6), lane = tid & 63, wr = wid >> 2, wc = wid & 3, fr = lane & 15, fq = lane >> 4;
    const int K = g.K, nt = K / BK;
    unsigned voffA[2], voffB[2];
#pragma unroll
    for (int i = 0; i < 2; ++i) { int R, C; stage_rc(tid * 16 + i * 8192, R, C); const int Rb = Epi::PERM ? ((R & ~31) + perm32(R & 31)) : R;
        voffA[i] = (unsigned)(R * K + C) * 2u; voffB[i] = (unsigned)(Rb * K + C) * 2u; }
    const size_t kstep = (size_t)(BK * 2);
    const size_t hstep = (size_t)HALF * K * 2;
    const size_t tstep = 2 * hstep;
    const size_t tstepA = GATHER ? 0 : tstep;
    unsigned tab[2][2][2];
    const int pmB = S.pm_of(1);
    if constexpr (GATHER) {
#pragma unroll
        for (int ei = 0; ei < 2; ++ei)
#pragma unroll
            for (int hf = 0; hf < 2; ++hf)
#pragma unroll
                for (int i = 0; i < 2; ++i) { int R, C; stage_rc(tid * 16 + i * 8192, R, C); tab[ei][hf][i] = (unsigned)(g.gidx[S.pm_of(ei) * BM + hf * HALF + R] * K + C) * 2u; }
    }
#define PG8_STAGE_A(bufoff, gbase, hf, ei) do { if constexpr (GATHER) { unsigned v_[2]; v_[0] = (ei) ? tab[1][hf][0] : tab[0][hf][0]; v_[1] = (ei) ? tab[1][hf][1] : tab[0][hf][1]; PG8_STAGE(bufoff, gbase, v_); } \
        else { PG8_STAGE(bufoff, (gbase) + (hf) * hstep, voffA); } } while (0)
    const unsigned ldsw = (unsigned)wid * 1024u;
    const int aoff = lds_byte(wr * 64 + fr, fq * 8), boff = lds_byte(wc * 32 + fr, fq * 8);
#define PG8_SA(b, h) (((b) * 2 + (h)) * HTB)
#define PG8_SB(b, h) ((4 + (b) * 2 + (h)) * HTB)
#define PG8_STAGE(bufoff, gbase, voff) do { _Pragma("unroll") for (int _i = 0; _i < 2; ++_i) \
        __builtin_amdgcn_global_load_lds((const unsigned*)((const char*)(gbase) + (voff)[_i]), (LAS unsigned*)(lds + (bufoff) + ldsw + _i * 8192), 16, 0, 0); } while (0)
#define PG8_LDA(dst, b, h) do { _Pragma("unroll") for (int m = 0; m < 4; ++m) _Pragma("unroll") for (int k = 0; k < 2; ++k) dst[m][k] = *(const LAS bf16x8*)(lds + PG8_SA(b, h) + aoff + m * 2048 + k * 1024); } while (0)
#define PG8_LDB(dst, b, h) do { _Pragma("unroll") for (int n = 0; n < 2; ++n) _Pragma("unroll") for (int k = 0; k < 2; ++k) dst[n][k] = *(const LAS bf16x8*)(lds + PG8_SB(b, h) + boff + n * 2048 + k * 1024); } while (0)
#define PG8_CAT(x) __builtin_shufflevector(__builtin_bit_cast(i32x4, (x)[0]), __builtin_bit_cast(i32x4, (x)[1]), 0, 1, 2, 3, 4, 5, 6, 7)
#define PG8_MMA(ai, bj, At, Bt) do { __builtin_amdgcn_s_setprio(1); _Pragma("unroll") for (int m = 0; m < 4; ++m) _Pragma("unroll") for (int n = 0; n < 2; ++n) { \
        if constexpr (F8) mfma_f8_acc(acc[ai][bj][m][n], PG8_CAT(Bt[n]), PG8_CAT(At[m])); \
        else { _Pragma("unroll") for (int k = 0; k < 2; ++k) acc[ai][bj][m][n] = __builtin_amdgcn_mfma_f32_16x16x32_bf16(Bt[n][k], At[m][k], acc[ai][bj][m][n], 0, 0, 0); } } \
        __builtin_amdgcn_s_setprio(0); } while (0)
#define PG8_WAIT_V(n) asm volatile("s_waitcnt vmcnt(" #n ")" ::: "memory")
#define PG8_WAIT_L(n) asm volatile("s_waitcnt lgkmcnt(" #n ")" ::: "memory")
#define PG8_BAR __builtin_amdgcn_s_barrier()
#define PG8_SCHED __builtin_amdgcn_sched_barrier(0)
    Unit cur, nxt; int ui = 0;
    if (!S.next(0, cur)) return;
    f32x4 acc[2][2][4][2];
#pragma unroll
    for (int a = 0; a < 2; ++a)
#pragma unroll
        for (int b = 0; b < 2; ++b)
#pragma unroll
            for (int m = 0; m < 4; ++m)
#pragma unroll
                for (int n = 0; n < 2; ++n) acc[a][b][m][n] = (f32x4){0.f, 0.f, 0.f, 0.f};
    bf16x8 At[4][2], B0[2][2], B1[2][2];
    const char* cA = (const char*)g.A + (size_t)cur.pm * tstepA; const char* cB = (const char*)g.Bt + (size_t)cur.pn * tstep;
    bool cur_ei = GATHER && cur.pm == pmB, nxt_ei = cur_ei;
    PG8_STAGE(PG8_SB(0, 0), cB, voffB); PG8_STAGE(PG8_SB(0, 1), cB + hstep, voffB); PG8_STAGE_A(PG8_SA(0, 0), cA, 0, cur_ei); PG8_STAGE_A(PG8_SA(0, 1), cA, 1, cur_ei);
    if (wr == 1) PG8_BAR;
    PG8_WAIT_V(2); PG8_BAR;
    PG8_STAGE(PG8_SB(1, 0), cB + kstep, voffB); PG8_STAGE_A(PG8_SA(1, 0), cA + kstep, 0, cur_ei); PG8_STAGE(PG8_SB(1, 1), cB + hstep + kstep, voffB);
    PG8_WAIT_V(6); PG8_BAR;
    for (;;) {
        const bool has_next = S.next(ui + 1, nxt);
        const char* nA = has_next ? (const char*)g.A + (size_t)nxt.pm * tstepA : cA; const char* nB = has_next ? (const char*)g.Bt + (size_t)nxt.pn * tstep : cB;
        nxt_ei = has_next ? (GATHER && nxt.pm == pmB) : cur_ei;
        for (int t = 0; t < nt; t += 2) {
            const bool last = (t == nt - 2);
            const char* a1 = cA + (size_t)(t + 1) * kstep;
            const char* a2 = last ? nA : cA + (size_t)(t + 2) * kstep; const char* b2 = last ? nB : cB + (size_t)(t + 2) * kstep;
            const char* a3 = a2 + kstep; const char* b3 = b2 + kstep;
            const bool e2 = last ? nxt_ei : cur_ei;
            PG8_LDB(B0, 0, 0); PG8_LDB(B1, 0, 1); PG8_SCHED; PG8_LDA(At, 0, 0); PG8_STAGE_A(PG8_SA(1, 1), a1, 1, cur_ei);
            PG8_WAIT_V(8); PG8_WAIT_L(0); PG8_BAR; PG8_MMA(0, 0, At, B0); PG8_MMA(0, 1, At, B1); PG8_BAR; PG8_SCHED;
            PG8_LDA(At, 0, 1); PG8_STAGE(PG8_SB(0, 0), b2, voffB); PG8_STAGE(PG8_SB(0, 1), b2 + hstep, voffB); PG8_STAGE_A(PG8_SA(0, 0), a2, 0, e2);
            PG8_WAIT_V(8); PG8_WAIT_L(0); PG8_BAR; PG8_MMA(1, 0, At, B0); PG8_MMA(1, 1, At, B1); PG8_BAR; PG8_SCHED;
            PG8_LDB(B0, 1, 0); PG8_LDB(B1, 1, 1); PG8_SCHED; PG8_LDA(At, 1, 0); PG8_STAGE_A(PG8_SA(0, 1), a2, 1, e2);
            PG8_WAIT_V(8); PG8_WAIT_L(0); PG8_BAR; PG8_MMA(0, 0, At, B0); PG8_MMA(0, 1, At, B1); PG8_BAR; PG8_SCHED;
            PG8_LDA(At, 1, 1); PG8_STAGE(PG8_SB(1, 0), b3, voffB); PG8_STAGE(PG8_SB(1, 1), b3 + hstep, voffB); PG8_STAGE_A(PG8_SA(1, 0), a3, 0, e2);
            PG8_WAIT_V(8); PG8_WAIT_L(0); PG8_BAR; PG8_MMA(1, 0, At, B0); PG8_MMA(1, 1, At, B1); PG8_BAR; PG8_SCHED;
        }
        if (wr == 0) PG8_BAR;
        if constexpr (F8) { asm volatile("s_nop 15\n\ts_nop 15" ::: "memory");
#pragma unroll
            for (int a = 0; a < 2; ++a)
#pragma unroll
                for (int b = 0; b < 2; ++b)
#pragma unroll
                    for (int m = 0; m < 4; ++m)
#pragma unroll
                        for (int n = 0; n < 2; ++n) asm volatile("" : "+v"(acc[a][b][m][n])); }
        E(acc, cur, wr, wc, fr, fq);
        if (!has_next) break;
#pragma unroll
        for (int a = 0; a < 2; ++a)
#pragma unroll
            for (int b = 0; b < 2; ++b)
#pragma unroll
                for (int m = 0; m < 4; ++m)
#pragma unroll
                    for (int n = 0; n < 2; ++n) acc[a][b][m][n] = (f32x4){0.f, 0.f, 0.f, 0.f};
        cur = nxt; cA = nA; cB = nB; cur_ei = nxt_ei; ++ui;
        if (wr == 1) PG8_BAR;
    }
    PG8_WAIT_V(0);
    PG8_BAR;
#undef PG8_SA
#undef PG8_SB
#undef PG8_STAGE
#undef PG8_STAGE_A
#undef PG8_LDA
#undef PG8_LDB
#undef PG8_MMA
#undef PG8_CAT
#undef PG8_WAIT_V
#undef PG8_WAIT_L
#undef PG8_BAR
#undef PG8_SCHED
}
struct EpiProj {
    static constexpr bool PERM = true;
    bf16_t* O; int ldc;
    __device__ __forceinline__ void operator()(const f32x4 (&acc)[2][2][4][2], const Unit& u, int wr, int wc, int fr, int fq) const {
        const int row0 = u.pm * BM + wr * 64 + fr, col0 = u.pn * BM + wc * 32 + 8 * fq;
#pragma unroll
        for (int ai = 0; ai < 2; ++ai)
#pragma unroll
            for (int m = 0; m < 4; ++m) { bf16_t* rowp = O + (size_t)(row0 + ai * HALF + m * 16) * ldc + col0;
#pragma unroll
                for (int bj = 0; bj < 2; ++bj) { const f32x4 v0 = acc[ai][bj][m][0], v1 = acc[ai][bj][m][1];
                    u32x4 w; w.x = cvt_pk_bf16_asm(v0[0], v0[1]); w.y = cvt_pk_bf16_asm(v0[2], v0[3]); w.z = cvt_pk_bf16_asm(v1[0], v1[1]); w.w = cvt_pk_bf16_asm(v1[2], v1[3]);
                    *(u32x4*)(rowp + bj * HALF) = w; } }
    }
};
struct EpiResid {
    static constexpr bool PERM = true;
    const float* base; bf16_t* C; int ldc;
    __device__ __forceinline__ void operator()(const f32x4 (&acc)[2][2][4][2], const Unit& u, int wr, int wc, int fr, int fq) const {
        const int row0 = u.pm * BM + wr * 64 + fr, col0 = u.pn * BM + wc * 32 + 8 * fq;
#pragma unroll
        for (int ai = 0; ai < 2; ++ai)
#pragma unroll
            for (int m = 0; m < 4; ++m) { const size_t off = (size_t)(row0 + ai * HALF + m * 16) * ldc + col0;
#pragma unroll
                for (int bj = 0; bj < 2; ++bj) { const f32x4 b0 = *(const f32x4*)(base + off + bj * HALF), b1 = *(const f32x4*)(base + off + bj * HALF + 4);
                    const f32x4 v0 = b0 + acc[ai][bj][m][0], v1 = b1 + acc[ai][bj][m][1];
                    u32x4 w; w.x = cvt_pk_bf16_asm(v0[0], v0[1]); w.y = cvt_pk_bf16_asm(v0[2], v0[3]); w.z = cvt_pk_bf16_asm(v1[0], v1[1]); w.w = cvt_pk_bf16_asm(v1[2], v1[3]);
                    *(u32x4*)(C + off + bj * HALF) = w; }
                asm volatile("" ::: "memory"); }
    }
};
struct EpiSwiglu {
    static constexpr bool PERM = true;
    unsigned char* O;
    __device__ __forceinline__ void operator()(const f32x4 (&acc)[2][2][4][2], const Unit& u, int wr, int wc, int fr, int fq) const {
        const int row0 = u.pm * BM + wr * 64 + fr, col0 = (u.pn & 15) * HALF + wc * 32 + 8 * fq;
#pragma unroll
        for (int ai = 0; ai < 2; ++ai)
#pragma unroll
            for (int m = 0; m < 4; ++m) { unsigned char* rowp = O + (size_t)(row0 + ai * HALF + m * 16) * FF + col0;
                float h[8];
#pragma unroll
                for (int n = 0; n < 2; ++n)
#pragma unroll
                    for (int j = 0; j < 4; ++j) { const float gt = acc[ai][0][m][n][j], up = acc[ai][1][m][n][j]; h[4 * n + j] = silu_f(gt * F8_DESCALE) * (up * (F8_DESCALE * F8_ACT)); }
                u32x2 w; w.x = pk4_fp8(h[0], h[1], h[2], h[3]); w.y = pk4_fp8(h[4], h[5], h[6], h[7]);
                *(u32x2*)rowp = w; }
    }
};
struct EpiDown {
    static constexpr bool PERM = true;
    bf16_t* O;
    __device__ __forceinline__ void operator()(const f32x4 (&acc)[2][2][4][2], const Unit& u, int wr, int wc, int fr, int fq) const {
        const int row0 = u.pm * BM + wr * 64 + fr, col0 = (u.pn & 3) * BM + wc * 32 + 8 * fq;
#pragma unroll
        for (int ai = 0; ai < 2; ++ai)
#pragma unroll
            for (int m = 0; m < 4; ++m) { bf16_t* rowp = O + (size_t)(row0 + ai * HALF + m * 16) * D + col0;
#pragma unroll
                for (int bj = 0; bj < 2; ++bj) { const f32x4 v0 = acc[ai][bj][m][0] * F8_DESCALE, v1 = acc[ai][bj][m][1] * F8_DESCALE;
                    u32x4 w; w.x = cvt_pk_bf16_asm(v0[0], v0[1]); w.y = cvt_pk_bf16_asm(v0[2], v0[3]); w.z = cvt_pk_bf16_asm(v1[0], v1[1]); w.w = cvt_pk_bf16_asm(v1[2], v1[3]);
                    *(u32x4*)(rowp + bj * HALF) = w; } }
    }
};
}

__device__ __forceinline__ void transpose_item(const float* W, int ld, int k0, int n0, bf16_t* WT, size_t dst_row0, int ldt, LAS float* scr, int lane) {
#pragma unroll 8
    for (int i = 0; i < 32; ++i) { const int kk = 2 * i + (lane >> 5); scr[kk * 33 + (lane & 31)] = W[(size_t)(k0 + kk) * ld + n0 + (lane & 31)]; }
    asm volatile("s_waitcnt lgkmcnt(0)" ::: "memory");
    const int c = lane & 7;
#pragma unroll
    for (int j = 0; j < 4; ++j) { const int n = (lane >> 3) + 8 * j; const LAS float* s = scr + (8 * c) * 33 + n;
        u32x4 o; o.x = cvt_pk_bf16(s[0 * 33], s[1 * 33]); o.y = cvt_pk_bf16(s[2 * 33], s[3 * 33]); o.z = cvt_pk_bf16(s[4 * 33], s[5 * 33]); o.w = cvt_pk_bf16(s[6 * 33], s[7 * 33]);
        *(u32x4*)(WT + (dst_row0 + n) * (size_t)ldt + k0 + 8 * c) = o; }
    asm volatile("s_waitcnt lgkmcnt(0)" ::: "memory");
}

__device__ __forceinline__ void transpose_item8(const float* W, int ld, int k0, int n0, unsigned char* WT, size_t dst_row0, int ldt, LAS float* scr, int lane) {
#pragma unroll 8
    for (int i = 0; i < 32; ++i) { const int kk = 2 * i + (lane >> 5); scr[kk * 33 + (lane & 31)] = W[(size_t)(k0 + kk) * ld + n0 + (lane & 31)]; }
    asm volatile("s_waitcnt lgkmcnt(0)" ::: "memory");
    const int c = lane & 3;
#pragma unroll
    for (int j = 0; j < 2; ++j) { const int n = (lane >> 2) + 16 * j; const LAS float* s = scr + (16 * c) * 33 + n;
        u32x4 o;
        o.x = pk4_fp8(s[0 * 33] * F8_WGT, s[1 * 33] * F8_WGT, s[2 * 33] * F8_WGT, s[3 * 33] * F8_WGT); o.y = pk4_fp8(s[4 * 33] * F8_WGT, s[5 * 33] * F8_WGT, s[6 * 33] * F8_WGT, s[7 * 33] * F8_WGT);
        o.z = pk4_fp8(s[8 * 33] * F8_WGT, s[9 * 33] * F8_WGT, s[10 * 33] * F8_WGT, s[11 * 33] * F8_WGT); o.w = pk4_fp8(s[12 * 33] * F8_WGT, s[13 * 33] * F8_WGT, s[14 * 33] * F8_WGT, s[15 * 33] * F8_WGT);
        *(u32x4*)(WT + (dst_row0 + n) * (size_t)ldt + k0 + 16 * c) = o; }
    asm volatile("s_waitcnt lgkmcnt(0)" ::: "memory");
}

#define MFMA16(A, B, C) __builtin_amdgcn_mfma_f32_16x16x32_bf16(A, B, C, 0, 0, 0)
template <int MODE>
__device__ __forceinline__ void row_pass(const Args& a, LAS unsigned char* lds) {
    const int tid = tid_fresh(), lane = tid & 63, wave = __builtin_amdgcn_readfirstlane(tid >> 6), l15 = lane & 15, l4 = lane >> 4;
    const float* src = a.in[0]; const bf16_t* srcb = (const bf16_t*)(a.ws + WS_HB);
    const float* nw = MODE == 0 ? a.in[1] : a.in[12];
    const float* wsm = MODE == 0 ? a.in[2] + 2048 : a.in[13];
    const int ld = MODE == 0 ? INC : NE;
    bf16_t* dst = (bf16_t*)(a.ws + WS_XN);
    float* aux = (float*)(a.ws + (MODE == 0 ? WS_GATES : WS_PROBS));
    LAS unsigned char* XH = lds; LAS unsigned char* XL = lds + 32768; LAS float* PART = (LAS float*)(lds + 65536);
    bf16x8 wh[4], wl[4];
#pragma unroll
    for (int ks = 0; ks < 4; ++ks) { float f[8];
#pragma unroll
        for (int j = 0; j < 8; ++j) f[j] = wsm[(size_t)(128 * wave + 32 * ks + 8 * l4 + j) * ld + l15];
        unsigned hw[4], lw[4];
#pragma unroll
        for (int j = 0; j < 4; ++j) { hw[j] = cvt_pk_bf16(f[2 * j], f[2 * j + 1]); lw[j] = cvt_pk_bf16(f[2 * j] - bflo(hw[j]), f[2 * j + 1] - bfhi(hw[j])); }
        u32x4 hv = (u32x4){hw[0], hw[1], hw[2], hw[3]}, lv = (u32x4){lw[0], lw[1], lw[2], lw[3]};
        wh[ks] = __builtin_bit_cast(bf16x8, hv); wl[ks] = __builtin_bit_cast(bf16x8, lv); }
    const f32x4* nw4 = (const f32x4*)nw + lane;
    f32x4 w4[4];
#pragma unroll
    for (int j = 0; j < 4; ++j) w4[j] = nw4[64 * j];
    const int ec = tid & 15;
    float alog = 0.f, dtb = 0.f;
    if (MODE == 0) { const int h = ec & 3; if (ec < 4) { alog = a.in[4][h]; dtb = a.in[5][h]; } else if (ec >= 8 && ec < 12) { alog = a.in[6][h]; dtb = a.in[7][h]; } }
    constexpr int NGRP = MTOK / 16;
    f32x4 vn[2][4];
    if ((int)blockIdx.x < NGRP) {
#pragma unroll
        for (int q = 0; q < 2; ++q) { const size_t r_ = (size_t)(16 * blockIdx.x + 2 * wave + q);
#pragma unroll
            for (int j = 0; j < 4; ++j) { if (MODE == 0) vn[q][j] = ((const f32x4*)(src + r_ * D) + lane)[64 * j];
                else { const u32x2 w_ = ((const u32x2*)(srcb + r_ * D) + lane)[64 * j]; vn[q][j] = (f32x4){bflo(w_.x), bfhi(w_.x), bflo(w_.y), bfhi(w_.y)}; } } } }
    for (int grp = blockIdx.x; grp < NGRP; grp += gridDim.x) {
        f32x4 v[2][4];
#pragma unroll
        for (int q = 0; q < 2; ++q)
#pragma unroll
            for (int j = 0; j < 4; ++j) v[q][j] = vn[q][j];
        if (grp + (int)gridDim.x < NGRP) {
#pragma unroll
            for (int q = 0; q < 2; ++q) { const size_t r_ = (size_t)(16 * (grp + gridDim.x) + 2 * wave + q);
#pragma unroll
                for (int j = 0; j < 4; ++j) { if (MODE == 0) vn[q][j] = ((const f32x4*)(src + r_ * D) + lane)[64 * j];
                    else { const u32x2 w_ = ((const u32x2*)(srcb + r_ * D) + lane)[64 * j]; vn[q][j] = (f32x4){bflo(w_.x), bfhi(w_.x), bflo(w_.y), bfhi(w_.y)}; } } } }
#pragma unroll
        for (int q = 0; q < 2; ++q) { const int lr = 2 * wave + q, row = 16 * grp + lr; float ss = 0.f;
#pragma unroll
            for (int j = 0; j < 4; ++j) ss += (v[q][j].x * v[q][j].x + v[q][j].y * v[q][j].y) + (v[q][j].z * v[q][j].z + v[q][j].w * v[q][j].w);
            const float r = rsqrtf(wave_sum(ss) * (1.f / D) + EPS);
            u32x2* o8 = (u32x2*)(dst + (size_t)row * D) + lane;
#pragma unroll
            for (int j = 0; j < 4; ++j) { const f32x4 y = v[q][j] * r * w4[j]; u32x2 hw, lw; hw.x = cvt_pk_bf16(y.x, y.y); hw.y = cvt_pk_bf16(y.z, y.w);
                lw.x = cvt_pk_bf16(y.x - bflo(hw.x), y.y - bfhi(hw.x)); lw.y = cvt_pk_bf16(y.z - bflo(hw.y), y.w - bfhi(hw.y));
                if (MODE == 0) o8[64 * j] = hw; else ((unsigned*)((unsigned char*)dst + (size_t)row * D) + lane)[64 * j] = pk4_fp8(y.x * F8_ACT, y.y * F8_ACT, y.z * F8_ACT, y.w * F8_ACT);
                const int off = lr * 2048 + ((((lane >> 1) + 32 * j) ^ lr) << 4) + 8 * (lane & 1);
                *(LAS u32x2*)(XH + off) = hw; *(LAS u32x2*)(XL + off) = lw; } }
        __syncthreads();
        f32x4 acc = (f32x4){0.f, 0.f, 0.f, 0.f};
#pragma unroll
        for (int ks = 0; ks < 4; ++ks) { const int off = l15 * 2048 + (((16 * wave + 4 * ks + l4) ^ l15) << 4);
            const bf16x8 xh = *(const LAS bf16x8*)(XH + off), xl = *(const LAS bf16x8*)(XL + off);
            acc = MFMA16(xh, wh[ks], acc); acc = MFMA16(xh, wl[ks], acc); acc = MFMA16(xl, wh[ks], acc); }
#pragma unroll
        for (int r4 = 0; r4 < 4; ++r4) PART[(wave * 16 + 4 * l4 + r4) * 16 + l15] = acc[r4];
        __syncthreads();
        if (tid < 256) { float s = 0.f;
#pragma unroll
            for (int w8 = 0; w8 < 8; ++w8) s += PART[w8 * 256 + tid];
            float res;
            if (MODE == 0) { if (ec < 4 || (ec >= 8 && ec < 12)) res = -__expf(alog) * softplus_f(s + dtb); else res = sigmoid_f(s); }
            else { float mx = s;
#pragma unroll
                for (int o = 1; o < 16; o <<= 1) mx = fmaxf(mx, __shfl_xor(mx, o));
                const float e = __expf(s - mx); float sm = e;
#pragma unroll
                for (int o = 1; o < 16; o <<= 1) sm += __shfl_xor(sm, o);
                res = e / sm; }
            aux[(size_t)(16 * grp) * 16 + tid] = res; }
        __syncthreads();
    }
}

__device__ __forceinline__ void ph_prologue(const Args& a, LAS unsigned char* lds) {
    const int tid = tid_fresh(), lane = tid & 63, wave = tid >> 6;
    LAS float* scr = (LAS float*)(lds + wave * 8704);
    const int gw = blockIdx.x * NWAVE + wave, NGW = gridDim.x * NWAVE;
    bf16_t* Win = (bf16_t*)(a.ws + WS_WIN); bf16_t* Wmix = (bf16_t*)(a.ws + WS_WMIX);
    constexpr int I_A = 16 * 64, I_B = 16 * 16, I_C = 8 * 32;
    for (int it = gw; it < I_A + I_B + I_C; it += NGW) {
        int r = it;
        if (r < I_A) { const int kb = r / 64, nb = r % 64; transpose_item(a.in[2], INC, 64 * kb, 32 * nb, Win, (size_t)32 * nb, D, scr, lane); continue; } r -= I_A;
        if (r < I_B) { const int kb = r / 16, nb = r % 16; transpose_item(a.in[2] + 2064, INC, 64 * kb, 32 * nb, Win, (size_t)2048 + 32 * nb, D, scr, lane); continue; } r -= I_B;
        { const int kb = r / 32, nb = r % 32; transpose_item(a.in[11], D, 64 * kb, 32 * nb, Wmix, (size_t)32 * nb, D, scr, lane); }
    }
    __syncthreads();
    for (int task = blockIdx.x; task < 256; task += gridDim.x) {
        const int g = task >> 6, n0 = (task & 63) * 16;
        LAS float* Wsc = (LAS float*)lds;
        LAS float* Pw = (LAS float*)(lds + 8192);
        for (int idx = tid; idx < 128 * 16; idx += NTHR) { const int d = idx >> 4, n = idx & 15; Wsc[idx] = a.in[11][(size_t)(512 + 128 * g + d) * D + n0 + n] * a.in[10][128 * g + d]; }
        for (int idx = tid; idx < 128 * 128; idx += NTHR) Pw[(idx >> 7) * 129 + (idx & 127)] = a.in[9][(size_t)g * 16384 + idx];
        __syncthreads();
        const int n = tid & 15, cq = tid >> 4;
        float accv[4] = {0.f, 0.f, 0.f, 0.f};
        for (int d = 0; d < 128; ++d) { const float w = Wsc[d * 16 + n];
#pragma unroll
            for (int j = 0; j < 4; ++j) accv[j] += Pw[(cq * 4 + j) * 129 + d] * w; }
        u32x2 o; o.x = cvt_pk_bf16(accv[0], accv[1]); o.y = cvt_pk_bf16(accv[2], accv[3]);
        *(u32x2*)(Wmix + (size_t)(n0 + n) * D + 512 + 128 * g + cq * 4) = o;
        __syncthreads();
    }
    __syncthreads();
    row_pass<0>(a, lds);
}

constexpr int CVT_ITEMS = NE * 3072, CVT_SPLIT = (CVT_ITEMS * 9 / 10) & ~2047;
template <bool EARLY>
__device__ __forceinline__ void expert_weight_cvt(const Args& a, LAS unsigned char* lds, int it_lo, int it_hi, int wg0, int nwg, int bid) {
    const int tid = tid_fresh(), lane = tid & 63, wave = tid >> 6;
    LAS float* scr = (LAS float*)(lds + wave * 8704);
    const int gw = (bid - wg0) * NWAVE + wave, NGW = nwg * NWAVE;
    unsigned char* Wgu = a.ws + WS_WGU; unsigned char* Wd = a.ws + WS_WD; unsigned char* WdA = a.ws + WS_WDA;
    if (bid < wg0 || bid >= wg0 + nwg) return;
    for (int it = it_lo + gw; it < it_hi; it += NGW) {
        if (EARLY) { const int e = it >> 10, q = it & 1023, kb = q >> 5, nb = q & 31;
            transpose_item8(a.in[16] + (size_t)e * FF * D, D, 64 * kb, 32 * nb, WdA, (size_t)e * 1024 + 32 * nb, FF, scr, lane); continue; }
        const int e = it / 3072, r = it % 3072, which = r >> 10, q = r & 1023;
        if (which < 2) { const int kb = q >> 6, nb = q & 63, f0 = 32 * nb;
            const float* W = (which == 0 ? a.in[14] : a.in[15]) + (size_t)e * D * FF;
            transpose_item8(W, FF, 64 * kb, f0, Wgu, (size_t)e * 4096 + (f0 >> 7) * 256 + which * 128 + (f0 & 127), D, scr, lane);
        } else if (e >= NEARLY) { const int kb = q >> 5, nb = q & 31;
            transpose_item8(a.in[16] + (size_t)e * FF * D, D, 64 * kb, 32 * nb, Wd, (size_t)e * 1024 + 32 * nb, FF, scr, lane); }
    }
}

__device__ __forceinline__ int a128(int row, int col) { return row * 256 + ((((col >> 3) ^ (row & 15))) << 4) + ((col & 7) << 1); }
__device__ __forceinline__ int a64(int row, int col) { return row * 128 + ((((col >> 3) ^ ((row >> 1) & 7))) << 4) + ((col & 7) << 1); }
__device__ __forceinline__ bf16x8 frag128(LAS unsigned char* base, int row0, int k0, int lane) { return *(const LAS bf16x8*)(base + a128(row0 + (lane & 15), k0 + ((lane >> 4) << 3))); }
__device__ __forceinline__ bf16x8 frag64(LAS unsigned char* base, int row0, int k0, int lane) { return *(const LAS bf16x8*)(base + a64(row0 + (lane & 15), k0 + ((lane >> 4) << 3))); }
__device__ __forceinline__ u32x2 pack4(f32x4 v) { u32x2 w; w.x = cvt_pk_bf16(v[0], v[1]); w.y = cvt_pk_bf16(v[2], v[3]); return w; }

template <bool FRAG>
__device__ __forceinline__ void staged_store_16x64(LAS unsigned char* stg, const f32x4 (&t)[4], unsigned char* gmat, int tile16, int half, int lane) {
    const int l15 = lane & 15, l4 = lane >> 4;
#pragma unroll
    for (int k = 0; k < 4; ++k) *(LAS u32x2*)(stg + l15 * 128 + (((2 * k + (l4 >> 1)) ^ (l15 & 7)) << 4) + 8 * (l4 & 1)) = pack4(t[k]);
#pragma unroll
    for (int q = 0; q < 2; ++q) { const int idx = lane + 64 * q, row = idx >> 3, c = idx & 7;
        const u32x4 v = *(const LAS u32x4*)(stg + row * 128 + ((c ^ (row & 7)) << 4));
        const size_t off = FRAG ? (size_t)(tile16 * 4 + 2 * half + (c >> 2)) * 1024 + row * 64 + (c & 3) * 16
                                : (size_t)(tile16 * 8 + 4 * half + (c >> 1)) * 512 + row * 32 + (c & 1) * 16;
        *(u32x4*)(gmat + off) = v; }
}
constexpr int L_QM = 0, L_KM = 16384, L_KT = 32768, L_VT = 49152, L_WT = 114688, L_UT = 131072, L_SM = 147456;
#define L_PD(d)  (65536 + (d) * 24576)
#define L_PTD(d) (65536 + (d) * 24576 + 8192)
#define L_PQD(d) (65536 + (d) * 24576 + 16384)
#define L_TD(d)  (114688 + (d) * 8192)
__device__ __forceinline__ void ph_chunk_prep(const Args& a, LAS unsigned char* lds) {
    const int tid0 = tid_fresh(), wave = __builtin_amdgcn_readfirstlane(tid0 >> 6);
    const bf16_t* proj = (const bf16_t*)(a.ws + WS_PROJ);
    const float* gates = (const float*)(a.ws + WS_GATES);
    float* eglp = (float*)(a.ws + WS_EGL);
    LAS float* sm = (LAS float*)(lds + L_SM);
    const int tn = wave & 3, tm0 = 2 * (wave >> 2);
#define SEG_LANE() int tid = tid0; asm volatile("" : "+v"(tid)); const int lane = tid & 63, l15 = lane & 15, l4 = lane >> 4, ra = 16 * tn + l15; (void)l4; (void)ra; (void)lane
    u32x4 raw[3][6]; float graw[4];
#define PREP_FETCH(task_) do { const int n_ = (task_) & 31, h_ = ((task_) >> 5) & 3, b_ = (task_) >> 7; int tidf = tid0; asm volatile("" : "+v"(tidf)); \
        const int cch_ = tidf & 15, i0_ = 2 * (tidf >> 4); \
        _Pragma("unroll") for (int mtx = 0; mtx < 3; ++mtx) _Pragma("unroll") for (int jj = 0; jj < 6; ++jj) { const int tl_ = n_ * 64 + i0_ - 2 + jj; \
            raw[mtx][jj] = (u32x4){0u, 0u, 0u, 0u}; \
            if (tl_ >= 0 && tl_ < T) raw[mtx][jj] = *(const u32x4*)(proj + (size_t)(b_ * T + tl_) * NPROJ + mtx * 512 + h_ * HD + 8 * cch_); } \
        if (wave == 0) { const float* gp_ = gates + (size_t)(b_ * T + n_ * 64 + (tidf & 63)) * 16; graw[0] = gp_[h_]; graw[1] = gp_[4 + h_]; graw[2] = gp_[8 + h_]; graw[3] = gp_[12 + h_]; } } while (0)
    if ((int)blockIdx.x < NB * NH * NCH) PREP_FETCH((int)blockIdx.x);
    for (int task = blockIdx.x; task < NB * NH * NCH; task += gridDim.x) {
        const int n = task & 31, h = (task >> 5) & 3, b = task >> 7;
        { SEG_LANE();
        if (wave == 0) {
            const float gf = graw[0], bfv = graw[1], gb = graw[2], bbv = graw[3];
            float pf = gf, pb = gb;
#pragma unroll
            for (int o = 1; o < 64; o <<= 1) { const float tf = __shfl_up(pf, o), tb = __shfl_up(pb, o); if (lane >= o) { pf += tf; pb += tb; } }
            const float totb = __shfl(pb, 63);
            sm[lane] = pf; sm[64 + lane] = totb - pb + gb; sm[128 + lane] = bfv; sm[192 + lane] = bbv;
        }
        {
            const int cch = tid & 15, rp = tid >> 4, i0 = 2 * rp;
#pragma unroll
            for (int mtx = 0; mtx < 3; ++mtx) {
                const int colb = mtx * 512 + h * HD + 8 * cch;
                float in[6][8];
#pragma unroll
                for (int jj = 0; jj < 6; ++jj) { const u32x4 w = raw[mtx][jj];
                    in[jj][0] = bflo(w.x); in[jj][1] = bfhi(w.x); in[jj][2] = bflo(w.y); in[jj][3] = bfhi(w.y); in[jj][4] = bflo(w.z); in[jj][5] = bfhi(w.z); in[jj][6] = bflo(w.w); in[jj][7] = bfhi(w.w); }
                float val[2][8];
#pragma unroll
                for (int r = 0; r < 2; ++r)
#pragma unroll
                    for (int e = 0; e < 8; ++e) val[r][e] = 0.f;
#pragma unroll
                for (int j = 0; j < 5; ++j) { const f32x4 c0 = *(const f32x4*)(a.in[3] + (size_t)j * 1536 + colb), c1 = *(const f32x4*)(a.in[3] + (size_t)j * 1536 + colb + 4);
#pragma unroll
                    for (int r = 0; r < 2; ++r) {
#pragma unroll
                        for (int e = 0; e < 4; ++e) { val[r][e] += in[r + j][e] * c0[e]; val[r][4 + e] += in[r + j][4 + e] * c1[e]; } } }
#pragma unroll
                for (int r = 0; r < 2; ++r) { float ss = 0.f;
#pragma unroll
                    for (int e = 0; e < 8; ++e) { val[r][e] = silu_f(val[r][e]); ss += val[r][e] * val[r][e]; }
                    if (mtx < 2) { ss += __shfl_xor(ss, 1); ss += __shfl_xor(ss, 2); ss += __shfl_xor(ss, 4); ss += __shfl_xor(ss, 8);
                        const float sc = rsqrtf(ss + EPS) * (mtx == 0 ? 0.08838834764831845f : 1.f);
#pragma unroll
                        for (int e = 0; e < 8; ++e) val[r][e] *= sc; } }
                if (mtx < 2) {
#pragma unroll
                    for (int r = 0; r < 2; ++r) { u32x4 w; w.x = cvt_pk_bf16(val[r][0], val[r][1]); w.y = cvt_pk_bf16(val[r][2], val[r][3]); w.z = cvt_pk_bf16(val[r][4], val[r][5]); w.w = cvt_pk_bf16(val[r][6], val[r][7]);
                        *(LAS u32x4*)(lds + (mtx == 0 ? L_QM : L_KM) + a128(i0 + r, 8 * cch)) = w; } }
                if (mtx >= 1) {
#pragma unroll
                    for (int e = 0; e < 8; ++e) *(LAS unsigned*)(lds + (mtx == 1 ? L_KT : L_VT) + a64(8 * cch + e, i0)) = cvt_pk_bf16(val[0][e], val[1][e]); }
            }
        }
        }
        if (task + (int)gridDim.x < NB * NH * NCH) PREP_FETCH(task + (int)gridDim.x);
        __syncthreads();
        { SEG_LANE();
            f32x4 kk[2] = {(f32x4){0, 0, 0, 0}, (f32x4){0, 0, 0, 0}}, qk[2] = {(f32x4){0, 0, 0, 0}, (f32x4){0, 0, 0, 0}};
#pragma unroll
            for (int ks = 0; ks < 4; ++ks) { const bf16x8 yk = frag128(lds + L_KM, 16 * tn, 32 * ks, lane), yq = frag128(lds + L_QM, 16 * tn, 32 * ks, lane);
#pragma unroll
                for (int t2 = 0; t2 < 2; ++t2) { const bf16x8 xk = frag128(lds + L_KM, 16 * (tm0 + t2), 32 * ks, lane);
                    kk[t2] = MFMA16(xk, yk, kk[t2]); qk[t2] = MFMA16(xk, yq, qk[t2]); } }
#pragma unroll
            for (int dir = 0; dir < 2; ++dir) {
                LAS float* gc = sm + 64 * dir; LAS float* bet = sm + 128 + 64 * dir;
                const float gca = gc[ra], ba = bet[ra];
#pragma unroll
                for (int t2 = 0; t2 < 2; ++t2) { const int rb0 = 16 * (tm0 + t2) + 4 * l4;
                    f32x4 pv, ptv, pqv, tv;
#pragma unroll
                    for (int r = 0; r < 4; ++r) { const int rb = rb0 + r; const float gcb = gc[rb], bb = bet[rb];
                        const bool st_ab = dir ? (rb > ra) : (rb < ra), st_ba = dir ? (ra > rb) : (ra < rb), in_ab = st_ab || (rb == ra);
                        const float dab = __expf(fminf(gca - gcb, 0.f)), dba = __expf(fminf(gcb - gca, 0.f));
                        pv[r] = st_ab ? ba * kk[t2][r] * dab : 0.f;
                        ptv[r] = st_ba ? bb * kk[t2][r] * dba : 0.f;
                        pqv[r] = in_ab ? qk[t2][r] * dab : 0.f;
                        tv[r] = (rb == ra ? 1.f : 0.f) - pv[r]; }
                    *(LAS u32x2*)(lds + L_PD(dir) + a64(ra, rb0)) = pack4(pv);
                    *(LAS u32x2*)(lds + L_PTD(dir) + a64(ra, rb0)) = pack4(ptv);
                    *(LAS u32x2*)(lds + L_PQD(dir) + a64(ra, rb0)) = pack4(pqv);
                    *(LAS u32x2*)(lds + L_TD(dir) + a64(ra, rb0)) = pack4(tv); }
            }
        }
        __syncthreads();
        if (wave < 4) { SEG_LANE();
            const int d = wave >> 1, R = 32 * (wave & 1);
            LAS unsigned char* Pi = lds + L_PD(d); LAS unsigned char* PTi = lds + L_PTD(d); LAS unsigned char* Ti = lds + L_TD(d); LAS unsigned char* TTi = lds + L_UT + wave * 4096;
            LAS float* gc = sm + 64 * d; LAS float* bet = sm + 128 + 64 * d;
            f32x4 Ta[2][2], TTa[2][2];
#pragma unroll
            for (int mi = 0; mi < 2; ++mi)
#pragma unroll
                for (int ni = 0; ni < 2; ++ni) { const int ar = R + 16 * ni + l15, b0 = R + 16 * mi + 4 * l4;
                    const u32x2 p = *(const LAS u32x2*)(Pi + a64(ar, b0)), pt = *(const LAS u32x2*)(PTi + a64(ar, b0));
                    Ta[mi][ni][0] = (ar == b0 ? 1.f : 0.f) - bflo(p.x); Ta[mi][ni][1] = (ar == b0 + 1 ? 1.f : 0.f) - bfhi(p.x); Ta[mi][ni][2] = (ar == b0 + 2 ? 1.f : 0.f) - bflo(p.y); Ta[mi][ni][3] = (ar == b0 + 3 ? 1.f : 0.f) - bfhi(p.y);
                    TTa[mi][ni][0] = (ar == b0 ? 1.f : 0.f) - bflo(pt.x); TTa[mi][ni][1] = (ar == b0 + 1 ? 1.f : 0.f) - bfhi(pt.x); TTa[mi][ni][2] = (ar == b0 + 2 ? 1.f : 0.f) - bflo(pt.y); TTa[mi][ni][3] = (ar == b0 + 3 ? 1.f : 0.f) - bfhi(pt.y);
                    *(LAS u32x2*)(TTi + a64(16 * ni + l15, b0)) = pack4(TTa[mi][ni]); }
#pragma unroll 1
            for (int s5 = 0; s5 < 5; ++s5) {
                bf16x8 fp[2], fpt[2], ft[2], ftt[2];
#pragma unroll
                for (int mi = 0; mi < 2; ++mi) { fp[mi] = frag64(Pi, R + 16 * mi, R, lane); fpt[mi] = frag64(PTi, R + 16 * mi, R, lane); ft[mi] = frag64(Ti, R + 16 * mi, R, lane);
                    ftt[mi] = *(const LAS bf16x8*)(TTi + a64(16 * mi + l15, R + 8 * l4)); }
                f32x4 pn[2][2], pnt[2][2];
#pragma unroll
                for (int mi = 0; mi < 2; ++mi)
#pragma unroll
                    for (int ni = 0; ni < 2; ++ni) { pn[mi][ni] = (f32x4){0, 0, 0, 0}; pnt[mi][ni] = (f32x4){0, 0, 0, 0};
                        if (s5 < 4) { pn[mi][ni] = MFMA16(fpt[mi], fp[ni], pn[mi][ni]); pnt[mi][ni] = MFMA16(fp[mi], fpt[ni], pnt[mi][ni]); }
                        if (s5 > 0) { Ta[mi][ni] = MFMA16(fpt[mi], ft[ni], Ta[mi][ni]); TTa[mi][ni] = MFMA16(ft[mi], fpt[ni], TTa[mi][ni]); } }
                (void)ftt;
#pragma unroll
                for (int mi = 0; mi < 2; ++mi)
#pragma unroll
                    for (int ni = 0; ni < 2; ++ni) { const int ar = R + 16 * ni + l15, b0 = R + 16 * mi + 4 * l4;
                        if (s5 < 4) { *(LAS u32x2*)(Pi + a64(ar, b0)) = pack4(pn[mi][ni]); *(LAS u32x2*)(PTi + a64(ar, b0)) = pack4(pnt[mi][ni]); }
                        if (s5 > 0 && s5 < 4) *(LAS u32x2*)(Ti + a64(ar, b0)) = pack4(Ta[mi][ni]); }
            }
#pragma unroll
            for (int mi = 0; mi < 2; ++mi)
#pragma unroll
                for (int ni = 0; ni < 2; ++ni) { const int ar = R + 16 * ni + l15, b0 = R + 16 * mi + 4 * l4; f32x4 tw, tu;
#pragma unroll
                    for (int r = 0; r < 4; ++r) { const float bb = bet[b0 + r]; tu[r] = Ta[mi][ni][r] * bb; tw[r] = tu[r] * __expf(gc[b0 + r]); }
                    *(LAS u32x2*)(Ti + a64(ar, b0)) = pack4(Ta[mi][ni]); *(LAS u32x2*)(TTi + a64(16 * ni + l15, b0)) = pack4(TTa[mi][ni]);
                    *(LAS u32x2*)(Pi + a64(ar, b0)) = pack4(tw); *(LAS u32x2*)(PTi + a64(ar, b0)) = pack4(tu); }
        }
        __syncthreads();
        if (wave == 4 || wave == 5) { SEG_LANE();
            const int d = wave - 4, ab = d ? 0 : 1, bb_ = 1 - ab, Ra = 32 * ab, Rb = 32 * bb_;
            LAS unsigned char* Pi = lds + L_PD(d); LAS unsigned char* PTi = lds + L_PTD(d); LAS unsigned char* Ti = lds + L_TD(d);
            LAS unsigned char* TTb = lds + L_UT + (2 * d + bb_) * 4096; LAS unsigned char* Zi = lds + L_KM + d * 4096;
            LAS float* gc = sm + 64 * d; LAS float* bet = sm + 128 + 64 * d;
            bf16x8 x1[2], y1[2];
#pragma unroll
            for (int t = 0; t < 2; ++t) { x1[t] = frag64(PTi, Rb + 16 * t, Ra, lane); y1[t] = frag64(Ti, Ra + 16 * t, Ra, lane); }
#pragma unroll
            for (int mi = 0; mi < 2; ++mi)
#pragma unroll
                for (int ni = 0; ni < 2; ++ni) { f32x4 z = (f32x4){0, 0, 0, 0}; z = MFMA16(x1[mi], y1[ni], z);
                    *(LAS u32x2*)(Zi + a64(16 * ni + l15, Rb + 16 * mi + 4 * l4)) = pack4(z);
                    *(LAS u32x2*)(PTi + a64(Rb + 16 * ni + l15, Ra + 16 * mi + 4 * l4)) = (u32x2){0u, 0u}; }
            bf16x8 x2[2], y2[2];
#pragma unroll
            for (int t = 0; t < 2; ++t) { x2[t] = *(const LAS bf16x8*)(TTb + a64(16 * t + l15, Rb + 8 * l4)); y2[t] = *(const LAS bf16x8*)(Zi + a64(16 * t + l15, Rb + 8 * l4)); }
#pragma unroll
            for (int mj = 0; mj < 2; ++mj)
#pragma unroll
                for (int ni = 0; ni < 2; ++ni) { f32x4 t = (f32x4){0, 0, 0, 0}; t = MFMA16(x2[mj], y2[ni], t);
                    const int ir = Ra + 16 * ni + l15, j0 = Rb + 16 * mj + 4 * l4; f32x4 tw, tu;
#pragma unroll
                    for (int r = 0; r < 4; ++r) { const float bb = bet[j0 + r]; tu[r] = -t[r] * bb; tw[r] = tu[r] * __expf(gc[j0 + r]); }
                    *(LAS u32x2*)(Pi + a64(ir, j0)) = pack4(tw); *(LAS u32x2*)(PTi + a64(ir, j0)) = pack4(tu); }
        }
        __syncthreads();
#pragma unroll 1
        for (int dir = 0; dir < 2; ++dir) {
            LAS float* gc = sm + 64 * dir;
            const float gl = dir ? gc[0] : gc[63];
            { SEG_LANE(); const int d = tid >> 2, ib = (tid & 3) * 16;
#pragma unroll
                for (int cpart = 0; cpart < 2; ++cpart) { const int i = ib + 8 * cpart; const u32x4 w = *(const LAS u32x4*)(lds + L_KT + a64(d, i));
                    float f[8] = {bflo(w.x), bfhi(w.x), bflo(w.y), bfhi(w.y), bflo(w.z), bfhi(w.z), bflo(w.w), bfhi(w.w)};
#pragma unroll
                    for (int e = 0; e < 8; ++e) f[e] *= __expf(gl - gc[i + e]);
                    u32x4 o; o.x = cvt_pk_bf16(f[0], f[1]); o.y = cvt_pk_bf16(f[2], f[3]); o.z = cvt_pk_bf16(f[4], f[5]); o.w = cvt_pk_bf16(f[6], f[7]);
                    *(LAS u32x4*)(lds + L_KM + a64(d, i)) = o; } }
            { SEG_LANE();
                f32x4 wa[4], ua[4];
#pragma unroll
                for (int t4 = 0; t4 < 4; ++t4) { wa[t4] = (f32x4){0, 0, 0, 0}; ua[t4] = (f32x4){0, 0, 0, 0}; }
#pragma unroll
                for (int ks = 0; ks < 2; ++ks) { const bf16x8 yk = frag64(lds + L_KT, 16 * wave, 32 * ks, lane), yv = frag64(lds + L_VT, 16 * wave, 32 * ks, lane);
#pragma unroll
                    for (int t4 = 0; t4 < 4; ++t4) { const bf16x8 xw = frag64(lds + L_PD(dir), 16 * t4, 32 * ks, lane), xu = frag64(lds + L_PTD(dir), 16 * t4, 32 * ks, lane);
                        wa[t4] = MFMA16(xw, yk, wa[t4]); ua[t4] = MFMA16(xu, yv, ua[t4]); } }
                const int rd = 16 * wave + l15;
#pragma unroll
                for (int t4 = 0; t4 < 4; ++t4) { *(LAS u32x2*)(lds + L_WT + a64(rd, 16 * t4 + 4 * l4)) = pack4(wa[t4]); *(LAS u32x2*)(lds + L_UT + a64(rd, 16 * t4 + 4 * l4)) = pack4(ua[t4]); }
            }
            __syncthreads();
            { SEG_LANE();
                const int cd = ((b * NH + h) * NCH + n) * 2 + dir;
                unsigned char* pb = a.ws + WS_PREP + (size_t)cd * PREP_STRIDE;
                if (tid == 0) eglp[cd] = __expf(gl);
                LAS unsigned char* stg = lds + L_PD(dir) + wave * 2048;
                {
                    bf16x8 y[2]; y[0] = frag64(lds + L_KM, 16 * wave, 0, lane); y[1] = frag64(lds + L_KM, 16 * wave, 32, lane);
#pragma unroll
                    for (int hf = 0; hf < 2; ++hf) { f32x4 c[4];
#pragma unroll
                        for (int t4 = 0; t4 < 4; ++t4) { const int t8 = 4 * hf + t4; c[t4] = (f32x4){0, 0, 0, 0};
                            c[t4] = MFMA16(frag64(lds + L_WT, 16 * t8, 0, lane), y[0], c[t4]); c[t4] = MFMA16(frag64(lds + L_WT, 16 * t8, 32, lane), y[1], c[t4]); c[t4] = -c[t4]; }
                        staged_store_16x64<true>(stg, c, pb, wave, hf, lane); }
                }
                {
                    bf16x8 y[2]; y[0] = frag64(lds + L_UT, 16 * wave, 0, lane); y[1] = frag64(lds + L_UT, 16 * wave, 32, lane);
#pragma unroll
                    for (int hf = 0; hf < 2; ++hf) { f32x4 c[4];
#pragma unroll
                        for (int t4 = 0; t4 < 4; ++t4) { const int t8 = 4 * hf + t4; c[t4] = (f32x4){0, 0, 0, 0};
                            c[t4] = MFMA16(frag64(lds + L_KM, 16 * t8, 0, lane), y[0], c[t4]); c[t4] = MFMA16(frag64(lds + L_KM, 16 * t8, 32, lane), y[1], c[t4]); }
                        staged_store_16x64<false>(stg, c, pb + 32768, wave, hf, lane); }
                }
                {
                    bf16x8 y[2]; y[0] = frag64(lds + L_PQD(dir), 16 * tn, 0, lane); y[1] = frag64(lds + L_PQD(dir), 16 * tn, 32, lane);
                    const float eg = __expf(gc[ra]);
                    f32x4 cq[4], co[4];
#pragma unroll
                    for (int t4 = 0; t4 < 4; ++t4) { const int mt = 4 * (wave >> 2) + t4, c0 = 16 * mt + 4 * l4;
                        cq[t4] = (f32x4){0, 0, 0, 0}; co[t4] = (f32x4){0, 0, 0, 0};
                        cq[t4] = MFMA16(frag64(lds + L_WT, 16 * mt, 0, lane), y[0], cq[t4]); cq[t4] = MFMA16(frag64(lds + L_WT, 16 * mt, 32, lane), y[1], cq[t4]);
                        co[t4] = MFMA16(frag64(lds + L_UT, 16 * mt, 0, lane), y[0], co[t4]); co[t4] = MFMA16(frag64(lds + L_UT, 16 * mt, 32, lane), y[1], co[t4]);
                        const u32x2 qw = *(const LAS u32x2*)(lds + L_QM + a128(ra, c0));
                        cq[t4][0] = eg * bflo(qw.x) - cq[t4][0]; cq[t4][1] = eg * bfhi(qw.x) - cq[t4][1]; cq[t4][2] = eg * bflo(qw.y) - cq[t4][2]; cq[t4][3] = eg * bfhi(qw.y) - cq[t4][3]; }
                    staged_store_16x64<true>(stg, cq, pb + 65536, tn, wave >> 2, lane);
                    staged_store_16x64<false>(stg, co, pb + 81920, tn, wave >> 2, lane);
                }
            }
            __syncthreads();
        }
    }
#undef SEG_LANE
#undef PREP_FETCH
}

__device__ __forceinline__ void ph_pool(const Args& a, LAS unsigned char* lds) {
    const int tid = tid_fresh(), lane = tid & 63, wave = __builtin_amdgcn_readfirstlane(tid >> 6), l15 = lane & 15, l4 = lane >> 4;
    const bf16_t* proj = (const bf16_t*)(a.ws + WS_PROJ);
    bf16_t* amix = (bf16_t*)(a.ws + WS_AMIX);
    for (int tile = blockIdx.x; tile < MTOK / 64; tile += gridDim.x) {
        const int tok0 = tile * 64, tl0 = tok0 & (T - 1);
        __syncthreads();
#pragma unroll
        for (int q = 0; q < 10; ++q) { const int idx = tid + NTHR * q, r = idx >> 6, ch = idx & 63, tl = tl0 - 8 + r;
            u32x4 v = (u32x4){0u, 0u, 0u, 0u};
            if (tl >= 0 && tl < T) v = *(const u32x4*)(proj + (size_t)(tok0 - 8 + r) * NPROJ + 2048 + 8 * ch);
            *(LAS u32x4*)(lds + r * 1024 + ch * 16) = v; }
        __syncthreads();
        const int g = wave & 3, w = 2 << g, lo = w >> 1, hi = w - lo - 1, ch = 16 * g + l15;
#pragma unroll 2
        for (int q = 0; q < 8; ++q) {
            const int tk = 8 * q + 4 * (wave >> 2) + l4, tl = tl0 + tk;
            float sum[8] = {0, 0, 0, 0, 0, 0, 0, 0};
            for (int j = -lo; j <= hi; ++j) { const u32x4 v = *(const LAS u32x4*)(lds + (tk + 8 + j) * 1024 + ch * 16);
                sum[0] += bflo(v.x); sum[1] += bfhi(v.x); sum[2] += bflo(v.y); sum[3] += bfhi(v.y); sum[4] += bflo(v.z); sum[5] += bfhi(v.z); sum[6] += bflo(v.w); sum[7] += bfhi(v.w); }
            const u32x4 v = *(const LAS u32x4*)(lds + (tk + 8) * 1024 + ch * 16);
            const int s0 = max(tl - lo, 0), e0 = min(tl + hi + 1, T);
            const float inv = 1.f / (float)(e0 - s0);
            u32x4 o; o.x = cvt_pk_bf16(sum[0] * inv - bflo(v.x), sum[1] * inv - bfhi(v.x)); o.y = cvt_pk_bf16(sum[2] * inv - bflo(v.y), sum[3] * inv - bfhi(v.y));
            o.z = cvt_pk_bf16(sum[4] * inv - bflo(v.z), sum[5] * inv - bfhi(v.z)); o.w = cvt_pk_bf16(sum[6] * inv - bflo(v.w), sum[7] * inv - bfhi(v.w));
            *(u32x4*)(amix + (size_t)(tok0 + tk) * D + 512 + 8 * ch) = o;
        }
    }
    __syncthreads();
}

struct ScanSet { bf16x8 xm[4]; bf16x8 yq[4]; u32x2 cw[2]; u32x2 ow; float egl; };
template <int VAR>
__device__ __forceinline__ void ph_scan(const Args& a, LAS unsigned char* lds, int vb) {
    const int tid = tid_fresh(), lane = tid & 63, wave = __builtin_amdgcn_readfirstlane(tid >> 6), l15 = lane & 15, l4 = lane >> 4;
    const float* eglp = (const float*)(a.ws + WS_EGL);
    bf16_t* od = (bf16_t*)(a.ws + (VAR == 0 ? WS_OD : (size_t)464 * MiB));
    const int tn = wave & 3, eo = wave >> 2;
    for (int job = vb; job < 256; job += gridDim.x) {
        const int x = job & 7, j = job >> 3, chain = x * 8 + (j >> 2), sl = j & 3, dir = chain & 1, bh = chain >> 1, b = bh >> 2, h = bh & 3;
        if (VAR == 1 && sl != 0) continue;
        f32x4 acc[2] = {(f32x4){0, 0, 0, 0}, (f32x4){0, 0, 0, 0}};
        const unsigned offx = (unsigned)(wave * 4) * 1024u + (unsigned)l15 * 64u + (unsigned)l4 * 16u;
        const unsigned offc = 32768u + (unsigned)((2 * sl) * 8 + wave) * 512u + (unsigned)l15 * 32u + (unsigned)l4 * 8u;
        const unsigned offq = 65536u + (unsigned)(tn * 4) * 1024u + (unsigned)l15 * 64u + (unsigned)l4 * 16u;
        const unsigned offo = 81920u + (unsigned)(tn * 8 + 2 * sl + eo) * 512u + (unsigned)l15 * 32u + (unsigned)l4 * 8u;
        const long dstep = dir ? -(long)(2 * PREP_STRIDE) : (long)(2 * PREP_STRIDE);
        const int cd0 = (bh * NCH + (dir ? NCH - 1 : 0)) * 2 + dir;
        const GAS unsigned char* pld = (const GAS unsigned char*)(a.ws + WS_PREP + (size_t)cd0 * PREP_STRIDE);
        const GAS float* pegl = (const GAS float*)(eglp + cd0);
        GAS bf16_t* pod = (GAS bf16_t*)od + ((size_t)dir * MTOK + (size_t)(b * T + (dir ? NCH - 1 : 0) * 64 + 16 * tn + l15)) * 512 + h * HD + 32 * sl + 16 * eo + 4 * l4;
        const long ostep = dir ? -(long)(64 * 512) : (long)(64 * 512);
        const long gstep = dir ? -2 : 2;
#define SCAN_LOAD(S) do { asm volatile("" : "+s"(pld), "+s"(pegl)); \
        _Pragma("unroll") for (int ks = 0; ks < 4; ++ks) { S.xm[ks] = *(const GAS bf16x8*)(pld + offx + 1024 * ks); S.yq[ks] = *(const GAS bf16x8*)(pld + offq + 1024 * ks); } \
        _Pragma("unroll") for (int et = 0; et < 2; ++et) S.cw[et] = *(const GAS u32x2*)(pld + offc + 4096 * et); \
        S.ow = *(const GAS u32x2*)(pld + offo); S.egl = *pegl; pld += dstep; pegl += gstep; } while (0)
#define SCAN_STEP(S, SN, step) do { const int cur_ = (step) & 1; \
        _Pragma("unroll") for (int et = 0; et < 2; ++et) *(LAS u32x2*)(lds + cur_ * 8192 + a128(16 * et + l15, 16 * wave + 4 * l4)) = pack4(acc[et]); \
        asm volatile("s_waitcnt lgkmcnt(0)" ::: "memory"); __builtin_amdgcn_s_barrier(); asm volatile("" ::: "memory"); \
        if ((step) + 3 < NCH) SCAN_LOAD(SN); \
        bf16x8 st_[2][4]; \
        _Pragma("unroll") for (int et = 0; et < 2; ++et) _Pragma("unroll") for (int ks = 0; ks < 4; ++ks) st_[et][ks] = frag128(lds + cur_ * 8192, 16 * et, 32 * ks, lane); \
        f32x4 o_; o_[0] = bflo(S.ow.x); o_[1] = bfhi(S.ow.x); o_[2] = bflo(S.ow.y); o_[3] = bfhi(S.ow.y); \
        _Pragma("unroll") for (int ks = 0; ks < 4; ++ks) o_ = MFMA16(eo ? st_[1][ks] : st_[0][ks], S.yq[ks], o_); \
        _Pragma("unroll") for (int et = 0; et < 2; ++et) { \
            acc[et][0] = S.egl * acc[et][0] + bflo(S.cw[et].x); acc[et][1] = S.egl * acc[et][1] + bfhi(S.cw[et].x); acc[et][2] = S.egl * acc[et][2] + bflo(S.cw[et].y); acc[et][3] = S.egl * acc[et][3] + bfhi(S.cw[et].y); \
            _Pragma("unroll") for (int ks = 0; ks < 4; ++ks) acc[et] = MFMA16(S.xm[ks], st_[et][ks], acc[et]); } \
        asm volatile("" : "+v"(pod)); *(GAS u32x2*)pod = pack4(o_); pod += ostep; } while (0)
        ScanSet s0, s1, s2, s3;
        SCAN_LOAD(s0); SCAN_LOAD(s1); SCAN_LOAD(s2);
        __syncthreads();
#pragma unroll
        for (int step = 0; step < NCH; step += 4) {
            SCAN_STEP(s0, s3, step); SCAN_STEP(s1, s0, step + 1); SCAN_STEP(s2, s1, step + 2); SCAN_STEP(s3, s2, step + 3);
        }
#undef SCAN_LOAD
#undef SCAN_STEP
    }
}

__device__ __forceinline__ void ph_delta_out(const Args& a, LAS unsigned char* lds) {
    const int tid = tid_fresh(), lane = tid & 63, wave = tid >> 6, l15 = lane & 15, l4 = lane >> 4;
    const bf16_t* proj = (const bf16_t*)(a.ws + WS_PROJ); const bf16_t* od = (const bf16_t*)(a.ws + WS_OD);
    bf16_t* amix = (bf16_t*)(a.ws + WS_AMIX);
    const f32x4 hw0 = *(const f32x4*)(a.in[8] + 8 * l15), hw1 = *(const f32x4*)(a.in[8] + 8 * l15 + 4);
    const int gw = blockIdx.x * NWAVE + wave, NGW = gridDim.x * NWAVE;
    u32x4 fn = (u32x4){0u, 0u, 0u, 0u}, gn = fn, zn = fn;
    if (gw < MTOK) { const size_t base = (size_t)gw * 512 + 128 * l4 + 8 * l15; fn = *(const u32x4*)(od + base); gn = *(const u32x4*)(od + (size_t)MTOK * 512 + base);
        zn = *(const u32x4*)(proj + (size_t)gw * NPROJ + 1536 + 128 * l4 + 8 * l15); }
    for (int it = gw; it < MTOK; it += NGW) {
        const u32x4 f = fn, g = gn, z = zn;
        if (it + NGW < MTOK) { const size_t base = (size_t)(it + NGW) * 512 + 128 * l4 + 8 * l15; fn = *(const u32x4*)(od + base); gn = *(const u32x4*)(od + (size_t)MTOK * 512 + base);
            zn = *(const u32x4*)(proj + (size_t)(it + NGW) * NPROJ + 1536 + 128 * l4 + 8 * l15); }
        float o[8] = {bflo(f.x) + bflo(g.x), bfhi(f.x) + bfhi(g.x), bflo(f.y) + bflo(g.y), bfhi(f.y) + bfhi(g.y), bflo(f.z) + bflo(g.z), bfhi(f.z) + bfhi(g.z), bflo(f.w) + bflo(g.w), bfhi(f.w) + bfhi(g.w)};
        float ss = 0.f;
#pragma unroll
        for (int e = 0; e < 8; ++e) ss += o[e] * o[e];
        ss += __shfl_xor(ss, 1); ss += __shfl_xor(ss, 2); ss += __shfl_xor(ss, 4); ss += __shfl_xor(ss, 8);
        const float r = rsqrtf(ss * (1.f / HD) + EPS);
        const float zf[8] = {bflo(z.x), bfhi(z.x), bflo(z.y), bfhi(z.y), bflo(z.z), bfhi(z.z), bflo(z.w), bfhi(z.w)};
        u32x4 w;
        w.x = cvt_pk_bf16(o[0] * r * hw0[0] * silu_f(zf[0]), o[1] * r * hw0[1] * silu_f(zf[1])); w.y = cvt_pk_bf16(o[2] * r * hw0[2] * silu_f(zf[2]), o[3] * r * hw0[3] * silu_f(zf[3]));
        w.z = cvt_pk_bf16(o[4] * r * hw1[0] * silu_f(zf[4]), o[5] * r * hw1[1] * silu_f(zf[5])); w.w = cvt_pk_bf16(o[6] * r * hw1[2] * silu_f(zf[6]), o[7] * r * hw1[3] * silu_f(zf[7]));
        *(u32x4*)(amix + (size_t)it * D + 128 * l4 + 8 * l15) = w;
    }
}

__device__ __forceinline__ int block_sum(int v, LAS int* slot8, int wave, int lane) {
#pragma unroll
    for (int o = 1; o < 64; o <<= 1) v += __shfl_xor(v, o);
    if (lane == 0) slot8[wave] = v;
    __syncthreads();
    int s = 0;
#pragma unroll
    for (int w = 0; w < 8; ++w) s += slot8[w];
    return s;
}
__device__ __forceinline__ int block_excl_scan(int v, LAS int* slot8, int wave, int lane) {
    int inc = v;
#pragma unroll
    for (int o = 1; o < 64; o <<= 1) { const int t = __shfl_up(inc, o); if (lane >= o) inc += t; }
    if (lane == 63) slot8[wave] = inc;
    __syncthreads();
    int off = 0;
#pragma unroll
    for (int w = 0; w < 8; ++w) off += (w < wave) ? slot8[w] : 0;
    return off + inc - v;
}
__device__ __forceinline__ void ph_topk_gather(const Args& a, LAS unsigned char* lds) {
    const int tid = tid_fresh(), lane = tid & 63, wave = tid >> 6;
    const float* probs = (const float*)(a.ws + WS_PROBS);
    int* inv = (int*)(a.ws + WS_INV); int* seli = (int*)(a.ws + WS_SELI); float* selg = (float*)(a.ws + WS_SELG);
    LAS int* red = (LAS int*)lds;
    for (int job = blockIdx.x; job < NB * NE; job += gridDim.x) {
        const int be = job, b = be >> 4, e = be & 15;
        unsigned v[4];
#pragma unroll
        for (int j = 0; j < 4; ++j) v[j] = __float_as_uint(probs[(size_t)(b * T + 4 * tid + j) * 16 + e]);
        __syncthreads();
        unsigned thr = 0u;
#pragma unroll 1
        for (int rd = 0; rd < 8; ++rd) { const int sh = 28 - 4 * rd;
            LAS int* slot = red + 128 * (rd & 1);
#pragma unroll
            for (int i = 1; i < 16; ++i) { const unsigned cand = thr | ((unsigned)i << sh); int c = 0;
#pragma unroll
                for (int j = 0; j < 4; ++j) c += (int)__builtin_popcountll(__ballot(v[j] >= cand));
                if (lane == 0) slot[wave * 16 + i] = c; }
            __syncthreads();
            int best = 0;
#pragma unroll
            for (int i = 1; i < 16; ++i) { int c = 0;
#pragma unroll
                for (int w8 = 0; w8 < 8; ++w8) c += slot[w8 * 16 + i];
                best = (c >= CAP) ? i : best; }
            thr |= (unsigned)best << sh; }
        __syncthreads();
        int cgt = 0, ceq = 0;
#pragma unroll
        for (int j = 0; j < 4; ++j) { cgt += (v[j] > thr) ? 1 : 0; ceq += (v[j] == thr) ? 1 : 0; }
        const int tot_gt = block_sum(cgt, red + 8 * 32, wave, lane);
        const int need_eq = CAP - tot_gt;
        const int eq_before = block_excl_scan(ceq, red + 8 * 33, wave, lane);
        int sel[4], nsel = 0, eqc = eq_before;
#pragma unroll
        for (int j = 0; j < 4; ++j) { const bool iseq = (v[j] == thr); sel[j] = (v[j] > thr) || (iseq && eqc < need_eq); eqc += iseq ? 1 : 0; nsel += sel[j]; }
        int slot = block_excl_scan(nsel, red + 8 * 34, wave, lane);
#pragma unroll
        for (int j = 0; j < 4; ++j) { const int t = 4 * tid + j;
            if (sel[j]) { seli[be * CAP + slot] = b * T + t; selg[be * CAP + slot] = __uint_as_float(v[j]); }
            inv[(size_t)(b * T + t) * 16 + e] = sel[j] ? slot : -1;
            slot += sel[j]; }
        __syncthreads();
    }
}

__device__ __forceinline__ void ph_final(const Args& a, bool with_ffn) {
    const int tid = tid_fresh(), lane = tid & 63, wave = tid >> 6;
    const int* inv = (const int*)(a.ws + WS_INV); const bf16_t* y = (const bf16_t*)(a.ws + WS_Y); const float* selg = (const float*)(a.ws + WS_SELG);
    const f32x4* nw4 = (const f32x4*)a.in[17] + lane;
    f32x4 w4[4];
#pragma unroll
    for (int j = 0; j < 4; ++j) w4[j] = nw4[64 * j];
    const int gw = blockIdx.x * NWAVE + wave, NGW = gridDim.x * NWAVE;
    const bf16_t* hb = (const bf16_t*)(a.ws + WS_HB);
    u32x2 hn[4]; int invn = -1;
    if (gw < MTOK) { const u32x2* xr0 = (const u32x2*)(hb + (size_t)gw * D) + lane;
#pragma unroll
        for (int j = 0; j < 4; ++j) hn[j] = xr0[64 * j];
        if (with_ffn && lane < NE) invn = inv[(size_t)gw * 16 + lane]; }
    for (int row = gw; row < MTOK; row += NGW) {
        f32x4* xr = (f32x4*)(a.out + (size_t)row * D) + lane;
        f32x4 v[4];
#pragma unroll
        for (int j = 0; j < 4; ++j) v[j] = (f32x4){bflo(hn[j].x), bfhi(hn[j].x), bflo(hn[j].y), bfhi(hn[j].y)};
        const int myinv = invn;
        if (row + NGW < MTOK) { const u32x2* xr1 = (const u32x2*)(hb + (size_t)(row + NGW) * D) + lane;
#pragma unroll
            for (int j = 0; j < 4; ++j) hn[j] = xr1[64 * j];
            invn = (with_ffn && lane < NE) ? inv[(size_t)(row + NGW) * 16 + lane] : -1; }
        if (with_ffn) {
            const int b = row >> 11;
            unsigned long long mask = __ballot(myinv >= 0);
            while (mask) {
                int yrow[4]; float gq[4];
#pragma unroll
                for (int q = 0; q < 4; ++q) { const bool ok = mask != 0ull; const int e = ok ? (int)__builtin_ctzll(mask) : 0; if (ok) mask &= mask - 1ull;
                    const int sl = __shfl(myinv, e); yrow[q] = (b * NE + e) * CAP + (ok ? sl : 0); gq[q] = ok ? selg[yrow[q]] : 0.f; }
                u32x2 wq[4][4];
#pragma unroll
                for (int q = 0; q < 4; ++q) { const u32x2* yr = (const u32x2*)(y + (size_t)yrow[q] * D) + lane;
#pragma unroll
                    for (int j = 0; j < 4; ++j) wq[q][j] = yr[64 * j]; }
#pragma unroll
                for (int q = 0; q < 4; ++q)
#pragma unroll
                    for (int j = 0; j < 4; ++j) { v[j].x += gq[q] * bflo(wq[q][j].x); v[j].y += gq[q] * bfhi(wq[q][j].x); v[j].z += gq[q] * bflo(wq[q][j].y); v[j].w += gq[q] * bfhi(wq[q][j].y); }
            }
        }
        float ss = 0.f;
#pragma unroll
        for (int j = 0; j < 4; ++j) ss += (v[j].x * v[j].x + v[j].y * v[j].y) + (v[j].z * v[j].z + v[j].w * v[j].w);
        const float r = rsqrtf(wave_sum(ss) * (1.f / D) + EPS);
#pragma unroll
        for (int j = 0; j < 4; ++j) xr[64 * j] = v[j] * r * w4[j];
    }
}

#ifndef EXP_VAR
#define EXP_VAR 0
#endif
#ifndef DBL_MASK
#define DBL_MASK 0
#endif
#ifndef PH_PER_LAUNCH
#define PH_PER_LAUNCH 1
#endif
#ifndef PLAIN_LAUNCH
#define PLAIN_LAUNCH 0
#endif
#ifndef USE_CG_SYNC
#define USE_CG_SYNC 0
#endif
#ifndef ONE_LAUNCH
#define ONE_LAUNCH 1
#endif
#ifndef DBG_STAGE
#define DBG_STAGE 3
#endif
#define XB_TMO      128
#define XB_XCNT(j)  (256  + 64 * (j))
#define XB_XSUB(j)  (1280 + 64 * (j))
#define XB_XGEN(j)  (2304 + 64 * (j))
#define XB_TOP      3328
#define XB_TOPGEN   3392
#define XCD_BAR_WORDS 3456
#define XB_SPIN_CAP (1u << 20)
__device__ __forceinline__ unsigned xb_ld(unsigned* p)              { return __hip_atomic_load(p, __ATOMIC_RELAXED, __HIP_MEMORY_SCOPE_AGENT); }
__device__ __forceinline__ unsigned xb_add(unsigned* p, unsigned v) { return __hip_atomic_fetch_add(p, v, __ATOMIC_RELAXED, __HIP_MEMORY_SCOPE_AGENT); }
__device__ __forceinline__ unsigned xb_xcc_id() { return (unsigned)__builtin_amdgcn_s_getreg((3 << 11) | 20) & 0xFu; }
#define XB_SPIN(cond, bar) do { unsigned _sp = 0; while (cond) { __builtin_amdgcn_s_sleep(1); \
    if ((++_sp & 255u) == 0u) { if (xb_ld(&(bar)[XB_TMO])) break; if (_sp > XB_SPIN_CAP) { atomicAdd(&(bar)[XB_TMO], 1u); break; } } } } while (0)
struct XcdBarrier { unsigned* bar; unsigned x; volatile LAS unsigned* st; };
__device__ __forceinline__ XcdBarrier xcd_barrier_post(unsigned* bar, volatile LAS unsigned* st) {
    XcdBarrier b; b.bar = bar; b.x = xb_xcc_id(); b.st = st;
    if (threadIdx.x == 0) st[2] = xb_add(&bar[XB_XCNT(b.x)], 1u);
    return b;
}
__device__ __forceinline__ void xcd_barrier_complete(unsigned* bar, unsigned x, unsigned& nloc, unsigned& nx) {
    const unsigned G = gridDim.x * gridDim.y * gridDim.z;
    unsigned sum, cnt, mine, sp = 0u;
    for (;;) {
        sum = 0u; cnt = 0u; mine = 0u;
#pragma unroll
        for (unsigned j = 0; j < 16; ++j) { const unsigned c = xb_ld(&bar[XB_XCNT(j)]); sum += c; cnt += (c > 0u) ? 1u : 0u; mine = (j == x) ? c : mine; }
        if (sum == G) break;
        __builtin_amdgcn_s_sleep(1);
        if ((++sp & 255u) == 0u) { if (xb_ld(&bar[XB_TMO])) break; if (sp > XB_SPIN_CAP) { atomicAdd(&bar[XB_TMO], 1u); break; } }
    }
    nloc = mine > 0u ? mine : 1u; nx = cnt > 0u ? cnt : 1u;
}
__device__ __forceinline__ void xcd_barrier(const XcdBarrier& b) {
    asm volatile("s_waitcnt vmcnt(0)" ::: "memory");
    __syncthreads();
    if (threadIdx.x == 0) {
        unsigned* bar = b.bar;
        __builtin_amdgcn_s_waitcnt(0);
        unsigned nloc = b.st[0], nx = b.st[1];
        if (nloc == 0u) { xcd_barrier_complete(bar, b.x, nloc, nx); b.st[0] = nloc; b.st[1] = nx; }
        const unsigned old = xb_add(&bar[XB_XSUB(b.x)], 1u);
        const unsigned gen = old / nloc;
        bool fire = false;
        if (old + 1u == (gen + 1u) * nloc) {
            __builtin_amdgcn_fence(__ATOMIC_RELEASE, "agent");
            asm volatile("s_waitcnt vmcnt(0)" ::: "memory");
            const unsigned og = xb_add(&bar[XB_TOP], 1u);
            if (og + 1u == (og / nx + 1u) * nx) { xb_add(&bar[XB_TOPGEN], 1u); fire = true; }
        }
        if (!fire) XB_SPIN(xb_ld(&bar[XB_TOPGEN]) == gen, bar);
        __builtin_amdgcn_fence(__ATOMIC_ACQUIRE, "agent");
        asm volatile("s_waitcnt vmcnt(0)" ::: "memory");
    }
    __syncthreads();
}

typedef const __attribute__((address_space(4))) Args* CArgsP;
__device__ __forceinline__ Args fresh_args() {
    Args r{};
#if defined(__HIP_DEVICE_COMPILE__)
    const __attribute__((address_space(4))) unsigned long long* p = (const __attribute__((address_space(4))) unsigned long long*)__builtin_amdgcn_kernarg_segment_ptr();
    asm volatile("" : "+s"(p));
#pragma unroll
    for (int i = 0; i < 18; ++i) r.in[i] = (const float*)(const __attribute__((address_space(1))) float*)p[i];
    r.out = (float*)(__attribute__((address_space(1))) float*)p[18]; r.ws = (unsigned char*)(__attribute__((address_space(1))) unsigned char*)p[19]; r.ph_lo = (int)(unsigned)p[20]; r.ph_hi = (int)(p[20] >> 32);
#endif
    return r;
}
template <int LO, int HI>
__global__ void __launch_bounds__(NTHR, 2) fwd_kernel(Args a_unused) {
    extern __shared__ __attribute__((aligned(16))) unsigned char lds_raw[];
    LAS unsigned char* lds = (LAS unsigned char*)lds_raw;
    int rlo = LO, rhi = HI;
    if constexpr (HI - LO > 1) { const Args a = fresh_args(); rlo = a.ph_lo; rhi = a.ph_hi; }
#define IN(k) (LO <= (k) && (k) < HI)
#define RIN(k) (rlo <= (k) && (k) < rhi)
    XcdBarrier bar; bar.bar = nullptr; bar.x = 0; bar.st = nullptr;
    if constexpr (HI - LO > 1) {
        volatile LAS unsigned* st = (volatile LAS unsigned*)(lds + LDS_BYTES - 16);
        if (threadIdx.x == 0) { st[0] = 0u; st[1] = 0u; }
        __syncthreads();
        const Args a = fresh_args();
        bar = xcd_barrier_post((unsigned*)(a.ws + WS_CTL), st);
    }
#if USE_CG_SYNC
#define SEAM(k) do { if constexpr (IN(k) && IN((k) + 1)) { cooperative_groups::this_grid().sync(); } } while (0)
#else
#define SEAM(k) do { if constexpr (IN(k) && IN((k) + 1)) { if (RIN(k) && RIN((k) + 1)) xcd_barrier(bar); } } while (0)
#endif
    if constexpr (IN(0)) if (RIN(0)) { const Args a = fresh_args(); ph_prologue(a, lds); }
    SEAM(0);
    int vb = blockIdx.x;
    if constexpr (HI - LO > 1) {
        if (RIN(0) && RIN(1)) {
            volatile LAS unsigned* st = (volatile LAS unsigned*)(lds + LDS_BYTES - 16);
            if (threadIdx.x == 0) { bool ok = gridDim.x == 256;
                for (unsigned j = 0; j < 16; ++j) { const unsigned c = xb_ld(&bar.bar[XB_XCNT(j)]); ok = ok && (j < 8 ? c == 32u : c == 0u); }
                st[3] = ok ? (bar.x + 8u * st[2]) : blockIdx.x; }
            __syncthreads();
            vb = __builtin_amdgcn_readfirstlane((int)st[3]);
        }
    }
    if constexpr (IN(1)) if (RIN(1)) { const Args a = fresh_args(); pg8::Gemm g{(const bf16_t*)(a.ws + WS_XN), (const bf16_t*)(a.ws + WS_WIN), D, nullptr}; pg8::StaticOrder S; S.init(MTOK, NPROJ, gridDim.x, vb);
        pg8::EpiProj E{(bf16_t*)(a.ws + WS_PROJ), NPROJ}; pg8::gemm_phase(lds, g, S, E);
        if (DBG_STAGE >= 3) { if (gridDim.x == 256) expert_weight_cvt<true>(a, lds, 0, NEARLY * 1024, 128, 128, vb); else expert_weight_cvt<true>(a, lds, 0, NEARLY * 1024, 0, gridDim.x, blockIdx.x); } }
    SEAM(1);
    if constexpr (IN(2)) if (RIN(2)) { const Args a = fresh_args(); ph_pool(a, lds); if (DBG_STAGE >= 2) ph_chunk_prep(a, lds); }
    SEAM(2);
    if constexpr (IN(3)) if (RIN(3)) { const Args a = fresh_args(); if (DBG_STAGE >= 2) ph_scan<0>(a, lds, vb); }
    SEAM(3);
    if constexpr (IN(4)) if (RIN(4)) { const Args a = fresh_args(); if (DBG_STAGE >= 2) ph_delta_out(a, lds); }
    SEAM(4);
    if constexpr (IN(5)) if (RIN(5)) { { const Args a = fresh_args(); pg8::Gemm g{(const bf16_t*)(a.ws + WS_AMIX), (const bf16_t*)(a.ws + WS_WMIX), D, nullptr}; pg8::StaticOrder S; S.init(MTOK, D, gridDim.x, vb);
        pg8::EpiResid E{a.in[0], (bf16_t*)(a.ws + WS_HB), D}; pg8::gemm_phase(lds, g, S, E); }
        if (DBG_STAGE >= 3) { const Args a = fresh_args(); expert_weight_cvt<false>(a, lds, 0, CVT_SPLIT, 0, gridDim.x, blockIdx.x); } }
    SEAM(5);
    if constexpr (IN(6)) if (RIN(6)) { const Args a = fresh_args(); if (DBG_STAGE >= 3) row_pass<1>(a, lds); }
    SEAM(6);
    if constexpr (IN(7)) if (RIN(7)) { const Args a = fresh_args(); if (DBG_STAGE >= 3) { ph_topk_gather(a, lds); if (gridDim.x > NB * NE) expert_weight_cvt<false>(a, lds, CVT_SPLIT, CVT_ITEMS, NB * NE, gridDim.x - NB * NE, blockIdx.x); else expert_weight_cvt<false>(a, lds, CVT_SPLIT, CVT_ITEMS, 0, gridDim.x, blockIdx.x); } }
    SEAM(7);
    if constexpr (IN(8)) if (RIN(8)) { if (DBG_STAGE >= 3) { const Args a = fresh_args(); pg8::Gemm g{(const bf16_t*)(a.ws + WS_XN), (const bf16_t*)(a.ws + WS_WGU), D / 2, (const int*)(a.ws + WS_SELI)}; pg8::ExpertOrder S; S.init(vb, 16);
        pg8::EpiSwiglu E{a.ws + WS_HMID}; pg8::gemm_phase<pg8::EpiSwiglu, pg8::ExpertOrder, true, true>(lds, g, S, E); } }
    SEAM(8);
    if constexpr (IN(9)) if (RIN(9)) { if (DBG_STAGE >= 3) { const Args a = fresh_args(); pg8::Gemm g{(const bf16_t*)(a.ws + WS_HMID), (const bf16_t*)(a.ws + WS_WD), FF / 2, nullptr}; pg8::ExpertOrder S; S.init(vb, 4, NEARLY, (int)((WS_WDA - WS_WD) / ((size_t)256 * FF)));
        pg8::EpiDown E{(bf16_t*)(a.ws + WS_Y)}; pg8::gemm_phase<pg8::EpiDown, pg8::ExpertOrder, false, true>(lds, g, S, E); } }
    SEAM(9);
    if constexpr (IN(10)) if (RIN(10)) { const Args a = fresh_args(); ph_final(a, DBG_STAGE >= 3); }
#undef IN
#undef SEAM
}
template <int VAR> __global__ void __launch_bounds__(NTHR, 2) exp_scan_kernel(Args a_unused) {
    extern __shared__ __attribute__((aligned(16))) unsigned char lds_raw[];
    const Args a = fresh_args(); ph_scan<VAR>(a, (LAS unsigned char*)lds_raw, blockIdx.x);
}
template <int P> static void launch_phase(const Args& a, hipStream_t stream) {
    static bool attr = false;
    if (!attr) { (void)hipFuncSetAttribute((const void*)fwd_kernel<P, P + 1>, hipFuncAttributeMaxDynamicSharedMemorySize, LDS_BYTES); attr = true; }
    hipLaunchKernelGGL((fwd_kernel<P, P + 1>), dim3(NBLK), dim3(NTHR), LDS_BYTES, stream, a);
}

extern "C" void kernel_launch(void* const* d_in, const int* in_sizes, int n_in, void* d_out, int out_size, void* d_ws, size_t ws_size, hipStream_t stream) {
    if (n_in != 18 || out_size != MTOK * D || ws_size < WS_END) { fprintf(stderr, "kernel_launch: unexpected shapes (n_in %d out %d ws %zu)\n", n_in, out_size, ws_size); return; }
    Args a{};
    for (int i = 0; i < 18; ++i) a.in[i] = (const float*)d_in[i];
    a.out = (float*)d_out; a.ws = (unsigned char*)d_ws;
    if (DBG_STAGE < 2) (void)hipMemsetAsync((char*)d_ws + WS_AMIX, 0, 32 * MiB, stream);
#if ONE_LAUNCH
    static int grid = 0;
    if (!grid) {
        int dev = 0, cus = 0, per_cu = 0;
        (void)hipGetDevice(&dev); (void)hipDeviceGetAttribute(&cus, hipDeviceAttributeMultiprocessorCount, dev);
        (void)hipFuncSetAttribute((const void*)fwd_kernel<0, 11>, hipFuncAttributeMaxDynamicSharedMemorySize, LDS_BYTES);
        (void)hipOccupancyMaxActiveBlocksPerMultiprocessor(&per_cu, (const void*)fwd_kernel<0, 11>, NTHR, LDS_BYTES);
        grid = (per_cu >= 1 && cus >= NBLK) ? NBLK : -1;
        if (grid < 0) fprintf(stderr, "kernel_launch: needs %d co-resident workgroups (cus %d, per_cu %d)\n", NBLK, cus, per_cu);
    }
    if (grid < 0) return;
    (void)hipMemsetAsync((char*)d_ws + WS_CTL, 0, 16384, stream);
    void* kargs[] = {(void*)&a};
#if PLAIN_LAUNCH
    (void)kargs;
    for (int p = 0; p < 11; p += PH_PER_LAUNCH) { a.ph_lo = p; a.ph_hi = (p + PH_PER_LAUNCH < 11) ? p + PH_PER_LAUNCH : 11;
        for (int rep = 0; rep < (((DBL_MASK >> p) & 1) ? 2 : 1); ++rep) hipLaunchKernelGGL((fwd_kernel<0, 11>), dim3(NBLK), dim3(NTHR), LDS_BYTES, stream, a);
#if EXP_VAR
        if (p == 3) { static bool at = false; if (!at) { (void)hipFuncSetAttribute((const void*)exp_scan_kernel<EXP_VAR>, hipFuncAttributeMaxDynamicSharedMemorySize, LDS_BYTES); at = true; }
            hipLaunchKernelGGL((exp_scan_kernel<EXP_VAR>), dim3(NBLK), dim3(NTHR), LDS_BYTES, stream, a); }
#endif
    }
#else
    a.ph_lo = 0; a.ph_hi = 11;
    hipError_t e = hipLaunchCooperativeKernel((const void*)fwd_kernel<0, 11>, dim3(NBLK), dim3(NTHR), kargs, LDS_BYTES, stream);
    if (e != hipSuccess) fprintf(stderr, "cooperative launch failed: %s\n", hipGetErrorString(e));
#endif
#else
    launch_phase<0>(a, stream); launch_phase<1>(a, stream); launch_phase<2>(a, stream); launch_phase<3>(a, stream); launch_phase<4>(a, stream); launch_phase<5>(a, stream);
    launch_phase<6>(a, stream); launch_phase<7>(a, stream); launch_phase<8>(a, stream); launch_phase<9>(a, stream); launch_phase<10>(a, stream);
#endif
}
#ifdef TEST_LO
template __global__ void fwd_kernel<TEST_LO, TEST_HI>(Args);
#endif
```

```cpp
#include <hip/hip_runtime.h>
#include <hip/hip_cooperative_groups.h>
#include <cstdio>
#include <cstdint>

#define LAS __attribute__((address_space(3)))
#define GAS __attribute__((address_space(1)))
typedef unsigned short bf16_t;
typedef short bf16x8 __attribute__((ext_vector_type(8)));
typedef float f32x4 __attribute__((ext_vector_type(4)));
typedef float f32x2 __attribute__((ext_vector_type(2)));
typedef unsigned u32x4 __attribute__((ext_vector_type(4)));
typedef unsigned u32x2 __attribute__((ext_vector_type(2)));
typedef int i32x4 __attribute__((ext_vector_type(4)));
typedef int i32x8 __attribute__((ext_vector_type(8)));

constexpr int NB = 8, T = 2048, D = 1024, MTOK = NB * T;
constexpr int INC = 2576, NPROJ = 2560;
constexpr int NH = 4, HD = 128, NCH = T / 64;
constexpr int NE = 16, CAP = 256, FF = 2048;
constexpr float EPS = 1e-6f;
constexpr int NBLK = 256, NTHR = 512, NWAVE = 8;
constexpr int LDS_BYTES = 155648;

constexpr size_t MiB = (size_t)1 << 20;
constexpr size_t WS_CTL = 0;
constexpr size_t WS_WIN = 1 * MiB;
constexpr size_t WS_WMIX = 6 * MiB;
constexpr size_t WS_PREP = 8 * MiB;
constexpr size_t WS_WGU = 396 * MiB;
constexpr size_t WS_WD = 200 * MiB;
constexpr size_t WS_XN = 460 * MiB;
constexpr size_t WS_XN2 = 232 * MiB;
constexpr size_t WS_AMIX = 232 * MiB;
constexpr size_t WS_Y = 268 * MiB;
constexpr size_t WS_GATES = 264 * MiB;
constexpr size_t WS_PROBS = 265 * MiB;
constexpr size_t WS_INV = 266 * MiB;
constexpr size_t WS_SELI = 267 * MiB;
constexpr size_t WS_SELG = 267 * MiB + 131072;
constexpr size_t WS_EGL = 267 * MiB + 262144;
constexpr size_t WS_PROJ = 268 * MiB;
constexpr size_t WS_XG = 268 * MiB;
constexpr size_t WS_OD = 348 * MiB;
constexpr size_t WS_HB = 8 * MiB;
constexpr size_t HB_BEXTRA = (24 * MiB - 4 * MiB) / 2;
constexpr size_t WS_HMID = 332 * MiB;
constexpr size_t WS_WDA = 492 * MiB;
#ifndef NEARLY_N
#define NEARLY_N 5
#endif
constexpr int NEARLY = NEARLY_N;
constexpr size_t WS_END = 502 * MiB;
constexpr size_t PREP_STRIDE = 98304;

struct Args { const float* in[18]; float* out; unsigned char* ws; int ph_lo, ph_hi; };

typedef __bf16 bf16v2_t __attribute__((ext_vector_type(2)));
__device__ __forceinline__ unsigned cvt_pk_bf16_asm(float lo, float hi) { unsigned r; asm volatile("v_cvt_pk_bf16_f32 %0, %1, %2" : "=v"(r) : "v"(lo), "v"(hi)); return r; }
__device__ __forceinline__ unsigned cvt_pk_bf16(float lo, float hi) { f32x2 f = {lo, hi}; return __builtin_bit_cast(unsigned, __builtin_convertvector(f, bf16v2_t)); }
constexpr float F8_ACT = 16.f, F8_WGT = 512.f;
constexpr float F8_DESCALE = 1.f / (F8_ACT * F8_WGT);
__device__ __forceinline__ void mfma_f8_acc(f32x4& c, const i32x8 a, const i32x8 b) { asm volatile("v_mfma_f32_16x16x128_f8f6f4 %0, %1, %2, %0" : "+v"(c) : "v"(a), "v"(b)); }
__device__ __forceinline__ float f8clamp(float v) { return __builtin_amdgcn_fmed3f(v, -448.f, 448.f); }
__device__ __forceinline__ unsigned pk4_fp8(float a, float b, float c, float d) { int w = 0; w = __builtin_amdgcn_cvt_pk_fp8_f32(f8clamp(a), f8clamp(b), w, false); w = __builtin_amdgcn_cvt_pk_fp8_f32(f8clamp(c), f8clamp(d), w, true); return (unsigned)w; }
__device__ __forceinline__ float bf2f(unsigned h) { return __uint_as_float(h << 16); }
__device__ __forceinline__ float bflo(unsigned w) { return __uint_as_float(w << 16); }
__device__ __forceinline__ float bfhi(unsigned w) { return __uint_as_float(w & 0xffff0000u); }
__device__ __forceinline__ float wave_sum(float v) {
#pragma unroll
    for (int o = 1; o < 64; o <<= 1) v += __shfl_xor(v, o);
    return v;
}
__device__ __forceinline__ int bitem(int vb, int k, int per) { return (vb & 7) * per + (vb >> 3) + 32 * k; }
__device__ __forceinline__ int tid_fresh() { int t = threadIdx.x; asm volatile("" : "+v"(t)); return t; }
__device__ __forceinline__ float silu_f(float x) { return x * __builtin_amdgcn_rcpf(1.f + __expf(-x)); }
__device__ __forceinline__ float sigmoid_f(float x) { return __builtin_amdgcn_rcpf(1.f + __expf(-x)); }
__device__ __forceinline__ float softplus_f(float x) { return fmaxf(x, 0.f) + log1pf(__expf(-fabsf(x))); }

namespace pg8 {
constexpr int BM = 256, BK = 64, HALF = 128, HTB = HALF * BK * 2, STAGE_BYTES = 8 * HTB, NXCD = 8, WGM = 8;
__host__ __device__ __forceinline__ int lds_byte(int r, int c) { const int st = (r >> 4) * 2 + (c >> 5), rr = r & 15, cc = c & 31, ob = rr * 64 + cc * 2; return st * 1024 + (ob ^ (((ob >> 9) & 1) << 5)); }
__host__ __device__ __forceinline__ void stage_rc(int b, int& R, int& C) { const int st = b / 1024, sb = b % 1024, swz = sb ^ (((sb >> 9) & 1) << 5); R = (st >> 1) * 16 + swz / 64; C = (st & 1) * 32 + (swz % 64) / 2; }
__host__ __device__ __forceinline__ int perm32(int rho) { const int n = rho >> 4, i = rho & 15; return 8 * (i >> 2) + 4 * n + (i & 3); }

struct Unit { int pm, pn; };
struct Gemm { const bf16_t* A; const bf16_t* Bt; int K; const int* gidx; };

struct StaticOrder {
    int nM, nN, nwg, G, c;
    __device__ void init(int M, int N, int G_, int c_) { nM = M / BM; nN = N / BM; nwg = nM * nN; G = G_; c = c_; }
    __device__ int pm_of(int) const { return 0; }
    __device__ bool next(int i, Unit& u) const {
        const long L = (long)i * G + c; if (L >= nwg) return false;
        int wgid = (int)L; { const int q = nwg / NXCD, r = nwg % NXCD, xcd = wgid % NXCD, off = wgid / NXCD; wgid = (xcd < r ? xcd * (q + 1) : r * (q + 1) + (xcd - r) * q) + off; }
        const int nig = WGM * nN, gid = wgid / nig, fm = gid * WGM, gsz = (nM - fm) < WGM ? (nM - fm) : WGM;
        u.pm = fm + ((wgid % nig) % gsz); u.pn = (wgid % nig) / gsz; return true;
    }
};
struct ExpertOrder {
    int x, b, pnq, ntile, rounds, rpe, early, eshift;
    __device__ void init(int c, int ntile_, int early_ = 0, int eshift_ = 0) { x = c & 7; const int j = c >> 3; b = j & 7; pnq = j >> 3; ntile = ntile_; rpe = ntile_ >> 2; rounds = 2 * rpe; early = early_; eshift = eshift_; }
    __device__ bool next(int i, Unit& u) const { if (i >= rounds) return false; const int e = 2 * x + (i / rpe); u.pm = b * NE + e; u.pn = e * ntile + 4 * (i % rpe) + pnq + (e < early ? eshift : 0); return true; }
    __device__ int pm_of(int k) const { return b * NE + 2 * x + k; }
};

template <class Epi, class Sched, bool GATHER = false, bool F8 = false>
__device__ __forceinline__ void gemm_phase(LAS unsigned char* lds, const Gemm g, const Sched& S, const Epi& E) {
    const int tid = tid_fresh(), wid = __builtin_amdgcn_readfirstlane(tid >> 6), lane = tid & 63, wr = wid >> 2, wc = wid & 3, fr = lane & 15, fq = lane >> 4;
    const int K = g.K, nt = K / BK;
    unsigned voffA[2], voffB[2];
#pragma unroll
    for (int i = 0; i < 2; ++i) { int R, C; stage_rc(tid * 16 + i * 8192, R, C); const int Rb = Epi::PERM ? ((R & ~31) + perm32(R & 31)) : R;
        voffA[i] = (unsigned)(R * K + C) * 2u; voffB[i] = (unsigned)(Rb * K + C) * 2u; }
    const size_t kstep = (size_t)(BK * 2);
    const size_t hstep = (size_t)HALF * K * 2;
    const size_t tstep = 2 * hstep;
    const size_t tstepA = GATHER ? 0 : tstep;
    unsigned tab[2][2][2];
    const int pmB = S.pm_of(1);
    if constexpr (GATHER) {
#pragma unroll
        for (int ei = 0; ei < 2; ++ei)
#pragma unroll
            for (int hf = 0; hf < 2; ++hf)
#pragma unroll
                for (int i = 0; i < 2; ++i) { int R, C; stage_rc(tid * 16 + i * 8192, R, C); tab[ei][hf][i] = (unsigned)(g.gidx[S.pm_of(ei) * BM + hf * HALF + R] * K + C) * 2u; }
    }
#define PG8_STAGE_A(bufoff, gbase, hf, ei) do { if constexpr (GATHER) { unsigned v_[2]; v_[0] = (ei) ? tab[1][hf][0] : tab[0][hf][0]; v_[1] = (ei) ? tab[1][hf][1] : tab[0][hf][1]; PG8_STAGE(bufoff, gbase, v_); } \
        else { PG8_STAGE(bufoff, (gbase) + (hf) * hstep, voffA); } } while (0)
    const unsigned ldsw = (unsigned)wid * 1024u;
    const int aoff = lds_byte(wr * 64 + fr, fq * 8), boff = lds_byte(wc * 32 + fr, fq * 8);
#define PG8_SA(b, h) (((b) * 2 + (h)) * HTB)
#define PG8_SB(b, h) ((4 + (b) * 2 + (h)) * HTB)
#define PG8_STAGE(bufoff, gbase, voff) do { _Pragma("unroll") for (int _i = 0; _i < 2; ++_i) \
        __builtin_amdgcn_global_load_lds((const unsigned*)((const char*)(gbase) + (voff)[_i]), (LAS unsigned*)(lds + (bufoff) + ldsw + _i * 8192), 16, 0, 0); } while (0)
#define PG8_LDA(dst, b, h) do { _Pragma("unroll") for (int m = 0; m < 4; ++m) _Pragma("unroll") for (int k = 0; k < 2; ++k) dst[m][k] = *(const LAS bf16x8*)(lds + PG8_SA(b, h) + aoff + m * 2048 + k * 1024); } while (0)
#define PG8_LDB(dst, b, h) do { _Pragma("unroll") for (int n = 0; n < 2; ++n) _Pragma("unroll") for (int k = 0; k < 2; ++k) dst[n][k] = *(const LAS bf16x8*)(lds + PG8_SB(b, h) + boff + n * 2048 + k * 1024); } while (0)
#define PG8_CAT(x) __builtin_shufflevector(__builtin_bit_cast(i32x4, (x)[0]), __builtin_bit_cast(i32x4, (x)[1]), 0, 1, 2, 3, 4, 5, 6, 7)
#define PG8_MMA(ai, bj, At, Bt) do { __builtin_amdgcn_s_setprio(1); _Pragma("unroll") for (int m = 0; m < 4; ++m) _Pragma("unroll") for (int n = 0; n < 2; ++n) { \
        if constexpr (F8) mfma_f8_acc(acc[ai][bj][m][n], PG8_CAT(Bt[n]), PG8_CAT(At[m])); \
        else { _Pragma("unroll") for (int k = 0; k < 2; ++k) acc[ai][bj][m][n] = __builtin_amdgcn_mfma_f32_16x16x32_bf16(Bt[n][k], At[m][k], acc[ai][bj][m][n], 0, 0, 0); } } \
        __builtin_amdgcn_s_setprio(0); } while (0)
#define PG8_WAIT_V(n) asm volatile("s_waitcnt vmcnt(" #n ")" ::: "memory")
#define PG8_WAIT_L(n) asm volatile("s_waitcnt lgkmcnt(" #n ")" ::: "memory")
#define PG8_BAR __builtin_amdgcn_s_barrier()
#define PG8_SCHED __builtin_amdgcn_sched_barrier(0)
    Unit cur, nxt; int ui = 0;
    if (!S.next(0, cur)) return;
    f32x4 acc[2][2][4][2];
#pragma unroll
    for (int a = 0; a < 2; ++a)
#pragma unroll
        for (int b = 0; b < 2; ++b)
#pragma unroll
            for (int m = 0; m < 4; ++m)
#pragma unroll
                for (int n = 0; n < 2; ++n) acc[a][b][m][n] = (f32x4){0.f, 0.f, 0.f, 0.f};
    bf16x8 At[4][2], B0[2][2], B1[2][2];
    const char* cA = (const char*)g.A + (size_t)cur.pm * tstepA; const char* cB = (const char*)g.Bt + (size_t)cur.pn * tstep;
    bool cur_ei = GATHER && cur.pm == pmB, nxt_ei = cur_ei;
    PG8_STAGE(PG8_SB(0, 0), cB, voffB); PG8_STAGE(PG8_SB(0, 1), cB + hstep, voffB); PG8_STAGE_A(PG8_SA(0, 0), cA, 0, cur_ei); PG8_STAGE_A(PG8_SA(0, 1), cA, 1, cur_ei);
    if (wr == 1) PG8_BAR;
    PG8_WAIT_V(2); PG8_BAR;
    PG8_STAGE(PG8_SB(1, 0), cB + kstep, voffB); PG8_STAGE_A(PG8_SA(1, 0), cA + kstep, 0, cur_ei); PG8_STAGE(PG8_SB(1, 1), cB + hstep + kstep, voffB);
    PG8_WAIT_V(6); PG8_BAR;
    for (;;) {
        const bool has_next = S.next(ui + 1, nxt);
        const char* nA = has_next ? (const char*)g.A + (size_t)nxt.pm * tstepA : cA; const char* nB = has_next ? (const char*)g.Bt + (size_t)nxt.pn * tstep : cB;
        nxt_ei = has_next ? (GATHER && nxt.pm == pmB) : cur_ei;
        for (int t = 0; t < nt; t += 2) {
            const bool last = (t == nt - 2);
            const char* a1 = cA + (size_t)(t + 1) * kstep;
            const char* a2 = last ? nA : cA + (size_t)(t + 2) * kstep; const char* b2 = last ? nB : cB + (size_t)(t + 2) * kstep;
            const char* a3 = a2 + kstep; const char* b3 = b2 + kstep;
            const bool e2 = last ? nxt_ei : cur_ei;
            PG8_LDB(B0, 0, 0); PG8_LDB(B1, 0, 1); PG8_SCHED; PG8_LDA(At, 0, 0); PG8_STAGE_A(PG8_SA(1, 1), a1, 1, cur_ei);
            PG8_WAIT_V(8); PG8_WAIT_L(0); PG8_BAR; PG8_MMA(0, 0, At, B0); PG8_MMA(0, 1, At, B1); PG8_BAR; PG8_SCHED;
            PG8_LDA(At, 0, 1); PG8_STAGE(PG8_SB(0, 0), b2, voffB); PG8_STAGE(PG8_SB(0, 1), b2 + hstep, voffB); PG8_STAGE_A(PG8_SA(0, 0), a2, 0, e2);
            PG8_WAIT_V(8); PG8_WAIT_L(0); PG8_BAR; PG8_MMA(1, 0, At, B0); PG8_MMA(1, 1, At, B1); PG8_BAR; PG8_SCHED;
            PG8_LDB(B0, 1, 0); PG8_LDB(B1, 1, 1); PG8_SCHED; PG8_LDA(At, 1, 0); PG8_STAGE_A(PG8_SA(0, 1), a2, 1, e2);
            PG8_WAIT_V(8); PG8_WAIT_L(0); PG8_BAR; PG8_MMA(0, 0, At, B0); PG8_MMA(0, 1, At, B1); PG8_BAR; PG8_SCHED;
            PG8_LDA(At, 1, 1); PG8_STAGE(PG8_SB(1, 0), b3, voffB); PG8_STAGE(PG8_SB(1, 1), b3 + hstep, voffB); PG8_STAGE_A(PG8_SA(1, 0), a3, 0, e2);
            PG8_WAIT_V(8); PG8_WAIT_L(0); PG8_BAR; PG8_MMA(1, 0, At, B0); PG8_MMA(1, 1, At, B1); PG8_BAR; PG8_SCHED;
        }
        if (wr == 0) PG8_BAR;
        if constexpr (F8) { asm volatile("s_nop 15\n\ts_nop 15" ::: "memory");
#pragma unroll
            for (int a = 0; a < 2; ++a)
#pragma unroll
                for (int b = 0; b < 2; ++b)
#pragma unroll
                    for (int m = 0; m < 4; ++m)
#pragma unroll
                        for (int n = 0; n < 2; ++n) asm volatile("" : "+v"(acc[a][b][m][n])); }
        E(acc, cur, wr, wc, fr, fq);
        if (!has_next) break;
#pragma unroll
        for (int a = 0; a < 2; ++a)
#pragma unroll
            for (int b = 0; b < 2; ++b)
#pragma unroll
                for (int m = 0; m < 4; ++m)
#pragma unroll
                    for (int n = 0; n < 2; ++n) acc[a][b][m][n] = (f32x4){0.f, 0.f, 0.f, 0.f};
        cur = nxt; cA = nA; cB = nB; cur_ei = nxt_ei; ++ui;
        if (wr == 1) PG8_BAR;
    }
    PG8_WAIT_V(0);
    PG8_BAR;
#undef PG8_SA
#undef PG8_SB
#undef PG8_STAGE
#undef PG8_STAGE_A
#undef PG8_LDA
#undef PG8_LDB
#undef PG8_MMA
#undef PG8_CAT
#undef PG8_WAIT_V
#undef PG8_WAIT_L
#undef PG8_BAR
#undef PG8_SCHED
}
struct EpiProj {
    static constexpr bool PERM = true;
    bf16_t* O; int ldc;
    __device__ __forceinline__ void operator()(const f32x4 (&acc)[2][2][4][2], const Unit& u, int wr, int wc, int fr, int fq) const {
        const int row0 = u.pm * BM + wr * 64 + fr, col0 = u.pn * BM + wc * 32 + 8 * fq;
#pragma unroll
        for (int ai = 0; ai < 2; ++ai)
#pragma unroll
            for (int m = 0; m < 4; ++m) { bf16_t* rowp = O + (size_t)(row0 + ai * HALF + m * 16) * ldc + col0;
#pragma unroll
                for (int bj = 0; bj < 2; ++bj) { const f32x4 v0 = acc[ai][bj][m][0], v1 = acc[ai][bj][m][1];
                    u32x4 w; w.x = cvt_pk_bf16_asm(v0[0], v0[1]); w.y = cvt_pk_bf16_asm(v0[2], v0[3]); w.z = cvt_pk_bf16_asm(v1[0], v1[1]); w.w = cvt_pk_bf16_asm(v1[2], v1[3]);
                    *(u32x4*)(rowp + bj * HALF) = w; } }
    }
};
struct EpiResid {
    static constexpr bool PERM = true;
    const float* base; bf16_t* C; int ldc; size_t bextra;
    __device__ __forceinline__ void operator()(const f32x4 (&acc)[2][2][4][2], const Unit& u, int wr, int wc, int fr, int fq) const {
        const int row0 = u.pm * BM + wr * 64 + fr, col0 = u.pn * BM + wc * 32 + 8 * fq;
#pragma unroll
        for (int ai = 0; ai < 2; ++ai)
#pragma unroll
            for (int m = 0; m < 4; ++m) { const size_t off = (size_t)(row0 + ai * HALF + m * 16) * ldc + col0;
#pragma unroll
                for (int bj = 0; bj < 2; ++bj) { const f32x4 b0 = __builtin_nontemporal_load((const f32x4*)(base + off + bj * HALF)), b1 = __builtin_nontemporal_load((const f32x4*)(base + off + bj * HALF + 4));
                    const f32x4 v0 = b0 + acc[ai][bj][m][0], v1 = b1 + acc[ai][bj][m][1];
                    u32x4 w; w.x = cvt_pk_bf16_asm(v0[0], v0[1]); w.y = cvt_pk_bf16_asm(v0[2], v0[3]); w.z = cvt_pk_bf16_asm(v1[0], v1[1]); w.w = cvt_pk_bf16_asm(v1[2], v1[3]);
                    *(u32x4*)(C + (size_t)(u.pm >> 3) * bextra + off + bj * HALF) = w; }
                asm volatile("" ::: "memory"); }
    }
};
struct EpiSwiglu {
    static constexpr bool PERM = true;
    unsigned char* O;
    __device__ __forceinline__ void operator()(const f32x4 (&acc)[2][2][4][2], const Unit& u, int wr, int wc, int fr, int fq) const {
        const int row0 = u.pm * BM + wr * 64 + fr, col0 = (u.pn & 15) * HALF + wc * 32 + 8 * fq;
#pragma unroll
        for (int ai = 0; ai < 2; ++ai)
#pragma unroll
            for (int m = 0; m < 4; ++m) { unsigned char* rowp = O + (size_t)(row0 + ai * HALF + m * 16) * FF + col0;
                float h[8];
#pragma unroll
                for (int n = 0; n < 2; ++n)
#pragma unroll
                    for (int j = 0; j < 4; ++j) { const float gt = acc[ai][0][m][n][j], up = acc[ai][1][m][n][j]; h[4 * n + j] = silu_f(gt * F8_DESCALE) * (up * (F8_DESCALE * F8_ACT)); }
                u32x2 w; w.x = pk4_fp8(h[0], h[1], h[2], h[3]); w.y = pk4_fp8(h[4], h[5], h[6], h[7]);
                *(u32x2*)rowp = w; }
    }
};
struct EpiDown {
    static constexpr bool PERM = true;
    unsigned char* O;
    __device__ __forceinline__ void operator()(const f32x4 (&acc)[2][2][4][2], const Unit& u, int wr, int wc, int fr, int fq) const {
        const int row0 = u.pm * BM + wr * 64 + fr, col0 = (u.pn & 3) * BM + wc * 32 + 8 * fq;
#pragma unroll
        for (int ai = 0; ai < 2; ++ai)
#pragma unroll
            for (int m = 0; m < 4; ++m) { unsigned char* rowp = O + (size_t)(row0 + ai * HALF + m * 16) * D + col0;
#pragma unroll
                for (int bj = 0; bj < 2; ++bj) { const f32x4 v0 = acc[ai][bj][m][0] * (F8_DESCALE * F8_ACT), v1 = acc[ai][bj][m][1] * (F8_DESCALE * F8_ACT);
                    u32x2 w; w.x = pk4_fp8(v0[0], v0[1], v0[2], v0[3]); w.y = pk4_fp8(v1[0], v1[1], v1[2], v1[3]);
                    *(u32x2*)(rowp + bj * HALF) = w; } }
    }
};
}

__device__ __forceinline__ void transpose_item(const float* W, int ld, int k0, int n0, bf16_t* WT, size_t dst_row0, int ldt, LAS float* scr, int lane) {
#pragma unroll 8
    for (int i = 0; i < 32; ++i) { const int kk = 2 * i + (lane >> 5); scr[kk * 33 + (lane & 31)] = __builtin_nontemporal_load(W + (size_t)(k0 + kk) * ld + n0 + (lane & 31)); }
    asm volatile("s_waitcnt lgkmcnt(0)" ::: "memory");
    const int c = lane & 7;
#pragma unroll
    for (int j = 0; j < 4; ++j) { const int n = (lane >> 3) + 8 * j; const LAS float* s = scr + (8 * c) * 33 + n;
        u32x4 o; o.x = cvt_pk_bf16(s[0 * 33], s[1 * 33]); o.y = cvt_pk_bf16(s[2 * 33], s[3 * 33]); o.z = cvt_pk_bf16(s[4 * 33], s[5 * 33]); o.w = cvt_pk_bf16(s[6 * 33], s[7 * 33]);
        *(u32x4*)(WT + (dst_row0 + n) * (size_t)ldt + k0 + 8 * c) = o; }
    asm volatile("s_waitcnt lgkmcnt(0)" ::: "memory");
}

__device__ __forceinline__ void transpose_item8(const float* W, int ld, int k0, int n0, unsigned char* WT, size_t dst_row0, int ldt, LAS float* scr, int lane) {
#pragma unroll 8
    for (int i = 0; i < 32; ++i) { const int kk = 2 * i + (lane >> 5); scr[kk * 33 + (lane & 31)] = __builtin_nontemporal_load(W + (size_t)(k0 + kk) * ld + n0 + (lane & 31)); }
    asm volatile("s_waitcnt lgkmcnt(0)" ::: "memory");
    const int c = lane & 3;
#pragma unroll
    for (int j = 0; j < 2; ++j) { const int n = (lane >> 2) + 16 * j; const LAS float* s = scr + (16 * c) * 33 + n;
        u32x4 o;
        o.x = pk4_fp8(s[0 * 33] * F8_WGT, s[1 * 33] * F8_WGT, s[2 * 33] * F8_WGT, s[3 * 33] * F8_WGT); o.y = pk4_fp8(s[4 * 33] * F8_WGT, s[5 * 33] * F8_WGT, s[6 * 33] * F8_WGT, s[7 * 33] * F8_WGT);
        o.z = pk4_fp8(s[8 * 33] * F8_WGT, s[9 * 33] * F8_WGT, s[10 * 33] * F8_WGT, s[11 * 33] * F8_WGT); o.w = pk4_fp8(s[12 * 33] * F8_WGT, s[13 * 33] * F8_WGT, s[14 * 33] * F8_WGT, s[15 * 33] * F8_WGT);
        *(u32x4*)(WT + (dst_row0 + n) * (size_t)ldt + k0 + 16 * c) = o; }
    asm volatile("s_waitcnt lgkmcnt(0)" ::: "memory");
}

#define MFMA16(A, B, C) __builtin_amdgcn_mfma_f32_16x16x32_bf16(A, B, C, 0, 0, 0)
template <int MODE>
__device__ __forceinline__ void row_pass(const Args& a, LAS unsigned char* lds, int vb) {
    const int tid = tid_fresh(), lane = tid & 63, wave = __builtin_amdgcn_readfirstlane(tid >> 6), l15 = lane & 15, l4 = lane >> 4;
    const float* src = a.in[0]; const bf16_t* srcb = (const bf16_t*)(a.ws + WS_HB);
    const float* nw = MODE == 0 ? a.in[1] : a.in[12];
    const float* wsm = MODE == 0 ? a.in[2] + 2048 : a.in[13];
    const int ld = MODE == 0 ? INC : NE;
    bf16_t* dst = (bf16_t*)(a.ws + WS_XN);
    float* aux = (float*)(a.ws + (MODE == 0 ? WS_GATES : WS_PROBS));
    bf16x8 wh[4], wl[4];
#pragma unroll
    for (int ks = 0; ks < 4; ++ks) { float f[8];
#pragma unroll
        for (int j = 0; j < 8; ++j) f[j] = wsm[(size_t)(128 * wave + 32 * ks + 8 * l4 + j) * ld + l15];
        unsigned hw[4], lw[4];
#pragma unroll
        for (int j = 0; j < 4; ++j) { hw[j] = cvt_pk_bf16(f[2 * j], f[2 * j + 1]); lw[j] = cvt_pk_bf16(f[2 * j] - bflo(hw[j]), f[2 * j + 1] - bfhi(hw[j])); }
        u32x4 hv = (u32x4){hw[0], hw[1], hw[2], hw[3]}, lv = (u32x4){lw[0], lw[1], lw[2], lw[3]};
        wh[ks] = __builtin_bit_cast(bf16x8, hv); wl[ks] = __builtin_bit_cast(bf16x8, lv); }
    const f32x4* nw4 = (const f32x4*)nw + lane;
    f32x4 w4[4];
#pragma unroll
    for (int j = 0; j < 4; ++j) w4[j] = nw4[64 * j];
    const int ec = tid & 15;
    float alog = 0.f, dtb = 0.f;
    if (MODE == 0) { const int h = ec & 3; if (ec < 4) { alog = a.in[4][h]; dtb = a.in[5][h]; } else if (ec >= 8 && ec < 12) { alog = a.in[6][h]; dtb = a.in[7][h]; } }
    constexpr int NGRP = MTOK / 16;
    const bool bmap = MODE == 1 && gridDim.x == 256;
#define RP_GRP(k) (bmap ? bitem(vb, (k), 128) : (int)blockIdx.x + (k) * (int)gridDim.x)
#define RP_HBX(r_) (MODE == 1 ? (size_t)((r_) >> 11) * HB_BEXTRA : (size_t)0)
#define RP_XH(bf_) (lds + (bf_) * 73728)
#define RP_XL(bf_) (lds + (bf_) * 73728 + 32768)
#define RP_PART(bf_) ((LAS float*)(lds + (bf_) * 73728 + 65536))
    f32x4 vn[2][4];
#define RP_LOADN(k_) do { _Pragma("unroll") for (int q = 0; q < 2; ++q) { const size_t r_ = (size_t)(16 * RP_GRP(k_) + 2 * wave + q); \
        _Pragma("unroll") for (int j = 0; j < 4; ++j) { if (MODE == 0) vn[q][j] = __builtin_nontemporal_load((const f32x4*)(src + r_ * D) + lane + 64 * j); \
            else { const u32x2 w_ = ((const u32x2*)(srcb + r_ * D + RP_HBX(r_)) + lane)[64 * j]; vn[q][j] = (f32x4){bflo(w_.x), bfhi(w_.x), bflo(w_.y), bfhi(w_.y)}; } } } } while (0)
#define RP_NORM(grp_, bf_) do { _Pragma("unroll") for (int q = 0; q < 2; ++q) { const int lr = 2 * wave + q, row = 16 * (grp_) + lr; float ss = 0.f; \
        _Pragma("unroll") for (int j = 0; j < 4; ++j) ss += (v[q][j].x * v[q][j].x + v[q][j].y * v[q][j].y) + (v[q][j].z * v[q][j].z + v[q][j].w * v[q][j].w); \
        const float r = rsqrtf(wave_sum(ss) * (1.f / D) + EPS); \
        u32x2* o8 = (u32x2*)(dst + (size_t)row * D) + lane; \
        _Pragma("unroll") for (int j = 0; j < 4; ++j) { const f32x4 y = v[q][j] * r * w4[j]; u32x2 hw, lw; hw.x = cvt_pk_bf16(y.x, y.y); hw.y = cvt_pk_bf16(y.z, y.w); \
            lw.x = cvt_pk_bf16(y.x - bflo(hw.x), y.y - bfhi(hw.x)); lw.y = cvt_pk_bf16(y.z - bflo(hw.y), y.w - bfhi(hw.y)); \
            if (MODE == 0) o8[64 * j] = hw; else ((unsigned*)(a.ws + WS_XN2 + (size_t)(row + (row >> 11) * 2048) * D) + lane)[64 * j] = pk4_fp8(y.x * F8_ACT, y.y * F8_ACT, y.z * F8_ACT, y.w * F8_ACT); \
            const int off = lr * 2048 + ((((lane >> 1) + 32 * j) ^ lr) << 4) + 8 * (lane & 1);         \
            *(LAS u32x2*)(RP_XH(bf_) + off) = hw; *(LAS u32x2*)(RP_XL(bf_) + off) = lw; } } } while (0)
    const int ngk = bmap ? 4 : (NGRP + (int)gridDim.x - 1 - (int)blockIdx.x) / (int)gridDim.x;
    f32x4 v[2][4];
    if (ngk > 0) { RP_LOADN(0);
#pragma unroll
        for (int q = 0; q < 2; ++q)
#pragma unroll
            for (int j = 0; j < 4; ++j) v[q][j] = vn[q][j];
        if (1 < ngk) RP_LOADN(1);
        RP_NORM(RP_GRP(0), 0); }
    __syncthreads();
    for (int gk = 0; gk < ngk; ++gk) { const int grp = RP_GRP(gk), bf = gk & 1;
        f32x4 acc = (f32x4){0.f, 0.f, 0.f, 0.f};
#pragma unroll
        for (int ks = 0; ks < 4; ++ks) { const int off = l15 * 2048 + (((16 * wave + 4 * ks + l4) ^ l15) << 4);
            const bf16x8 xh = *(const LAS bf16x8*)(RP_XH(bf) + off), xl = *(const LAS bf16x8*)(RP_XL(bf) + off);
            acc = MFMA16(xh, wh[ks], acc); acc = MFMA16(xh, wl[ks], acc); acc = MFMA16(xl, wh[ks], acc); }
#pragma unroll
        for (int r4 = 0; r4 < 4; ++r4) RP_PART(bf)[(wave * 16 + 4 * l4 + r4) * 16 + l15] = acc[r4];
        if (gk + 1 < ngk) {
#pragma unroll
            for (int q = 0; q < 2; ++q)
#pragma unroll
                for (int j = 0; j < 4; ++j) v[q][j] = vn[q][j];
            if (gk + 2 < ngk) RP_LOADN(gk + 2);
            RP_NORM(RP_GRP(gk + 1), bf ^ 1); }
        __syncthreads();
        if (tid < 256) { float s = 0.f;
#pragma unroll
            for (int w8 = 0; w8 < 8; ++w8) s += RP_PART(bf)[w8 * 256 + tid];
            float res;
            if (MODE == 0) { if (ec < 4 || (ec >= 8 && ec < 12)) res = -__expf(alog) * softplus_f(s + dtb); else res = sigmoid_f(s); }
            else { float mx = s;
#pragma unroll
                for (int o = 1; o < 16; o <<= 1) mx = fmaxf(mx, __shfl_xor(mx, o));
                const float e = __expf(s - mx); float sm = e;
#pragma unroll
                for (int o = 1; o < 16; o <<= 1) sm += __shfl_xor(sm, o);
                res = e / sm; }
            aux[(size_t)(16 * grp) * 16 + tid] = res; }
    }
    __syncthreads();
#undef RP_XH
#undef RP_XL
#undef RP_PART
#undef RP_LOADN
#undef RP_NORM
}

__device__ __forceinline__ void ph_prologue(const Args& a, LAS unsigned char* lds) {
    const int tid = tid_fresh(), lane = tid & 63, wave = tid >> 6;
    LAS float* scr = (LAS float*)(lds + wave * 8704);
    const int gw = blockIdx.x * NWAVE + wave, NGW = gridDim.x * NWAVE;
    bf16_t* Win = (bf16_t*)(a.ws + WS_WIN); bf16_t* Wmix = (bf16_t*)(a.ws + WS_WMIX);
    f32x4 pa0[4][2]; float wsc0[4];
    { const int task0 = (int)blockIdx.x & 255, g0 = task0 >> 6, n00 = (task0 & 63) * 16;
      const f32x4* pr = (const f32x4*)(a.in[9] + (size_t)g0 * 16384 + (size_t)(16 * wave + (lane & 15)) * 128 + 8 * (lane >> 4));
#pragma unroll
      for (int ks = 0; ks < 4; ++ks) { pa0[ks][0] = pr[8 * ks]; pa0[ks][1] = pr[8 * ks + 1]; }
#pragma unroll
      for (int k4 = 0; k4 < 4; ++k4) { const int idx = tid + NTHR * k4, d = idx >> 4, n = idx & 15; wsc0[k4] = a.in[11][(size_t)(512 + 128 * g0 + d) * D + n00 + n] * a.in[10][128 * g0 + d]; } }
    constexpr int I_A = 16 * 64, I_B = 16 * 16, I_C = 8 * 32;
    for (int it = gw; it < I_A + I_B + I_C; it += NGW) {
        int r = it;
        if (r < I_A) { const int kb = r / 64, nb = r % 64; transpose_item(a.in[2], INC, 64 * kb, 32 * nb, Win, (size_t)32 * nb, D, scr, lane); continue; } r -= I_A;
        if (r < I_B) { const int kb = r / 16, nb = r % 16; transpose_item(a.in[2] + 2064, INC, 64 * kb, 32 * nb, Win, (size_t)2048 + 32 * nb, D, scr, lane); continue; } r -= I_B;
        { const int kb = r / 32, nb = r % 32; transpose_item(a.in[11], D, 64 * kb, 32 * nb, Wmix, (size_t)32 * nb, D, scr, lane); }
    }
    __syncthreads();
    for (int task = blockIdx.x; task < 256; task += gridDim.x) {
        const int g = task >> 6, n0 = (task & 63) * 16;
        const int l15 = lane & 15, l4 = lane >> 4;
        LAS unsigned short* WH = (LAS unsigned short*)lds;
        LAS unsigned short* WL = (LAS unsigned short*)(lds + 8192);
        f32x4 pa[4][2];
        const bool first = task == ((int)blockIdx.x & 255);
        if (first) {
#pragma unroll
            for (int ks = 0; ks < 4; ++ks) { pa[ks][0] = pa0[ks][0]; pa[ks][1] = pa0[ks][1]; }
        } else { const f32x4* pr = (const f32x4*)(a.in[9] + (size_t)g * 16384 + (size_t)(16 * wave + l15) * 128 + 8 * l4);
#pragma unroll
          for (int ks = 0; ks < 4; ++ks) { pa[ks][0] = pr[8 * ks]; pa[ks][1] = pr[8 * ks + 1]; } }
#pragma unroll
        for (int k4 = 0; k4 < 4; ++k4) { const int idx = tid + NTHR * k4, d = idx >> 4, n = idx & 15; const float w = first ? wsc0[k4] : a.in[11][(size_t)(512 + 128 * g + d) * D + n0 + n] * a.in[10][128 * g + d];
            const unsigned h2 = cvt_pk_bf16(w, 0.f), l2 = cvt_pk_bf16(w - bflo(h2), 0.f); WH[n * 136 + d] = (unsigned short)h2; WL[n * 136 + d] = (unsigned short)l2; }
        __syncthreads();
        f32x4 acc = (f32x4){0.f, 0.f, 0.f, 0.f};
#pragma unroll
        for (int ks = 0; ks < 4; ++ks) { const float f[8] = {pa[ks][0].x, pa[ks][0].y, pa[ks][0].z, pa[ks][0].w, pa[ks][1].x, pa[ks][1].y, pa[ks][1].z, pa[ks][1].w};
            unsigned hw[4], lw[4];
#pragma unroll
            for (int q = 0; q < 4; ++q) { hw[q] = cvt_pk_bf16(f[2 * q], f[2 * q + 1]); lw[q] = cvt_pk_bf16(f[2 * q] - bflo(hw[q]), f[2 * q + 1] - bfhi(hw[q])); }
            const bf16x8 ah = __builtin_bit_cast(bf16x8, (u32x4){hw[0], hw[1], hw[2], hw[3]}), al = __builtin_bit_cast(bf16x8, (u32x4){lw[0], lw[1], lw[2], lw[3]});
            const bf16x8 bh = *(const LAS bf16x8*)(WH + l15 * 136 + 32 * ks + 8 * l4), bl = *(const LAS bf16x8*)(WL + l15 * 136 + 32 * ks + 8 * l4);
            acc = MFMA16(ah, bh, acc); acc = MFMA16(ah, bl, acc); acc = MFMA16(al, bh, acc); }
        u32x2 o; o.x = cvt_pk_bf16(acc[0], acc[1]); o.y = cvt_pk_bf16(acc[2], acc[3]);
        *(u32x2*)(Wmix + (size_t)(n0 + l15) * D + 512 + 128 * g + 16 * wave + 4 * l4) = o;
        __syncthreads();
    }
    __syncthreads();
    row_pass<0>(a, lds, (int)blockIdx.x);
}

constexpr int CVT_ITEMS = NEARLY * 2048 + (NE - NEARLY) * 3072;
#ifndef CVT_TAIL
#define CVT_TAIL 8192
#endif
#ifndef CVT_SOLO
#define CVT_SOLO (CVT_SPLIT - 4096)
#endif
constexpr int CVT_SPLIT = CVT_ITEMS - CVT_TAIL;
#ifndef P5_GEMM_WGS
#define P5_GEMM_WGS 128
#endif
struct CvtItem { const float* src; unsigned char* dst; int ld, ldt; };
template <bool EARLY>
__device__ __forceinline__ void cvt_decode(const Args& a, int it, CvtItem& c) {
    if (EARLY) { const int e = it >> 10, q = it & 1023, kb = q >> 5, nb = q & 31;
        c.src = a.in[16] + (size_t)e * FF * D + (size_t)(64 * kb) * D + 32 * nb; c.ld = D; c.ldt = FF; c.dst = a.ws + WS_WDA + ((size_t)e * 1024 + 32 * nb) * FF + 64 * kb; return; }
    int e, r;
    if (it < NEARLY * 2048) { e = it >> 11; r = it & 2047; } else { const int o = it - NEARLY * 2048; e = NEARLY + o / 3072; r = o % 3072; }
    const int which = r >> 10, q = r & 1023;
    if (which < 2) { const int kb = q >> 6, nb = q & 63, f0 = 32 * nb;
        c.src = (which == 0 ? a.in[14] : a.in[15]) + (size_t)e * D * FF + (size_t)(64 * kb) * FF + f0; c.ld = FF; c.ldt = D;
        c.dst = a.ws + WS_WGU + ((size_t)e * 4096 + (f0 >> 7) * 256 + which * 128 + (f0 & 127)) * D + 64 * kb; return; }
    const int kb = q >> 5, nb = q & 31;
    c.src = a.in[16] + (size_t)e * FF * D + (size_t)(64 * kb) * D + 32 * nb; c.ld = D; c.ldt = FF; c.dst = a.ws + WS_WD + ((size_t)e * 1024 + 32 * nb) * FF + 64 * kb;
}
template <bool EARLY>
__device__ __forceinline__ void expert_weight_cvt(const Args& a, LAS unsigned char* lds, int it_lo, int it_hi, int wg0, int nwg, int bid) {
    const int tid = tid_fresh(), lane = tid & 63, wave = tid >> 6;
    LAS float* scr = (LAS float*)(lds + wave * 8704);
    const int gw = (bid - wg0) * NWAVE + wave, NGW = nwg * NWAVE;
    if (bid < wg0 || bid >= wg0 + nwg) return;
    const int lrow = lane >> 5, lcol = lane & 31, c4 = lane & 3, n4 = lane >> 2;
#define CVT_LOAD(V_, item_) do { const float* p_ = (item_).src + (size_t)lrow * (item_).ld + lcol; \
        _Pragma("unroll") for (int i = 0; i < 32; ++i) V_[i] = __builtin_nontemporal_load(p_ + (size_t)(2 * i) * (item_).ld); } while (0)
#define CVT_PARK(V_) do { _Pragma("unroll") for (int i = 0; i < 32; ++i) scr[(2 * i + lrow) * 33 + lcol] = V_[i]; } while (0)
#define CVT_PROC(item_) do { asm volatile("s_waitcnt lgkmcnt(0)" ::: "memory"); \
        _Pragma("unroll") for (int j = 0; j < 2; ++j) { const int n = n4 + 16 * j; const LAS float* s = scr + (16 * c4) * 33 + n; \
            u32x4 o; \
            o.x = pk4_fp8(s[0 * 33] * F8_WGT, s[1 * 33] * F8_WGT, s[2 * 33] * F8_WGT, s[3 * 33] * F8_WGT); o.y = pk4_fp8(s[4 * 33] * F8_WGT, s[5 * 33] * F8_WGT, s[6 * 33] * F8_WGT, s[7 * 33] * F8_WGT); \
            o.z = pk4_fp8(s[8 * 33] * F8_WGT, s[9 * 33] * F8_WGT, s[10 * 33] * F8_WGT, s[11 * 33] * F8_WGT); o.w = pk4_fp8(s[12 * 33] * F8_WGT, s[13 * 33] * F8_WGT, s[14 * 33] * F8_WGT, s[15 * 33] * F8_WGT); \
            *(u32x4*)((item_).dst + (size_t)n * (item_).ldt + 16 * c4) = o; } \
        asm volatile("s_waitcnt lgkmcnt(0)" ::: "memory"); } while (0)
    CvtItem ia, ib, in_; int ita = it_lo + gw, itb = ita + NGW;
    if (ita >= it_hi) return;
    bool hasB = itb < it_hi;
    float va[32], vb[32];
    cvt_decode<EARLY>(a, ita, ia); CVT_LOAD(va, ia);
    if (hasB) { cvt_decode<EARLY>(a, itb, ib); CVT_LOAD(vb, ib); }
    for (;;) {
        bool moreA;
        { const int nit = ita + 2 * NGW; moreA = nit < it_hi; if (moreA) cvt_decode<EARLY>(a, nit, in_);
          CVT_PARK(va); if (moreA) CVT_LOAD(va, in_);
          CVT_PROC(ia);
          if (moreA) { ia = in_; ita = nit; } }
        if (!hasB) break;
        { const int nit = itb + 2 * NGW; const bool moreB = nit < it_hi; if (moreB) cvt_decode<EARLY>(a, nit, in_);
          CVT_PARK(vb); if (moreB) CVT_LOAD(vb, in_);
          CVT_PROC(ib);
          if (moreB) { ib = in_; itb = nit; } hasB = moreB; }
        if (!moreA) break;
    }
#undef CVT_LOAD
#undef CVT_PARK
#undef CVT_PROC
}

__device__ __forceinline__ int a128(int row, int col) { return row * 256 + ((((col >> 3) ^ (row & 15))) << 4) + ((col & 7) << 1); }
__device__ __forceinline__ int a64(int row, int col) { return row * 128 + ((((col >> 3) ^ ((row >> 1) & 7))) << 4) + ((col & 7) << 1); }
__device__ __forceinline__ bf16x8 frag128(LAS unsigned char* base, int row0, int k0, int lane) { return *(const LAS bf16x8*)(base + a128(row0 + (lane & 15), k0 + ((lane >> 4) << 3))); }
__device__ __forceinline__ bf16x8 frag64(LAS unsigned char* base, int row0, int k0, int lane) { return *(const LAS bf16x8*)(base + a64(row0 + (lane & 15), k0 + ((lane >> 4) << 3))); }
__device__ __forceinline__ u32x2 pack4(f32x4 v) { u32x2 w; w.x = cvt_pk_bf16(v[0], v[1]); w.y = cvt_pk_bf16(v[2], v[3]); return w; }

template <bool FRAG>
__device__ __forceinline__ void staged_store_16x64(LAS unsigned char* stg, const f32x4 (&t)[4], unsigned char* gmat, int tile16, int half, int lane) {
    const int l15 = lane & 15, l4 = lane >> 4;
#pragma unroll
    for (int k = 0; k < 4; ++k) *(LAS u32x2*)(stg + l15 * 128 + (((2 * k + (l4 >> 1)) ^ (l15 & 7)) << 4) + 8 * (l4 & 1)) = pack4(t[k]);
#pragma unroll
    for (int q = 0; q < 2; ++q) { const int idx = lane + 64 * q, row = idx >> 3, c = idx & 7;
        const u32x4 v = *(const LAS u32x4*)(stg + row * 128 + ((c ^ (row & 7)) << 4));
        const size_t off = FRAG ? (size_t)(tile16 * 4 + 2 * half + (c >> 2)) * 1024 + row * 64 + (c & 3) * 16
                                : (size_t)(tile16 * 8 + 4 * half + (c >> 1)) * 512 + row * 32 + (c & 1) * 16;
        *(u32x4*)(gmat + off) = v; }
}
constexpr int L_QM = 0, L_KM = 16384, L_KT = 32768, L_VT = 49152, L_WT = 114688, L_UT = 131072, L_SM = 147456;
#define L_PD(d)  (65536 + (d) * 24576)
#define L_PTD(d) (65536 + (d) * 24576 + 8192)
#define L_PQD(d) (65536 + (d) * 24576 + 16384)
#define L_TD(d)  (114688 + (d) * 8192)
__device__ __forceinline__ void ph_chunk_prep(const Args& a, LAS unsigned char* lds, int vb) {
    const int tid0 = tid_fresh(), wave = __builtin_amdgcn_readfirstlane(tid0 >> 6);
    if (wave >= 4) __builtin_amdgcn_s_setprio(1);
    const bf16_t* proj = (const bf16_t*)(a.ws + WS_PROJ);
    const float* gates = (const float*)(a.ws + WS_GATES);
    float* eglp = (float*)(a.ws + WS_EGL);
    LAS float* sm = (LAS float*)(lds + L_SM);
    const int tn = wave & 3, tm0 = 2 * (wave >> 2);
#define SEG_LANE() int tid = tid0; asm volatile("" : "+v"(tid)); const int lane = tid & 63, l15 = lane & 15, l4 = lane >> 4, ra = 16 * tn + l15; (void)l4; (void)ra; (void)lane
    u32x4 raw[3][6]; float graw[4];
#define PREP_FETCH(task_) do { const int n_ = (task_) & 31, h_ = ((task_) >> 5) & 3, b_ = (task_) >> 7; int tidf = tid0; asm volatile("" : "+v"(tidf)); \
        const int cch_ = tidf & 15, i0_ = 2 * (tidf >> 4); \
        _Pragma("unroll") for (int mtx = 0; mtx < 3; ++mtx) _Pragma("unroll") for (int jj = 0; jj < 6; ++jj) { const int tl_ = n_ * 64 + i0_ - 2 + jj; \
            raw[mtx][jj] = (u32x4){0u, 0u, 0u, 0u}; \
            if (tl_ >= 0 && tl_ < T) raw[mtx][jj] = *(const u32x4*)(proj + (size_t)(b_ * T + tl_) * NPROJ + mtx * 512 + h_ * HD + 8 * cch_); } \
        if (wave == 0) { const float* gp_ = gates + (size_t)(b_ * T + n_ * 64 + (tidf & 63)) * 16; graw[0] = gp_[h_]; graw[1] = gp_[4 + h_]; graw[2] = gp_[8 + h_]; graw[3] = gp_[12 + h_]; } } while (0)
    const bool bmap = gridDim.x == 256;
    const int ntk = bmap ? 4 : (NB * NH * NCH + (int)gridDim.x - 1 - (int)blockIdx.x) / (int)gridDim.x;
#define CP_TASK(k) (bmap ? bitem(vb, (k), 128) : (int)blockIdx.x + (k) * (int)gridDim.x)
    if (ntk > 0) PREP_FETCH(CP_TASK(0));
    for (int tk_ = 0; tk_ < ntk; ++tk_) { const int task = CP_TASK(tk_);
        const int n = task & 31, h = (task >> 5) & 3, b = task >> 7;
        { SEG_LANE();
        if (wave == 0) {
            const float gf = graw[0], bfv = graw[1], gb = graw[2], bbv = graw[3];
            float pf = gf, pb = gb;
#pragma unroll
            for (int o = 1; o < 64; o <<= 1) { const float tf = __shfl_up(pf, o), tb = __shfl_up(pb, o); if (lane >= o) { pf += tf; pb += tb; } }
            const float totb = __shfl(pb, 63);
            sm[lane] = pf; sm[64 + lane] = totb - pb + gb; sm[128 + lane] = bfv; sm[192 + lane] = bbv;
        }
        {
            const int cch = tid & 15, rp = tid >> 4, i0 = 2 * rp;
#pragma unroll
            for (int mtx = 0; mtx < 3; ++mtx) {
                const int colb = mtx * 512 + h * HD + 8 * cch;
                float in[6][8];
#pragma unroll
                for (int jj = 0; jj < 6; ++jj) { const u32x4 w = raw[mtx][jj];
                    in[jj][0] = bflo(w.x); in[jj][1] = bfhi(w.x); in[jj][2] = bflo(w.y); in[jj][3] = bfhi(w.y); in[jj][4] = bflo(w.z); in[jj][5] = bfhi(w.z); in[jj][6] = bflo(w.w); in[jj][7] = bfhi(w.w); }
                float val[2][8];
#pragma unroll
                for (int r = 0; r < 2; ++r)
#pragma unroll
                    for (int e = 0; e < 8; ++e) val[r][e] = 0.f;
#pragma unroll
                for (int j = 0; j < 5; ++j) { const f32x4 c0 = *(const f32x4*)(a.in[3] + (size_t)j * 1536 + colb), c1 = *(const f32x4*)(a.in[3] + (size_t)j * 1536 + colb + 4);
#pragma unroll
                    for (int r = 0; r < 2; ++r) {
#pragma unroll
                        for (int e = 0; e < 4; ++e) { val[r][e] += in[r + j][e] * c0[e]; val[r][4 + e] += in[r + j][4 + e] * c1[e]; } } }
#pragma unroll
                for (int r = 0; r < 2; ++r) { float ss = 0.f;
#pragma unroll
                    for (int e = 0; e < 8; ++e) { val[r][e] = silu_f(val[r][e]); ss += val[r][e] * val[r][e]; }
                    if (mtx < 2) { ss += __shfl_xor(ss, 1); ss += __shfl_xor(ss, 2); ss += __shfl_xor(ss, 4); ss += __shfl_xor(ss, 8);
                        const float sc = rsqrtf(ss + EPS) * (mtx == 0 ? 0.08838834764831845f : 1.f);
#pragma unroll
                        for (int e = 0; e < 8; ++e) val[r][e] *= sc; } }
                if (mtx < 2) {
#pragma unroll
                    for (int r = 0; r < 2; ++r) { u32x4 w; w.x = cvt_pk_bf16(val[r][0], val[r][1]); w.y = cvt_pk_bf16(val[r][2], val[r][3]); w.z = cvt_pk_bf16(val[r][4], val[r][5]); w.w = cvt_pk_bf16(val[r][6], val[r][7]);
                        *(LAS u32x4*)(lds + (mtx == 0 ? L_QM : L_KM) + a128(i0 + r, 8 * cch)) = w; } }
                if (mtx >= 1) {
#pragma unroll
                    for (int e = 0; e < 8; ++e) *(LAS unsigned*)(lds + (mtx == 1 ? L_KT : L_VT) + a64(8 * cch + e, i0)) = cvt_pk_bf16(val[0][e], val[1][e]); }
            }
        }
        }
        if (tk_ + 1 < ntk) PREP_FETCH(CP_TASK(tk_ + 1));
        __syncthreads();
        { SEG_LANE();
            f32x4 kk[2] = {(f32x4){0, 0, 0, 0}, (f32x4){0, 0, 0, 0}}, qk[2] = {(f32x4){0, 0, 0, 0}, (f32x4){0, 0, 0, 0}};
#pragma unroll
            for (int ks = 0; ks < 4; ++ks) { const bf16x8 yk = frag128(lds + L_KM, 16 * tn, 32 * ks, lane), yq = frag128(lds + L_QM, 16 * tn, 32 * ks, lane);
#pragma unroll
                for (int t2 = 0; t2 < 2; ++t2) { const bf16x8 xk = frag128(lds + L_KM, 16 * (tm0 + t2), 32 * ks, lane);
                    kk[t2] = MFMA16(xk, yk, kk[t2]); qk[t2] = MFMA16(xk, yq, qk[t2]); } }
#pragma unroll
            for (int dir = 0; dir < 2; ++dir) {
                LAS float* gc = sm + 64 * dir; LAS float* bet = sm + 128 + 64 * dir;
                const float gca = gc[ra], ba = bet[ra];
#pragma unroll
                for (int t2 = 0; t2 < 2; ++t2) { const int rb0 = 16 * (tm0 + t2) + 4 * l4;
                    f32x4 pv, ptv, pqv, tv;
#pragma unroll
                    for (int r = 0; r < 4; ++r) { const int rb = rb0 + r; const float gcb = gc[rb], bb = bet[rb];
                        const bool st_ab = dir ? (rb > ra) : (rb < ra), st_ba = dir ? (ra > rb) : (ra < rb), in_ab = st_ab || (rb == ra);
                        const float dab = __expf(fminf(gca - gcb, 0.f)), dba = __expf(fminf(gcb - gca, 0.f));
                        pv[r] = st_ab ? ba * kk[t2][r] * dab : 0.f;
                        ptv[r] = st_ba ? bb * kk[t2][r] * dba : 0.f;
                        pqv[r] = in_ab ? qk[t2][r] * dab : 0.f;
                        tv[r] = (rb == ra ? 1.f : 0.f) - pv[r]; }
                    *(LAS u32x2*)(lds + L_PD(dir) + a64(ra, rb0)) = pack4(pv);
                    *(LAS u32x2*)(lds + L_PTD(dir) + a64(ra, rb0)) = pack4(ptv);
                    *(LAS u32x2*)(lds + L_PQD(dir) + a64(ra, rb0)) = pack4(pqv);
                    *(LAS u32x2*)(lds + L_TD(dir) + a64(ra, rb0)) = pack4(tv); }
            }
        }
        __syncthreads();
        if (wave < 4) { SEG_LANE();
            const int d = wave >> 1, R = 32 * (wave & 1);
            LAS unsigned char* Pi = lds + L_PD(d); LAS unsigned char* PTi = lds + L_PTD(d); LAS unsigned char* Ti = lds + L_TD(d); LAS unsigned char* TTi = lds + L_UT + wave * 4096;
            LAS float* gc = sm + 64 * d; LAS float* bet = sm + 128 + 64 * d;
            f32x4 Ta[2][2], TTa[2][2];
#pragma unroll
            for (int mi = 0; mi < 2; ++mi)
#pragma unroll
                for (int ni = 0; ni < 2; ++ni) { const int ar = R + 16 * ni + l15, b0 = R + 16 * mi + 4 * l4;
                    const u32x2 p = *(const LAS u32x2*)(Pi + a64(ar, b0)), pt = *(const LAS u32x2*)(PTi + a64(ar, b0));
                    Ta[mi][ni][0] = (ar == b0 ? 1.f : 0.f) - bflo(p.x); Ta[mi][ni][1] = (ar == b0 + 1 ? 1.f : 0.f) - bfhi(p.x); Ta[mi][ni][2] = (ar == b0 + 2 ? 1.f : 0.f) - bflo(p.y); Ta[mi][ni][3] = (ar == b0 + 3 ? 1.f : 0.f) - bfhi(p.y);
                    TTa[mi][ni][0] = (ar == b0 ? 1.f : 0.f) - bflo(pt.x); TTa[mi][ni][1] = (ar == b0 + 1 ? 1.f : 0.f) - bfhi(pt.x); TTa[mi][ni][2] = (ar == b0 + 2 ? 1.f : 0.f) - bflo(pt.y); TTa[mi][ni][3] = (ar == b0 + 3 ? 1.f : 0.f) - bfhi(pt.y);
                    *(LAS u32x2*)(TTi + a64(16 * ni + l15, b0)) = pack4(TTa[mi][ni]); }
#pragma unroll 1
            for (int s5 = 0; s5 < 5; ++s5) {
                bf16x8 fp[2], fpt[2], ft[2], ftt[2];
#pragma unroll
                for (int mi = 0; mi < 2; ++mi) { fp[mi] = frag64(Pi, R + 16 * mi, R, lane); fpt[mi] = frag64(PTi, R + 16 * mi, R, lane); ft[mi] = frag64(Ti, R + 16 * mi, R, lane);
                    ftt[mi] = *(const LAS bf16x8*)(TTi + a64(16 * mi + l15, R + 8 * l4)); }
                f32x4 pn[2][2], pnt[2][2];
#pragma unroll
                for (int mi = 0; mi < 2; ++mi)
#pragma unroll
                    for (int ni = 0; ni < 2; ++ni) { pn[mi][ni] = (f32x4){0, 0, 0, 0}; pnt[mi][ni] = (f32x4){0, 0, 0, 0};
                        if (s5 < 4) { pn[mi][ni] = MFMA16(fpt[mi], fp[ni], pn[mi][ni]); pnt[mi][ni] = MFMA16(fp[mi], fpt[ni], pnt[mi][ni]); }
                        if (s5 > 0) { Ta[mi][ni] = MFMA16(fpt[mi], ft[ni], Ta[mi][ni]); TTa[mi][ni] = MFMA16(ft[mi], fpt[ni], TTa[mi][ni]); } }
                (void)ftt;
#pragma unroll
                for (int mi = 0; mi < 2; ++mi)
#pragma unroll
                    for (int ni = 0; ni < 2; ++ni) { const int ar = R + 16 * ni + l15, b0 = R + 16 * mi + 4 * l4;
                        if (s5 < 4) { *(LAS u32x2*)(Pi + a64(ar, b0)) = pack4(pn[mi][ni]); *(LAS u32x2*)(PTi + a64(ar, b0)) = pack4(pnt[mi][ni]); }
                        if (s5 > 0 && s5 < 4) *(LAS u32x2*)(Ti + a64(ar, b0)) = pack4(Ta[mi][ni]); }
            }
#pragma unroll
            for (int mi = 0; mi < 2; ++mi)
#pragma unroll
                for (int ni = 0; ni < 2; ++ni) { const int ar = R + 16 * ni + l15, b0 = R + 16 * mi + 4 * l4; f32x4 tw, tu;
#pragma unroll
                    for (int r = 0; r < 4; ++r) { const float bb = bet[b0 + r]; tu[r] = Ta[mi][ni][r] * bb; tw[r] = tu[r] * __expf(gc[b0 + r]); }
                    *(LAS u32x2*)(Ti + a64(ar, b0)) = pack4(Ta[mi][ni]); *(LAS u32x2*)(TTi + a64(16 * ni + l15, b0)) = pack4(TTa[mi][ni]);
                    *(LAS u32x2*)(Pi + a64(ar, b0)) = pack4(tw); *(LAS u32x2*)(PTi + a64(ar, b0)) = pack4(tu); }
        }
        __syncthreads();
        if (wave == 4 || wave == 5) { SEG_LANE();
            const int d = wave - 4, ab = d ? 0 : 1, bb_ = 1 - ab, Ra = 32 * ab, Rb = 32 * bb_;
            LAS unsigned char* Pi = lds + L_PD(d); LAS unsigned char* PTi = lds + L_PTD(d); LAS unsigned char* Ti = lds + L_TD(d);
            LAS unsigned char* TTb = lds + L_UT + (2 * d + bb_) * 4096; LAS unsigned char* Zi = lds + L_KM + d * 4096;
            LAS float* gc = sm + 64 * d; LAS float* bet = sm + 128 + 64 * d;
            bf16x8 x1[2], y1[2];
#pragma unroll
            for (int t = 0; t < 2; ++t) { x1[t] = frag64(PTi, Rb + 16 * t, Ra, lane); y1[t] = frag64(Ti, Ra + 16 * t, Ra, lane); }
#pragma unroll
            for (int mi = 0; mi < 2; ++mi)
#pragma unroll
                for (int ni = 0; ni < 2; ++ni) { f32x4 z = (f32x4){0, 0, 0, 0}; z = MFMA16(x1[mi], y1[ni], z);
                    *(LAS u32x2*)(Zi + a64(16 * ni + l15, Rb + 16 * mi + 4 * l4)) = pack4(z);
                    *(LAS u32x2*)(PTi + a64(Rb + 16 * ni + l15, Ra + 16 * mi + 4 * l4)) = (u32x2){0u, 0u}; }
            bf16x8 x2[2], y2[2];
#pragma unroll
            for (int t = 0; t < 2; ++t) { x2[t] = *(const LAS bf16x8*)(TTb + a64(16 * t + l15, Rb + 8 * l4)); y2[t] = *(const LAS bf16x8*)(Zi + a64(16 * t + l15, Rb + 8 * l4)); }
#pragma unroll
            for (int mj = 0; mj < 2; ++mj)
#pragma unroll
                for (int ni = 0; ni < 2; ++ni) { f32x4 t = (f32x4){0, 0, 0, 0}; t = MFMA16(x2[mj], y2[ni], t);
                    const int ir = Ra + 16 * ni + l15, j0 = Rb + 16 * mj + 4 * l4; f32x4 tw, tu;
#pragma unroll
                    for (int r = 0; r < 4; ++r) { const float bb = bet[j0 + r]; tu[r] = -t[r] * bb; tw[r] = tu[r] * __expf(gc[j0 + r]); }
                    *(LAS u32x2*)(Pi + a64(ir, j0)) = pack4(tw); *(LAS u32x2*)(PTi + a64(ir, j0)) = pack4(tu); }
        }
        __syncthreads();
#pragma unroll 1
        for (int dir = 0; dir < 2; ++dir) {
            LAS float* gc = sm + 64 * dir;
            const float gl = dir ? gc[0] : gc[63];
            { SEG_LANE(); const int d = tid >> 2, ib = (tid & 3) * 16;
#pragma unroll
                for (int cpart = 0; cpart < 2; ++cpart) { const int i = ib + 8 * cpart; const u32x4 w = *(const LAS u32x4*)(lds + L_KT + a64(d, i));
                    float f[8] = {bflo(w.x), bfhi(w.x), bflo(w.y), bfhi(w.y), bflo(w.z), bfhi(w.z), bflo(w.w), bfhi(w.w)};
#pragma unroll
                    for (int e = 0; e < 8; ++e) f[e] *= __expf(gl - gc[i + e]);
                    u32x4 o; o.x = cvt_pk_bf16(f[0], f[1]); o.y = cvt_pk_bf16(f[2], f[3]); o.z = cvt_pk_bf16(f[4], f[5]); o.w = cvt_pk_bf16(f[6], f[7]);
                    *(LAS u32x4*)(lds + L_KM + a64(d, i)) = o; } }
            { SEG_LANE();
                f32x4 wa[4], ua[4];
#pragma unroll
                for (int t4 = 0; t4 < 4; ++t4) { wa[t4] = (f32x4){0, 0, 0, 0}; ua[t4] = (f32x4){0, 0, 0, 0}; }
#pragma unroll
                for (int ks = 0; ks < 2; ++ks) { const bf16x8 yk = frag64(lds + L_KT, 16 * wave, 32 * ks, lane), yv = frag64(lds + L_VT, 16 * wave, 32 * ks, lane);
#pragma unroll
                    for (int t4 = 0; t4 < 4; ++t4) { const bf16x8 xw = frag64(lds + L_PD(dir), 16 * t4, 32 * ks, lane), xu = frag64(lds + L_PTD(dir), 16 * t4, 32 * ks, lane);
                        wa[t4] = MFMA16(xw, yk, wa[t4]); ua[t4] = MFMA16(xu, yv, ua[t4]); } }
                const int rd = 16 * wave + l15;
#pragma unroll
                for (int t4 = 0; t4 < 4; ++t4) { *(LAS u32x2*)(lds + L_WT + a64(rd, 16 * t4 + 4 * l4)) = pack4(wa[t4]); *(LAS u32x2*)(lds + L_UT + a64(rd, 16 * t4 + 4 * l4)) = pack4(ua[t4]); }
            }
            __syncthreads();
            { SEG_LANE();
                const int cd = ((b * NH + h) * NCH + n) * 2 + dir;
                unsigned char* pb = a.ws + WS_PREP + (size_t)cd * PREP_STRIDE;
                if (tid == 0) eglp[cd] = __expf(gl);
                LAS unsigned char* stg = lds + L_PD(dir) + wave * 2048;
                {
                    bf16x8 y[2]; y[0] = frag64(lds + L_KM, 16 * wave, 0, lane); y[1] = frag64(lds + L_KM, 16 * wave, 32, lane);
#pragma unroll
                    for (int hf = 0; hf < 2; ++hf) { f32x4 c[4];
#pragma unroll
                        for (int t4 = 0; t4 < 4; ++t4) { const int t8 = 4 * hf + t4; c[t4] = (f32x4){0, 0, 0, 0};
                            c[t4] = MFMA16(frag64(lds + L_WT, 16 * t8, 0, lane), y[0], c[t4]); c[t4] = MFMA16(frag64(lds + L_WT, 16 * t8, 32, lane), y[1], c[t4]); c[t4] = -c[t4]; }
                        staged_store_16x64<true>(stg, c, pb, wave, hf, lane); }
                }
                {
                    bf16x8 y[2]; y[0] = frag64(lds + L_UT, 16 * wave, 0, lane); y[1] = frag64(lds + L_UT, 16 * wave, 32, lane);
#pragma unroll
                    for (int hf = 0; hf < 2; ++hf) { f32x4 c[4];
#pragma unroll
                        for (int t4 = 0; t4 < 4; ++t4) { const int t8 = 4 * hf + t4; c[t4] = (f32x4){0, 0, 0, 0};
                            c[t4] = MFMA16(frag64(lds + L_KM, 16 * t8, 0, lane), y[0], c[t4]); c[t4] = MFMA16(frag64(lds + L_KM, 16 * t8, 32, lane), y[1], c[t4]); }
                        staged_store_16x64<false>(stg, c, pb + 32768, wave, hf, lane); }
                }
                {
                    bf16x8 y[2]; y[0] = frag64(lds + L_PQD(dir), 16 * tn, 0, lane); y[1] = frag64(lds + L_PQD(dir), 16 * tn, 32, lane);
                    const float eg = __expf(gc[ra]);
                    f32x4 cq[4], co[4];
#pragma unroll
                    for (int t4 = 0; t4 < 4; ++t4) { const int mt = 4 * (wave >> 2) + t4, c0 = 16 * mt + 4 * l4;
                        cq[t4] = (f32x4){0, 0, 0, 0}; co[t4] = (f32x4){0, 0, 0, 0};
                        cq[t4] = MFMA16(frag64(lds + L_WT, 16 * mt, 0, lane), y[0], cq[t4]); cq[t4] = MFMA16(frag64(lds + L_WT, 16 * mt, 32, lane), y[1], cq[t4]);
                        co[t4] = MFMA16(frag64(lds + L_UT, 16 * mt, 0, lane), y[0], co[t4]); co[t4] = MFMA16(frag64(lds + L_UT, 16 * mt, 32, lane), y[1], co[t4]);
                        const u32x2 qw = *(const LAS u32x2*)(lds + L_QM + a128(ra, c0));
                        cq[t4][0] = eg * bflo(qw.x) - cq[t4][0]; cq[t4][1] = eg * bfhi(qw.x) - cq[t4][1]; cq[t4][2] = eg * bflo(qw.y) - cq[t4][2]; cq[t4][3] = eg * bfhi(qw.y) - cq[t4][3]; }
                    staged_store_16x64<true>(stg, cq, pb + 65536, tn, wave >> 2, lane);
                    staged_store_16x64<false>(stg, co, pb + 81920, tn, wave >> 2, lane);
                }
            }
            __syncthreads();
        }
    }
    __builtin_amdgcn_s_setprio(0);
#undef SEG_LANE
#undef PREP_FETCH
}

__device__ __forceinline__ void ph_pool(const Args& a, LAS unsigned char* lds, int vb) {
    const int tid = tid_fresh(), lane = tid & 63, wave = __builtin_amdgcn_readfirstlane(tid >> 6), l15 = lane & 15, l4 = lane >> 4;
    const bf16_t* proj = (const bf16_t*)(a.ws + WS_PROJ);
    bf16_t* amix = (bf16_t*)(a.ws + WS_AMIX);
    for (int tile0 = blockIdx.x; tile0 < MTOK / 64; tile0 += gridDim.x) {
        const int tile = gridDim.x == 256 ? bitem(vb, 0, 32) : tile0;
        const int tok0 = tile * 64, tl0 = tok0 & (T - 1);
        __syncthreads();
#pragma unroll
        for (int q = 0; q < 10; ++q) { const int idx = tid + NTHR * q, r = idx >> 6, ch = idx & 63, tl = tl0 - 8 + r;
            u32x4 v = (u32x4){0u, 0u, 0u, 0u};
            if (tl >= 0 && tl < T) v = *(const u32x4*)(proj + (size_t)(tok0 - 8 + r) * NPROJ + 2048 + 8 * ch);
            *(LAS u32x4*)(lds + r * 1024 + ch * 16) = v; }
        __syncthreads();
        const int g = wave & 3, w = 2 << g, lo = w >> 1, hi = w - lo - 1, ch = 16 * g + l15;
#pragma unroll 2
        for (int q = 0; q < 8; ++q) {
            const int tk = 8 * q + 4 * (wave >> 2) + l4, tl = tl0 + tk;
            float sum[8] = {0, 0, 0, 0, 0, 0, 0, 0};
            for (int j = -lo; j <= hi; ++j) { const u32x4 v = *(const LAS u32x4*)(lds + (tk + 8 + j) * 1024 + ch * 16);
                sum[0] += bflo(v.x); sum[1] += bfhi(v.x); sum[2] += bflo(v.y); sum[3] += bfhi(v.y); sum[4] += bflo(v.z); sum[5] += bfhi(v.z); sum[6] += bflo(v.w); sum[7] += bfhi(v.w); }
            const u32x4 v = *(const LAS u32x4*)(lds + (tk + 8) * 1024 + ch * 16);
            const int s0 = max(tl - lo, 0), e0 = min(tl + hi + 1, T);
            const float inv = 1.f / (float)(e0 - s0);
            u32x4 o; o.x = cvt_pk_bf16(sum[0] * inv - bflo(v.x), sum[1] * inv - bfhi(v.x)); o.y = cvt_pk_bf16(sum[2] * inv - bflo(v.y), sum[3] * inv - bfhi(v.y));
            o.z = cvt_pk_bf16(sum[4] * inv - bflo(v.z), sum[5] * inv - bfhi(v.z)); o.w = cvt_pk_bf16(sum[6] * inv - bflo(v.w), sum[7] * inv - bfhi(v.w));
            *(u32x4*)(amix + (size_t)(tok0 + tk) * D + 512 + 8 * ch) = o;
        }
    }
    __syncthreads();
}

struct ScanSet { bf16x8 xm[4]; bf16x8 yq[4]; u32x2 cw[2]; u32x2 ow; float egl; };
template <int VAR>
__device__ __forceinline__ void ph_scan(const Args& a, LAS unsigned char* lds, int vb) {
    const int tid = tid_fresh(), lane = tid & 63, wave = __builtin_amdgcn_readfirstlane(tid >> 6), l15 = lane & 15, l4 = lane >> 4;
    const float* eglp = (const float*)(a.ws + WS_EGL);
    bf16_t* od = (bf16_t*)(a.ws + (VAR == 0 ? WS_OD : (size_t)464 * MiB));
    const int tn = wave & 3, eo = wave >> 2;
    for (int job = vb; job < 256; job += gridDim.x) {
        const int x = job & 7, j = job >> 3, chain = x * 8 + (j >> 2), sl = j & 3, dir = chain & 1, bh = chain >> 1, b = bh >> 2, h = bh & 3;
        if (VAR == 1 && sl != 0) continue;
        f32x4 acc[2] = {(f32x4){0, 0, 0, 0}, (f32x4){0, 0, 0, 0}};
        const unsigned offx = (unsigned)(wave * 4) * 1024u + (unsigned)l15 * 64u + (unsigned)l4 * 16u;
        const unsigned offc = 32768u + (unsigned)((2 * sl) * 8 + wave) * 512u + (unsigned)l15 * 32u + (unsigned)l4 * 8u;
        const unsigned offq = 65536u + (unsigned)(tn * 4) * 1024u + (unsigned)l15 * 64u + (unsigned)l4 * 16u;
        const unsigned offo = 81920u + (unsigned)(tn * 8 + 2 * sl + eo) * 512u + (unsigned)l15 * 32u + (unsigned)l4 * 8u;
        const long dstep = dir ? -(long)(2 * PREP_STRIDE) : (long)(2 * PREP_STRIDE);
        const int cd0 = (bh * NCH + (dir ? NCH - 1 : 0)) * 2 + dir;
        const GAS unsigned char* pld = (const GAS unsigned char*)(a.ws + WS_PREP + (size_t)cd0 * PREP_STRIDE);
        const GAS float* pegl = (const GAS float*)(eglp + cd0);
        GAS bf16_t* pod = (GAS bf16_t*)od + ((size_t)dir * MTOK + (size_t)(b * T + (dir ? NCH - 1 : 0) * 64 + 16 * tn + l15)) * 512 + h * HD + 32 * sl + 16 * eo + 4 * l4;
        const long ostep = dir ? -(long)(64 * 512) : (long)(64 * 512);
        const long gstep = dir ? -2 : 2;
#define SCAN_LOAD(S) do { asm volatile("" : "+s"(pld), "+s"(pegl)); \
        _Pragma("unroll") for (int ks = 0; ks < 4; ++ks) { S.xm[ks] = *(const GAS bf16x8*)(pld + offx + 1024 * ks); S.yq[ks] = *(const GAS bf16x8*)(pld + offq + 1024 * ks); } \
        _Pragma("unroll") for (int et = 0; et < 2; ++et) S.cw[et] = *(const GAS u32x2*)(pld + offc + 4096 * et); \
        S.ow = *(const GAS u32x2*)(pld + offo); S.egl = *pegl; pld += dstep; pegl += gstep; } while (0)
#define SCAN_STEP(S, SN, step) do { const int cur_ = (step) & 1; \
        _Pragma("unroll") for (int et = 0; et < 2; ++et) *(LAS u32x2*)(lds + cur_ * 8192 + a128(16 * et + l15, 16 * wave + 4 * l4)) = pack4(acc[et]); \
        asm volatile("s_waitcnt lgkmcnt(0)" ::: "memory"); __builtin_amdgcn_s_barrier(); asm volatile("" ::: "memory"); \
        if ((step) + 3 < NCH) SCAN_LOAD(SN); \
        bf16x8 st_[2][4]; \
        _Pragma("unroll") for (int et = 0; et < 2; ++et) _Pragma("unroll") for (int ks = 0; ks < 4; ++ks) st_[et][ks] = frag128(lds + cur_ * 8192, 16 * et, 32 * ks, lane); \
        f32x4 o_; o_[0] = bflo(S.ow.x); o_[1] = bfhi(S.ow.x); o_[2] = bflo(S.ow.y); o_[3] = bfhi(S.ow.y); \
        _Pragma("unroll") for (int ks = 0; ks < 4; ++ks) o_ = MFMA16(eo ? st_[1][ks] : st_[0][ks], S.yq[ks], o_); \
        _Pragma("unroll") for (int et = 0; et < 2; ++et) { \
            acc[et][0] = S.egl * acc[et][0] + bflo(S.cw[et].x); acc[et][1] = S.egl * acc[et][1] + bfhi(S.cw[et].x); acc[et][2] = S.egl * acc[et][2] + bflo(S.cw[et].y); acc[et][3] = S.egl * acc[et][3] + bfhi(S.cw[et].y); \
            _Pragma("unroll") for (int ks = 0; ks < 4; ++ks) acc[et] = MFMA16(S.xm[ks], st_[et][ks], acc[et]); } \
        asm volatile("" : "+v"(pod)); *(GAS u32x2*)pod = pack4(o_); pod += ostep; } while (0)
        ScanSet s0, s1, s2, s3;
        SCAN_LOAD(s0); SCAN_LOAD(s1); SCAN_LOAD(s2);
        __syncthreads();
#pragma unroll
        for (int step = 0; step < NCH; step += 4) {
            SCAN_STEP(s0, s3, step); SCAN_STEP(s1, s0, step + 1); SCAN_STEP(s2, s1, step + 2); SCAN_STEP(s3, s2, step + 3);
        }
#undef SCAN_LOAD
#undef SCAN_STEP
    }
}

__device__ __forceinline__ void ph_delta_out(const Args& a, LAS unsigned char* lds, int vb) {
    const int tid = tid_fresh(), lane = tid & 63, wave = tid >> 6, l15 = lane & 15, l4 = lane >> 4;
    const bf16_t* proj = (const bf16_t*)(a.ws + WS_PROJ); const bf16_t* od = (const bf16_t*)(a.ws + WS_OD);
    bf16_t* amix = (bf16_t*)(a.ws + WS_AMIX);
    const f32x4 hw0 = *(const f32x4*)(a.in[8] + 8 * l15), hw1 = *(const f32x4*)(a.in[8] + 8 * l15 + 4);
    const bool bmap = gridDim.x == 256;
    const int gw = bmap ? (vb & 7) * T + (vb >> 3) * NWAVE + wave : (int)blockIdx.x * NWAVE + wave, NGW = bmap ? 256 : (int)gridDim.x * NWAVE;
    const int rend = bmap ? ((vb & 7) + 1) * T : MTOK;
    u32x4 fn = (u32x4){0u, 0u, 0u, 0u}, gn = fn, zn = fn;
    if (gw < rend) { const size_t base = (size_t)gw * 512 + 128 * l4 + 8 * l15; fn = *(const u32x4*)(od + base); gn = *(const u32x4*)(od + (size_t)MTOK * 512 + base);
        zn = *(const u32x4*)(proj + (size_t)gw * NPROJ + 1536 + 128 * l4 + 8 * l15); }
    for (int it = gw; it < rend; it += NGW) {
        const u32x4 f = fn, g = gn, z = zn;
        if (it + NGW < rend) { const size_t base = (size_t)(it + NGW) * 512 + 128 * l4 + 8 * l15; fn = *(const u32x4*)(od + base); gn = *(const u32x4*)(od + (size_t)MTOK * 512 + base);
            zn = *(const u32x4*)(proj + (size_t)(it + NGW) * NPROJ + 1536 + 128 * l4 + 8 * l15); }
        float o[8] = {bflo(f.x) + bflo(g.x), bfhi(f.x) + bfhi(g.x), bflo(f.y) + bflo(g.y), bfhi(f.y) + bfhi(g.y), bflo(f.z) + bflo(g.z), bfhi(f.z) + bfhi(g.z), bflo(f.w) + bflo(g.w), bfhi(f.w) + bfhi(g.w)};
        float ss = 0.f;
#pragma unroll
        for (int e = 0; e < 8; ++e) ss += o[e] * o[e];
        ss += __shfl_xor(ss, 1); ss += __shfl_xor(ss, 2); ss += __shfl_xor(ss, 4); ss += __shfl_xor(ss, 8);
        const float r = rsqrtf(ss * (1.f / HD) + EPS);
        const float zf[8] = {bflo(z.x), bfhi(z.x), bflo(z.y), bfhi(z.y), bflo(z.z), bfhi(z.z), bflo(z.w), bfhi(z.w)};
        u32x4 w;
        w.x = cvt_pk_bf16(o[0] * r * hw0[0] * silu_f(zf[0]), o[1] * r * hw0[1] * silu_f(zf[1])); w.y = cvt_pk_bf16(o[2] * r * hw0[2] * silu_f(zf[2]), o[3] * r * hw0[3] * silu_f(zf[3]));
        w.z = cvt_pk_bf16(o[4] * r * hw1[0] * silu_f(zf[4]), o[5] * r * hw1[1] * silu_f(zf[5])); w.w = cvt_pk_bf16(o[6] * r * hw1[2] * silu_f(zf[6]), o[7] * r * hw1[3] * silu_f(zf[7]));
        *(u32x4*)(amix + (size_t)it * D + 128 * l4 + 8 * l15) = w;
    }
}

__device__ __forceinline__ int block_sum(int v, LAS int* slot8, int wave, int lane) {
#pragma unroll
    for (int o = 1; o < 64; o <<= 1) v += __shfl_xor(v, o);
    if (lane == 0) slot8[wave] = v;
    __syncthreads();
    int s = 0;
#pragma unroll
    for (int w = 0; w < 8; ++w) s += slot8[w];
    return s;
}
__device__ __forceinline__ int block_excl_scan(int v, LAS int* slot8, int wave, int lane) {
    int inc = v;
#pragma unroll
    for (int o = 1; o < 64; o <<= 1) { const int t = __shfl_up(inc, o); if (lane >= o) inc += t; }
    if (lane == 63) slot8[wave] = inc;
    __syncthreads();
    int off = 0;
#pragma unroll
    for (int w = 0; w < 8; ++w) off += (w < wave) ? slot8[w] : 0;
    return off + inc - v;
}
__device__ __forceinline__ void ph_topk_gather(const Args& a, LAS unsigned char* lds, int vb) {
    const int tid = tid_fresh(), lane = tid & 63, wave = tid >> 6;
    const float* probs = (const float*)(a.ws + WS_PROBS);
    int* inv = (int*)(a.ws + WS_INV); int* seli = (int*)(a.ws + WS_SELI); float* selg = (float*)(a.ws + WS_SELG);
    LAS int* red = (LAS int*)lds;
    for (int job0 = gridDim.x == 256 ? 0 : (int)blockIdx.x; job0 < (gridDim.x == 256 ? 1 : NB * NE); job0 += gridDim.x) {
        int job = job0; if (gridDim.x == 256) { if ((vb >> 3) >= NE) break; job = (vb & 7) * NE + (vb >> 3); }
        const int be = job, b = be >> 4, e = be & 15;
        unsigned v[4];
#pragma unroll
        for (int j = 0; j < 4; ++j) v[j] = __float_as_uint(probs[(size_t)(b * T + 4 * tid + j) * 16 + e]);
        __syncthreads();
        unsigned thr = 0u;
#pragma unroll 1
        for (int rd = 0; rd < 8; ++rd) { const int sh = 28 - 4 * rd;
            LAS int* slot = red + 128 * (rd & 1);
#pragma unroll
            for (int i = 1; i < 16; ++i) { const unsigned cand = thr | ((unsigned)i << sh); int c = 0;
#pragma unroll
                for (int j = 0; j < 4; ++j) c += (int)__builtin_popcountll(__ballot(v[j] >= cand));
                if (lane == 0) slot[wave * 16 + i] = c; }
            __syncthreads();
            int best = 0;
#pragma unroll
            for (int i = 1; i < 16; ++i) { int c = 0;
#pragma unroll
                for (int w8 = 0; w8 < 8; ++w8) c += slot[w8 * 16 + i];
                best = (c >= CAP) ? i : best; }
            thr |= (unsigned)best << sh; }
        __syncthreads();
        int cgt = 0, ceq = 0;
#pragma unroll
        for (int j = 0; j < 4; ++j) { cgt += (v[j] > thr) ? 1 : 0; ceq += (v[j] == thr) ? 1 : 0; }
        const int tot_gt = block_sum(cgt, red + 8 * 32, wave, lane);
        const int need_eq = CAP - tot_gt;
        const int eq_before = block_excl_scan(ceq, red + 8 * 33, wave, lane);
        int sel[4], nsel = 0, eqc = eq_before;
#pragma unroll
        for (int j = 0; j < 4; ++j) { const bool iseq = (v[j] == thr); sel[j] = (v[j] > thr) || (iseq && eqc < need_eq); eqc += iseq ? 1 : 0; nsel += sel[j]; }
        int slot = block_excl_scan(nsel, red + 8 * 34, wave, lane);
#pragma unroll
        for (int j = 0; j < 4; ++j) { const int t = 4 * tid + j;
            if (sel[j]) { seli[be * CAP + slot] = b * 4096 + t; selg[be * CAP + slot] = __uint_as_float(v[j]); }
            inv[(size_t)(b * T + t) * 16 + e] = sel[j] ? slot : -1;
            slot += sel[j]; }
        __syncthreads();
    }
}

__device__ __forceinline__ void ph_final(const Args& a, bool with_ffn) {
    const int tid = tid_fresh(), lane = tid & 63, wave = tid >> 6;
    const int* inv = (const int*)(a.ws + WS_INV); const unsigned char* y = a.ws + WS_Y; const float* selg = (const float*)(a.ws + WS_SELG);
    const f32x4* nw4 = (const f32x4*)a.in[17] + lane;
    f32x4 w4[4];
#pragma unroll
    for (int j = 0; j < 4; ++j) w4[j] = nw4[64 * j];
    const int gw = blockIdx.x * NWAVE + wave, NGW = gridDim.x * NWAVE;
    const bf16_t* hb = (const bf16_t*)(a.ws + WS_HB);
    u32x2 hn[4]; int invn = -1;
    if (gw < MTOK) { const u32x2* xr0 = (const u32x2*)(hb + (size_t)gw * D + (size_t)(gw >> 11) * HB_BEXTRA) + lane;
#pragma unroll
        for (int j = 0; j < 4; ++j) hn[j] = xr0[64 * j];
        if (with_ffn && lane < NE) invn = inv[(size_t)gw * 16 + lane]; }
    for (int row = gw; row < MTOK; row += NGW) {
        f32x4* xr = (f32x4*)(a.out + (size_t)row * D) + lane;
        f32x4 v[4];
#pragma unroll
        for (int j = 0; j < 4; ++j) v[j] = (f32x4){bflo(hn[j].x), bfhi(hn[j].x), bflo(hn[j].y), bfhi(hn[j].y)};
        const int myinv = invn;
        if (row + NGW < MTOK) { const u32x2* xr1 = (const u32x2*)(hb + (size_t)(row + NGW) * D + (size_t)((row + NGW) >> 11) * HB_BEXTRA) + lane;
#pragma unroll
            for (int j = 0; j < 4; ++j) hn[j] = xr1[64 * j];
            invn = (with_ffn && lane < NE) ? inv[(size_t)(row + NGW) * 16 + lane] : -1; }
        if (with_ffn) {
            const int b = row >> 11;
            unsigned long long mask = __ballot(myinv >= 0);
            while (mask) {
                int yrow[4]; float gq[4];
#pragma unroll
                for (int q = 0; q < 4; ++q) { const bool ok = mask != 0ull; const int e = ok ? (int)__builtin_ctzll(mask) : 0; if (ok) mask &= mask - 1ull;
                    const int sl = __shfl(myinv, e); yrow[q] = (b * NE + e) * CAP + (ok ? sl : 0); gq[q] = ok ? selg[yrow[q]] : 0.f; }
                unsigned wq[4][4];
#pragma unroll
                for (int q = 0; q < 4; ++q) { const unsigned* yr = (const unsigned*)(y + (size_t)yrow[q] * D) + lane;
#pragma unroll
                    for (int j = 0; j < 4; ++j) wq[q][j] = yr[64 * j]; }
#pragma unroll
                for (int q = 0; q < 4; ++q)
#pragma unroll
                    for (int j = 0; j < 4; ++j) { const float gs = gq[q] * (1.f / F8_ACT); const int wv = (int)wq[q][j];
                        v[j].x += gs * __builtin_amdgcn_cvt_f32_fp8(wv, 0); v[j].y += gs * __builtin_amdgcn_cvt_f32_fp8(wv, 1); v[j].z += gs * __builtin_amdgcn_cvt_f32_fp8(wv, 2); v[j].w += gs * __builtin_amdgcn_cvt_f32_fp8(wv, 3); }
            }
        }
        float ss = 0.f;
#pragma unroll
        for (int j = 0; j < 4; ++j) ss += (v[j].x * v[j].x + v[j].y * v[j].y) + (v[j].z * v[j].z + v[j].w * v[j].w);
        const float r = rsqrtf(wave_sum(ss) * (1.f / D) + EPS);
#pragma unroll
        for (int j = 0; j < 4; ++j) __builtin_nontemporal_store(v[j] * r * w4[j], xr + 64 * j);
    }
}

#ifndef EXP_VAR
#define EXP_VAR 0
#endif
#ifndef DBL_MASK
#define DBL_MASK 0
#endif
#ifndef PH_PER_LAUNCH
#define PH_PER_LAUNCH 1
#endif
#ifndef PLAIN_LAUNCH
#define PLAIN_LAUNCH 0
#endif
#ifndef USE_CG_SYNC
#define USE_CG_SYNC 0
#endif
#ifndef ONE_LAUNCH
#define ONE_LAUNCH 1
#endif
#ifndef DBG_STAGE
#ifndef LOCAL_SEAMS
#define LOCAL_SEAMS 1
#endif
#define DBG_STAGE 3
#endif
#define XB_TMO      128
#define XB_XCNT(j)  (256  + 64 * (j))
#define XB_XSUB(j)  (1280 + 64 * (j))
#define XB_XGEN(j)  (2304 + 64 * (j))
#define XB_TOP      3328
#define XB_TOPGEN   3392
#define XCD_BAR_WORDS 3456
#define XB_SPIN_CAP (1u << 20)
__device__ __forceinline__ unsigned xb_ld(unsigned* p)              { return __hip_atomic_load(p, __ATOMIC_RELAXED, __HIP_MEMORY_SCOPE_AGENT); }
__device__ __forceinline__ unsigned xb_add(unsigned* p, unsigned v) { return __hip_atomic_fetch_add(p, v, __ATOMIC_RELAXED, __HIP_MEMORY_SCOPE_AGENT); }
__device__ __forceinline__ unsigned xb_xcc_id() { return (unsigned)__builtin_amdgcn_s_getreg((3 << 11) | 20) & 0xFu; }
#define XB_SPIN(cond, bar) do { unsigned _sp = 0; while (cond) { __builtin_amdgcn_s_sleep(1); \
    if ((++_sp & 255u) == 0u) { if (xb_ld(&(bar)[XB_TMO])) break; if (_sp > XB_SPIN_CAP) { atomicAdd(&(bar)[XB_TMO], 1u); break; } } } } while (0)
struct XcdBarrier { unsigned* bar; unsigned x; volatile LAS unsigned* st; };
__device__ __forceinline__ XcdBarrier xcd_barrier_post(unsigned* bar, volatile LAS unsigned* st) {
    XcdBarrier b; b.bar = bar; b.x = xb_xcc_id(); b.st = st;
    if (threadIdx.x == 0) st[2] = xb_add(&bar[XB_XCNT(b.x)], 1u);
    return b;
}
__device__ __forceinline__ void xcd_barrier_complete(unsigned* bar, unsigned x, unsigned& nloc, unsigned& nx) {
    const unsigned G = gridDim.x * gridDim.y * gridDim.z;
    unsigned sum, cnt, mine, sp = 0u;
    for (;;) {
        sum = 0u; cnt = 0u; mine = 0u;
#pragma unroll
        for (unsigned j = 0; j < 16; ++j) { const unsigned c = xb_ld(&bar[XB_XCNT(j)]); sum += c; cnt += (c > 0u) ? 1u : 0u; mine = (j == x) ? c : mine; }
        if (sum == G) break;
        __builtin_amdgcn_s_sleep(1);
        if ((++sp & 255u) == 0u) { if (xb_ld(&bar[XB_TMO])) break; if (sp > XB_SPIN_CAP) { atomicAdd(&bar[XB_TMO], 1u); break; } }
    }
    nloc = mine > 0u ? mine : 1u; nx = cnt > 0u ? cnt : 1u;
}
__device__ __forceinline__ void xcd_barrier(const XcdBarrier& b) {
    asm volatile("s_waitcnt vmcnt(0)" ::: "memory");
    __syncthreads();
    if (threadIdx.x == 0) {
        unsigned* bar = b.bar;
        __builtin_amdgcn_s_waitcnt(0);
        unsigned nloc = b.st[0], nx = b.st[1];
        if (nloc == 0u) { xcd_barrier_complete(bar, b.x, nloc, nx); b.st[0] = nloc; b.st[1] = nx; }
        const unsigned old = xb_add(&bar[XB_XSUB(b.x)], 1u);
        const unsigned gen = old / nloc;
        bool fire = false;
        if (old + 1u == (gen + 1u) * nloc) {
            __builtin_amdgcn_fence(__ATOMIC_RELEASE, "agent");
            asm volatile("s_waitcnt vmcnt(0)" ::: "memory");
            const unsigned og = xb_add(&bar[XB_TOP], 1u);
            if (og + 1u == (og / nx + 1u) * nx) { xb_add(&bar[XB_TOPGEN], 1u); fire = true; }
        }
        if (!fire) XB_SPIN(xb_ld(&bar[XB_TOPGEN]) == gen, bar);
        __builtin_amdgcn_fence(__ATOMIC_ACQUIRE, "agent");
        asm volatile("s_waitcnt vmcnt(0)" ::: "memory");
    }
    __syncthreads();
}

__device__ __forceinline__ void xcd_local_barrier(const XcdBarrier& b) {
    asm volatile("s_waitcnt vmcnt(0)" ::: "memory");
    __syncthreads();
    if (threadIdx.x == 0) {
        unsigned* bar = b.bar;
        __builtin_amdgcn_s_waitcnt(0);
        const unsigned old = xb_add(&bar[XB_XGEN(b.x)], 1u);
        const unsigned target = (old / 32u + 1u) * 32u;
        XB_SPIN(xb_ld(&bar[XB_XGEN(b.x)]) < target, bar);
        __builtin_amdgcn_fence(__ATOMIC_ACQUIRE, "agent");
        asm volatile("s_waitcnt vmcnt(0)" ::: "memory");
    }
    __syncthreads();
}

typedef const __attribute__((address_space(4))) Args* CArgsP;
__device__ __forceinline__ Args fresh_args() {
    Args r{};
#if defined(__HIP_DEVICE_COMPILE__)
    const __attribute__((address_space(4))) unsigned long long* p = (const __attribute__((address_space(4))) unsigned long long*)__builtin_amdgcn_kernarg_segment_ptr();
    asm volatile("" : "+s"(p));
#pragma unroll
    for (int i = 0; i < 18; ++i) r.in[i] = (const float*)(const __attribute__((address_space(1))) float*)p[i];
    r.out = (float*)(__attribute__((address_space(1))) float*)p[18]; r.ws = (unsigned char*)(__attribute__((address_space(1))) unsigned char*)p[19]; r.ph_lo = (int)(unsigned)p[20]; r.ph_hi = (int)(p[20] >> 32);
#endif
    return r;
}
template <int LO, int HI>
__global__ void __launch_bounds__(NTHR, 2) fwd_kernel(Args a_unused) {
    extern __shared__ __attribute__((aligned(16))) unsigned char lds_raw[];
    LAS unsigned char* lds = (LAS unsigned char*)lds_raw;
    int rlo = LO, rhi = HI;
    if constexpr (HI - LO > 1) { const Args a = fresh_args(); rlo = a.ph_lo; rhi = a.ph_hi; }
#define IN(k) (LO <= (k) && (k) < HI)
#define RIN(k) (rlo <= (k) && (k) < rhi)
    XcdBarrier bar; bar.bar = nullptr; bar.x = 0; bar.st = nullptr;
    if constexpr (HI - LO > 1) {
        volatile LAS unsigned* st = (volatile LAS unsigned*)(lds + LDS_BYTES - 16);
        if (threadIdx.x == 0) { st[0] = 0u; st[1] = 0u; }
        __syncthreads();
        const Args a = fresh_args();
        bar = xcd_barrier_post((unsigned*)(a.ws + WS_CTL), st);
    }
#if USE_CG_SYNC
#define SEAM(k) do { if constexpr (IN(k) && IN((k) + 1)) { cooperative_groups::this_grid().sync(); } } while (0)
#else
#define SEAM(k) do { if constexpr (IN(k) && IN((k) + 1)) { if (RIN(k) && RIN((k) + 1)) xcd_barrier(bar); } } while (0)
#endif
#define SEAM_L(k) do { if constexpr (IN(k) && IN((k) + 1)) { if (RIN(k) && RIN((k) + 1)) { if (local_ok && LOCAL_SEAMS) xcd_local_barrier(bar); else xcd_barrier(bar); } } } while (0)
    if constexpr (IN(0)) if (RIN(0)) { const Args a = fresh_args(); ph_prologue(a, lds); }
    SEAM(0);
    int vb = blockIdx.x; bool local_ok = false;
    if constexpr (HI - LO > 1) {
        if (RIN(0) && RIN(1)) {
            volatile LAS unsigned* st = (volatile LAS unsigned*)(lds + LDS_BYTES - 16);
            if (threadIdx.x == 0) { bool ok = gridDim.x == 256;
                for (unsigned j = 0; j < 16; ++j) { const unsigned c = xb_ld(&bar.bar[XB_XCNT(j)]); ok = ok && (j < 8 ? c == 32u : c == 0u); }
                st[3] = ok ? (256u + bar.x + 8u * st[2]) : blockIdx.x; }
            __syncthreads();
            vb = __builtin_amdgcn_readfirstlane((int)st[3]);
            local_ok = (vb >> 8) != 0; vb &= 255;
        }
    }
    if constexpr (IN(1)) if (RIN(1)) { const Args a = fresh_args(); pg8::Gemm g{(const bf16_t*)(a.ws + WS_XN), (const bf16_t*)(a.ws + WS_WIN), D, nullptr}; pg8::StaticOrder S; S.init(MTOK, NPROJ, gridDim.x, vb);
        pg8::EpiProj E{(bf16_t*)(a.ws + WS_PROJ), NPROJ}; pg8::gemm_phase(lds, g, S, E);
        if (DBG_STAGE >= 3) { if (gridDim.x == 256) expert_weight_cvt<true>(a, lds, 0, NEARLY * 1024, 128, 128, vb); else expert_weight_cvt<true>(a, lds, 0, NEARLY * 1024, 0, gridDim.x, blockIdx.x); } }
    SEAM_L(1);
    if constexpr (IN(2)) if (RIN(2)) { const Args a = fresh_args(); ph_pool(a, lds, vb); if (DBG_STAGE >= 2) ph_chunk_prep(a, lds, vb); }
    SEAM_L(2);
    if constexpr (IN(3)) if (RIN(3)) { const Args a = fresh_args(); if (DBG_STAGE >= 2) ph_scan<0>(a, lds, vb); }
    SEAM_L(3);
    if constexpr (IN(4)) if (RIN(4)) { const Args a = fresh_args(); if (DBG_STAGE >= 2) ph_delta_out(a, lds, vb); }
    SEAM_L(4);
    if constexpr (IN(5)) if (RIN(5)) {
        const bool split = (DBG_STAGE >= 3) && gridDim.x == 256;
        if (!split || vb < P5_GEMM_WGS) { const Args a = fresh_args(); pg8::Gemm g{(const bf16_t*)(a.ws + WS_AMIX), (const bf16_t*)(a.ws + WS_WMIX), D, nullptr}; pg8::StaticOrder S; S.init(MTOK, D, split ? P5_GEMM_WGS : gridDim.x, vb);
            pg8::EpiResid E{a.in[0], (bf16_t*)(a.ws + WS_HB), D, HB_BEXTRA}; pg8::gemm_phase(lds, g, S, E); }
        if (DBG_STAGE >= 3) { const Args a = fresh_args();
            if (split) { if (vb >= P5_GEMM_WGS) expert_weight_cvt<false>(a, lds, 0, CVT_SOLO, P5_GEMM_WGS, 256 - P5_GEMM_WGS, vb); else expert_weight_cvt<false>(a, lds, CVT_SOLO, CVT_SPLIT, 0, P5_GEMM_WGS, vb); }
            else expert_weight_cvt<false>(a, lds, 0, CVT_SPLIT, 0, gridDim.x, blockIdx.x); } }
    SEAM_L(5);
    if constexpr (IN(6)) if (RIN(6)) { const Args a = fresh_args(); if (DBG_STAGE >= 3) row_pass<1>(a, lds, vb); }
    SEAM_L(6);
    if constexpr (IN(7)) if (RIN(7)) { const Args a = fresh_args(); if (DBG_STAGE >= 3) { ph_topk_gather(a, lds, vb);
        if (gridDim.x == 256) { if ((vb >> 3) >= NE) expert_weight_cvt<false>(a, lds, CVT_SPLIT, CVT_ITEMS, 0, 128, (vb & 7) * 16 + (vb >> 3) - NE); }
        else if (gridDim.x > NB * NE) expert_weight_cvt<false>(a, lds, CVT_SPLIT, CVT_ITEMS, NB * NE, gridDim.x - NB * NE, blockIdx.x); else expert_weight_cvt<false>(a, lds, CVT_SPLIT, CVT_ITEMS, 0, gridDim.x, blockIdx.x); } }
    SEAM(7);
    if constexpr (IN(8)) if (RIN(8)) { if (DBG_STAGE >= 3) { const Args a = fresh_args(); pg8::Gemm g{(const bf16_t*)(a.ws + WS_XN2), (const bf16_t*)(a.ws + WS_WGU), D / 2, (const int*)(a.ws + WS_SELI)}; pg8::ExpertOrder S; S.init(vb, 16);
        pg8::EpiSwiglu E{a.ws + WS_HMID}; pg8::gemm_phase<pg8::EpiSwiglu, pg8::ExpertOrder, true, true>(lds, g, S, E); } }
    SEAM_L(8);
    if constexpr (IN(9)) if (RIN(9)) { if (DBG_STAGE >= 3) { const Args a = fresh_args(); pg8::Gemm g{(const bf16_t*)(a.ws + WS_HMID), (const bf16_t*)(a.ws + WS_WD), FF / 2, nullptr}; pg8::ExpertOrder S; S.init(vb, 4, NEARLY, (int)((WS_WDA - WS_WD) / ((size_t)256 * FF)));
        pg8::EpiDown E{a.ws + WS_Y}; pg8::gemm_phase<pg8::EpiDown, pg8::ExpertOrder, false, true>(lds, g, S, E); } }
    SEAM(9);
    if constexpr (IN(10)) if (RIN(10)) { const Args a = fresh_args(); ph_final(a, DBG_STAGE >= 3); }
#undef IN
#undef SEAM
#undef SEAM_L
}
template <int VAR> __global__ void __launch_bounds__(NTHR, 2) exp_scan_kernel(Args a_unused) {
    extern __shared__ __attribute__((aligned(16))) unsigned char lds_raw[];
    const Args a = fresh_args(); ph_scan<VAR>(a, (LAS unsigned char*)lds_raw, blockIdx.x);
}
template <int P> static void launch_phase(const Args& a, hipStream_t stream) {
    static bool attr = false;
    if (!attr) { (void)hipFuncSetAttribute((const void*)fwd_kernel<P, P + 1>, hipFuncAttributeMaxDynamicSharedMemorySize, LDS_BYTES); attr = true; }
    hipLaunchKernelGGL((fwd_kernel<P, P + 1>), dim3(NBLK), dim3(NTHR), LDS_BYTES, stream, a);
}

extern "C" void kernel_launch(void* const* d_in, const int* in_sizes, int n_in, void* d_out, int out_size, void* d_ws, size_t ws_size, hipStream_t stream) {
    if (n_in != 18 || out_size != MTOK * D || ws_size < WS_END) { fprintf(stderr, "kernel_launch: unexpected shapes (n_in %d out %d ws %zu)\n", n_in, out_size, ws_size); return; }
    Args a{};
    for (int i = 0; i < 18; ++i) a.in[i] = (const float*)d_in[i];
    a.out = (float*)d_out; a.ws = (unsigned char*)d_ws;
    if (DBG_STAGE < 2) (void)hipMemsetAsync((char*)d_ws + WS_AMIX, 0, 32 * MiB, stream);
#if ONE_LAUNCH
    static int grid = 0;
    if (!grid) {
        int dev = 0, cus = 0, per_cu = 0;
        (void)hipGetDevice(&dev); (void)hipDeviceGetAttribute(&cus, hipDeviceAttributeMultiprocessorCount, dev);
        (void)hipFuncSetAttribute((const void*)fwd_kernel<0, 11>, hipFuncAttributeMaxDynamicSharedMemorySize, LDS_BYTES);
        (void)hipOccupancyMaxActiveBlocksPerMultiprocessor(&per_cu, (const void*)fwd_kernel<0, 11>, NTHR, LDS_BYTES);
        grid = (per_cu >= 1 && cus >= NBLK) ? NBLK : -1;
        if (grid < 0) fprintf(stderr, "kernel_launch: needs %d co-resident workgroups (cus %d, per_cu %d)\n", NBLK, cus, per_cu);
    }
    if (grid < 0) return;
    (void)hipMemsetAsync((char*)d_ws + WS_CTL, 0, 16384, stream);
    void* kargs[] = {(void*)&a};
#if PLAIN_LAUNCH
    (void)kargs;
    for (int p = 0; p < 11; p += PH_PER_LAUNCH) { a.ph_lo = p; a.ph_hi = (p + PH_PER_LAUNCH < 11) ? p + PH_PER_LAUNCH : 11;
        for (int rep = 0; rep < (((DBL_MASK >> p) & 1) ? 2 : 1); ++rep) hipLaunchKernelGGL((fwd_kernel<0, 11>), dim3(NBLK), dim3(NTHR), LDS_BYTES, stream, a);
#if EXP_VAR
        if (p == 3) { static bool at = false; if (!at) { (void)hipFuncSetAttribute((const void*)exp_scan_kernel<EXP_VAR>, hipFuncAttributeMaxDynamicSharedMemorySize, LDS_BYTES); at = true; }
            hipLaunchKernelGGL((exp_scan_kernel<EXP_VAR>), dim3(NBLK), dim3(NTHR), LDS_BYTES, stream, a); }
#endif
    }
#else
    a.ph_lo = 0; a.ph_hi = 11;
    hipError_t e = hipLaunchCooperativeKernel((const void*)fwd_kernel<0, 11>, dim3(NBLK), dim3(NTHR), kargs, LDS_BYTES, stream);
    if (e != hipSuccess) fprintf(stderr, "cooperative launch failed: %s\n", hipGetErrorString(e));
#endif
#else
    launch_phase<0>(a, stream); launch_phase<1>(a, stream); launch_phase<2>(a, stream); launch_phase<3>(a, stream); launch_phase<4>(a, stream); launch_phase<5>(a, stream);
    launch_phase<6>(a, stream); launch_phase<7>(a, stream); launch_phase<8>(a, stream); launch_phase<9>(a, stream); launch_phase<10>(a, stream);
#endif
}
#ifdef TEST_LO
template __global__ void fwd_kernel<TEST_LO, TEST_HI>(Args);
#endif
```
